# Optimizing an MI355X kernel written in HIP

```python
import math
import jax
import jax.numpy as jnp
from jax import lax
import numpy as np

D_MODEL = 1024
BATCH = 8
SEQ = 4096
DEPTH = 2

CTX_LEN = 256
GRID_W = 64
D_MIX = D_MODEL
RET_W = D_MIX // 4
GLA_W = D_MIX // 4
S5_W = D_MIX // 4
HY_W = D_MIX - RET_W - GLA_W - S5_W
RET_HEADS = 4
RET_DH = RET_W // RET_HEADS
ROPE_BASE = 10000.0
GLA_HEADS = 4
GLA_DK = GLA_W // (2 * GLA_HEADS)
GLA_DV = GLA_W // GLA_HEADS
GLA_LOWRANK = 16
GLA_TAU = 16.0
S5_GROUP = 16
S5_GROUPS = S5_W // S5_GROUP
S5_STATE = 64
S5_DT_MIN = 1e-3
S5_DT_MAX = 1e-1
HY_CONV = 3
HY_EMB = 33
HY_BANDS = (HY_EMB - 1) // 2
HY_FFN = 64
HY_DECAY_SLOW = -math.log(1e-2) / 1.5
HY_DECAY_FAST = -math.log(1e-2) / 0.3
CHUNK = 128
D_FF = ((8 * D_MODEL // 3 + 255) // 256) * 256
N_EXPERTS = 8
TOP_K = 2
MOE_BLOCK = 256
N_DENSE = (DEPTH + 1) // 2
N_MOE = DEPTH // 2
ALPHA = (2 * DEPTH) ** 0.25
BETA = (8 * DEPTH) ** -0.25
LN_EPS = 1e-5
PROJ_LAYOUT = (('ret_q', RET_W), ('ret_k', RET_W), ('ret_v', RET_W), ('ret_g', RET_W),
               ('gla_q', GLA_HEADS * GLA_DK), ('gla_k', GLA_HEADS * GLA_DK), ('gla_v', GLA_W),
               ('gla_r', GLA_W), ('gla_a', 2 * GLA_LOWRANK), ('s5_u', S5_W), ('hy_p', 3 * HY_W))
D_PROJ = sum(w for _, w in PROJ_LAYOUT)
CTX_STATE_FIELDS = ('ret_k', 'ret_v', 'gla_k', 'gla_v', 'gla_a', 's5_u')

kernel_name = 'hybrid_ret_gla_s5_hyena_moe_dit'


def _ln(x, g=None, b=None):
    xf = x.astype(jnp.float32)
    mu = jnp.mean(xf, axis=-1, keepdims=True)
    var = jnp.mean(jnp.square(xf - mu), axis=-1, keepdims=True)
    y = (xf - mu) * lax.rsqrt(var + LN_EPS)
    if g is not None:
        y = y * g.astype(jnp.float32) + b.astype(jnp.float32)
    return y.astype(x.dtype)


def _same(t):
    return t


def _flip_pos(t):
    return jnp.flip(t, axis=2)


def _split_heads(t, n_heads):
    b, n, w = t.shape
    return t.reshape(b, n, n_heads, w // n_heads).transpose(0, 2, 1, 3)


def _merge_heads(t):
    b, h, n, d = t.shape
    return t.transpose(0, 2, 1, 3).reshape(b, n, h * d)


def _to_chunks(t):
    b, h, n, d = t.shape
    return t.reshape(b, h, n // CHUNK, CHUNK, d).transpose(2, 0, 1, 3, 4)


def _from_chunks(t):
    nc, b, h, c, d = t.shape
    return t.transpose(1, 2, 0, 3, 4).reshape(b, h, nc * c, d)


def _project(u, w_in, fields):
    offsets, start = {}, 0
    for name, width in PROJ_LAYOUT:
        offsets[name] = (start, width)
        start += width
    cols = jnp.concatenate([w_in[:, offsets[n][0]:offsets[n][0] + offsets[n][1]] for n in fields], axis=1)
    y = u @ cols
    out, start = {}, 0
    for n in fields:
        w = offsets[n][1]
        out[n] = y[..., start:start + w]
        start += w
    return out


def _grid_rotary(n_tokens):
    rows = n_tokens // GRID_W
    row = jnp.broadcast_to(jnp.arange(rows, dtype=jnp.float32)[:, None], (rows, GRID_W)).reshape(-1)
    col = jnp.broadcast_to(jnp.arange(GRID_W, dtype=jnp.float32)[None, :], (rows, GRID_W)).reshape(-1)
    n_freq = RET_DH // 4
    inv = ROPE_BASE ** (-jnp.arange(n_freq, dtype=jnp.float32) / n_freq)
    ang = jnp.concatenate([row[:, None] * inv, col[:, None] * inv], axis=-1)
    return jnp.cos(ang), jnp.sin(ang)


def _retention_scan(q, k, v, log_g, s0):
    pos = jnp.arange(CHUNK, dtype=jnp.float32)
    k_to_end = jnp.exp(log_g[:, None] * (CHUNK - 1.0 - pos))[None, :, :, None]
    chunk_decay = jnp.exp(log_g * CHUNK)[None, :, None, None]

    def update(s, kb, vb):
        return chunk_decay * s + jnp.einsum('bhcd,bhce->bhde', kb * k_to_end, vb)

    if q is None:
        def state_step(s, kv):
            return update(s, kv[0], kv[1]), None
        s, _ = lax.scan(state_step, s0, (_to_chunks(k), _to_chunks(v)))
        return None, s
    rel = pos[:, None] - pos[None, :]
    lower = rel >= 0
    dmat = jnp.where(lower, jnp.exp(log_g[:, None, None] * jnp.where(lower, rel, 0.0)), 0.0)[None]
    q_from_state = jnp.exp(log_g[:, None] * (pos + 1.0))[None, :, :, None]

    def step(s, qkv):
        qb, kb, vb = qkv
        att = jnp.einsum('bhid,bhjd->bhij', qb, kb) * dmat
        o = jnp.einsum('bhij,bhje->bhie', att, vb) + jnp.einsum('bhid,bhde->bhie', qb * q_from_state, s)
        return update(s, kb, vb), o

    s, o = lax.scan(step, s0, (_to_chunks(q), _to_chunks(k), _to_chunks(v)))
    return _from_chunks(o), s


def _gla_scan(q, k, v, log_a, s0):
    pos = jnp.arange(CHUNK)
    lower = (pos[:, None] >= pos[None, :])[:, :, None]

    def update(s, kb, vb, cum):
        end = cum[:, :, -1]
        return jnp.exp(end)[..., None] * s + jnp.einsum('bhcd,bhce->bhde', kb * jnp.exp(end[:, :, None] - cum), vb)

    if q is None:
        def state_step(s, inp):
            kb, vb, ab = inp
            return update(s, kb, vb, jnp.cumsum(ab, axis=2)), None
        s, _ = lax.scan(state_step, s0, (_to_chunks(k), _to_chunks(v), _to_chunks(log_a)))
        return None, s

    def step(s, inp):
        qb, kb, vb, ab = inp
        cum = jnp.cumsum(ab, axis=2)
        diff = jnp.where(lower, cum[:, :, :, None, :] - cum[:, :, None, :, :], -jnp.inf)
        att = jnp.einsum('bhid,bhjd,bhijd->bhij', qb, kb, jnp.exp(diff))
        o = jnp.einsum('bhij,bhje->bhie', att, vb) + jnp.einsum('bhid,bhde->bhie', qb * jnp.exp(cum), s)
        return update(s, kb, vb, cum), o

    s, o = lax.scan(step, s0, (_to_chunks(q), _to_chunks(k), _to_chunks(v), _to_chunks(log_a)))
    return _from_chunks(o), s


def _retention_mixer(pl, pc, lp, need_ctx):
    f32 = jnp.float32
    cos, sin = _grid_rotary(pl['ret_q'].shape[1])

    def rotate(t):
        b, n, _ = t.shape
        t = t.astype(f32).reshape(b, n, RET_HEADS, RET_DH)
        t1, t2 = jnp.split(t, 2, axis=-1)
        cs, sn = cos[None, :, None, :], sin[None, :, None, :]
        return jnp.concatenate([t1 * cs - t2 * sn, t1 * sn + t2 * cs], axis=-1).transpose(0, 2, 1, 3)

    def heads(t):
        return _split_heads(t.astype(f32), RET_HEADS)

    scale = RET_DH ** -0.5
    q_l, k_l, v_l = rotate(pl['ret_q']), rotate(pl['ret_k']) * scale, heads(pl['ret_v'])
    q_c = heads(pc['ret_q']) if need_ctx else None
    k_c, v_c = heads(pc['ret_k']) * scale, heads(pc['ret_v'])
    s0 = jnp.zeros((k_c.shape[0], RET_HEADS, RET_DH, RET_DH), f32)
    o_l, o_c = [], []
    for d in range(2):
        log_g = jax.nn.log_sigmoid(lp['ret_decay'][d].astype(f32))
        fl = _same if d == 0 else _flip_pos
        oc, s_ctx = _retention_scan(None if q_c is None else fl(q_c), fl(k_c), fl(v_c), log_g, s0)
        ol, _ = _retention_scan(fl(q_l), fl(k_l), fl(v_l), log_g, s_ctx)
        o_l.append(fl(ol))
        if need_ctx:
            o_c.append(fl(oc))

    def finish(o, gate):
        o = o[0] + o[1]
        mu = jnp.mean(o, axis=-1, keepdims=True)
        var = jnp.mean(jnp.square(o - mu), axis=-1, keepdims=True)
        y = _merge_heads((o - mu) * lax.rsqrt(var + LN_EPS)) * lp['ret_gn_g'].astype(f32) + lp['ret_gn_b'].astype(f32)
        return (y * jax.nn.silu(gate.astype(f32))).astype(gate.dtype)

    y_l = finish(o_l, pl['ret_g'])
    y_c = finish(o_c, pc['ret_g']) if need_ctx else None
    return y_l, y_c


def _gla_mixer(pl, pc, lp, need_ctx):
    f32 = jnp.float32
    scale = GLA_DK ** -0.5

    def heads(t):
        return _split_heads(t.astype(f32), GLA_HEADS)

    def log_gate(a, d):
        a = a.astype(f32)[..., d * GLA_LOWRANK:(d + 1) * GLA_LOWRANK]
        g = a @ lp['gla_wa'][d].astype(f32) + lp['gla_ba'][d].astype(f32)
        return heads(jax.nn.log_sigmoid(g) / GLA_TAU)

    q_l, k_l, v_l = heads(pl['gla_q']) * scale, heads(pl['gla_k']), heads(pl['gla_v'])
    q_c = heads(pc['gla_q']) * scale if need_ctx else None
    k_c, v_c = heads(pc['gla_k']), heads(pc['gla_v'])
    s0 = jnp.zeros((k_c.shape[0], GLA_HEADS, GLA_DK, GLA_DV), f32)
    o_l, o_c = [], []
    for d in range(2):
        fl = _same if d == 0 else _flip_pos
        oc, s_ctx = _gla_scan(None if q_c is None else fl(q_c), fl(k_c), fl(v_c), fl(log_gate(pc['gla_a'], d)), s0)
        ol, _ = _gla_scan(fl(q_l), fl(k_l), fl(v_l), fl(log_gate(pl['gla_a'], d)), s_ctx)
        o_l.append(fl(ol))
        if need_ctx:
            o_c.append(fl(oc))

    def finish(o, r):
        o = o[0] + o[1]
        o = o * lax.rsqrt(jnp.mean(jnp.square(o), axis=-1, keepdims=True) + LN_EPS)
        return (_merge_heads(o) * lp['gla_norm_g'].astype(f32) * jax.nn.silu(r.astype(f32))).astype(r.dtype)

    y_l = finish(o_l, pl['gla_r'])
    y_c = finish(o_c, pc['gla_r']) if need_ctx else None
    return y_l, y_c


def _s5_scan(lam_bar, bu, h0):
    bu = bu.at[:, 0].add(lam_bar * h0)
    a = jnp.broadcast_to(lam_bar, bu.shape)

    def combine(left, right):
        a_l, b_l = left
        a_r, b_r = right
        return a_r * a_l, a_r * b_l + b_r

    return lax.associative_scan(combine, (a, bu), axis=1)[1]


def _s5_mixer(u_lat, u_ctx, lp, need_ctx):
    f32 = jnp.float32

    def groups(u):
        b, n, _ = u.shape
        return u.astype(f32).reshape(b, n, S5_GROUPS, S5_GROUP).astype(jnp.complex64)

    def flip_seq(t):
        return jnp.flip(t, axis=1)

    ul, uc = groups(u_lat), groups(u_ctx)
    h0 = jnp.zeros((ul.shape[0], S5_GROUPS, S5_STATE), jnp.complex64)
    y_l, y_c = [], []
    for d in range(2):
        lam = lp['s5_lam_re'][d].astype(f32) + 1j * lp['s5_lam_im'][d].astype(f32)
        dt = jnp.exp(lp['s5_log_dt'][d].astype(f32))[:, None]
        lam_bar = jnp.exp(lam * dt)
        b_mat = lp['s5_b_re'][d].astype(f32) + 1j * lp['s5_b_im'][d].astype(f32)
        b_bar = ((lam_bar - 1.0) / lam)[:, :, None] * b_mat
        c_mat = lp['s5_c_re'][d].astype(f32) + 1j * lp['s5_c_im'][d].astype(f32)
        fl = _same if d == 0 else flip_seq
        h_c = _s5_scan(lam_bar, jnp.einsum('blgp,gnp->blgn', fl(uc), b_bar), h0)
        h_l = _s5_scan(lam_bar, jnp.einsum('blgp,gnp->blgn', fl(ul), b_bar), h_c[:, -1])
        y_l.append(fl(jnp.real(jnp.einsum('blgn,gpn->blgp', h_l, c_mat))))
        if need_ctx:
            y_c.append(fl(jnp.real(jnp.einsum('blgn,gpn->blgp', h_c, c_mat))))

    def finish(ys, u):
        b, n = u.shape[:2]
        y = (ys[0] + ys[1]).reshape(b, n, S5_W) + lp['s5_d'].astype(f32) * u.astype(f32)
        g = jax.nn.gelu(y)
        return (g * jax.nn.sigmoid(g @ lp['s5_glu_w'].astype(f32) + lp['s5_glu_b'].astype(f32))).astype(u.dtype)

    out_l = finish(y_l, u_lat)
    out_c = finish(y_c, u_ctx) if need_ctx else None
    return out_l, out_c


def _hyena_response(n, lp):
    f32 = jnp.float32
    t = jnp.linspace(0.0, 1.0, n, dtype=f32)[:, None]
    idx = jnp.arange(n, dtype=f32)[:, None]
    bands = jnp.linspace(1e-4, HY_BANDS - 1, HY_BANDS, dtype=f32)[None, :]
    ang = (2.0 * math.pi / n) * bands * idx
    z = jnp.concatenate([t, jnp.cos(ang), -jnp.sin(ang)], axis=-1)
    fr = lp['hy_freq'].astype(f32)
    hdn = jnp.sin(fr * (z @ lp['hy_fw1'].astype(f32) + lp['hy_fb1'].astype(f32)))
    hdn = jnp.sin(fr * (hdn @ lp['hy_fw2'].astype(f32) + lp['hy_fb2'].astype(f32)))
    window = jnp.exp(-t[:, :, None] * jnp.abs(lp['hy_decay'].astype(f32)))
    filt = (hdn @ lp['hy_fw3'].astype(f32)).reshape(n, 2, HY_W) * window
    circ = jnp.concatenate([filt[:, 0], jnp.zeros((1, HY_W), f32), jnp.flip(filt[1:, 1], axis=0)], axis=0)
    circ = circ / jnp.sum(jnp.abs(circ), axis=0, keepdims=True)
    return jnp.fft.rfft(circ, axis=0)


def _hyena(p, lp):
    f32 = jnp.float32
    n = p.shape[1]
    pad = HY_CONV // 2
    pp = jnp.pad(p.astype(f32), ((0, 0), (pad, pad), (0, 0)))
    cw = lp['hy_conv_w'].astype(f32)
    s = lp['hy_conv_b'].astype(f32)
    for j in range(HY_CONV):
        s = s + pp[:, j:j + n] * cw[j]
    x0, x1, v = jnp.split(s, 3, axis=-1)
    z = x1 * v
    resp = _hyena_response(n, lp)
    y = jnp.fft.irfft(jnp.fft.rfft(z, n=2 * n, axis=1) * resp[None], n=2 * n, axis=1)[:, :n]
    return (x0 * (y + z * lp['hy_bias'].astype(f32))).astype(p.dtype)


def _token_mixer(u_lat, u_ctx, lp, need_ctx):
    all_fields = tuple(name for name, _ in PROJ_LAYOUT)
    pl = _project(u_lat, lp['w_in'], all_fields)
    pc = _project(u_ctx, lp['w_in'], all_fields if need_ctx else CTX_STATE_FIELDS)
    ret_l, ret_c = _retention_mixer(pl, pc, lp, need_ctx)
    gla_l, gla_c = _gla_mixer(pl, pc, lp, need_ctx)
    s5_l, s5_c = _s5_mixer(pl['s5_u'], pc['s5_u'], lp, need_ctx)
    y_l = jnp.concatenate([ret_l, gla_l, s5_l, _hyena(pl['hy_p'], lp)], axis=-1) @ lp['w_out']
    if not need_ctx:
        return y_l, None
    y_c = jnp.concatenate([ret_c, gla_c, s5_c, _hyena(pc['hy_p'], lp)], axis=-1) @ lp['w_out']
    return y_l, y_c


def _swiglu(h, w1, w3, w2):
    return (jax.nn.silu(h @ w1) * (h @ w3)) @ w2


def _moe_swiglu(h, router_w, router_b, w1, w3, w2):
    shape = h.shape
    t = h.reshape(-1, shape[-1])
    n_tok = t.shape[0]
    n_asg = n_tok * TOP_K
    logits = (t @ router_w).astype(jnp.float32) + router_b.astype(jnp.float32)
    top_logit, top_idx = lax.top_k(logits, TOP_K)
    gate = jax.nn.softmax(top_logit, axis=-1).reshape(-1)
    expert = top_idx.reshape(-1)
    token = jnp.repeat(jnp.arange(n_tok, dtype=jnp.int32), TOP_K)
    order = jnp.argsort(expert)
    expert_s, token_s, gate_s = expert[order], token[order], gate[order]
    count = jnp.bincount(expert, length=N_EXPERTS)
    padded = (count + MOE_BLOCK - 1) // MOE_BLOCK * MOE_BLOCK
    pad_end = jnp.cumsum(padded)
    pad_start = pad_end - padded
    sort_start = jnp.cumsum(count) - count
    slot = pad_start[expert_s] + jnp.arange(n_asg, dtype=jnp.int32) - sort_start[expert_s]
    n_blocks = -(-n_asg // MOE_BLOCK) + N_EXPERTS
    cap = n_blocks * MOE_BLOCK
    slot_token = jnp.full((cap,), n_tok, jnp.int32).at[slot].set(token_s)
    slot_gate = jnp.zeros((cap,), jnp.float32).at[slot].set(gate_s)
    block_expert = jnp.minimum(jnp.searchsorted(pad_end, jnp.arange(n_blocks, dtype=jnp.int32) * MOE_BLOCK, side='right'), N_EXPERTS - 1)
    xb = jnp.take(t, slot_token, axis=0, mode='clip').reshape(n_blocks, MOE_BLOCK, -1)

    def expert_block(args):
        xe, e = args
        return (jax.nn.silu(xe @ w1[e]) * (xe @ w3[e])) @ w2[e]

    yb = lax.map(expert_block, (xb, block_expert)).reshape(cap, -1)
    out = jnp.zeros_like(t).at[slot_token].add(yb * slot_gate[:, None].astype(yb.dtype), mode='drop')
    return out.reshape(shape)


def setup_inputs(seed: int = 0) -> dict:
    key = jax.random.key(seed)
    keys = jax.random.split(key, 64)
    counter = [0]
    f32 = jnp.float32

    def nxt():
        counter[0] += 1
        return keys[counter[0] - 1]

    def nrm(shape, scale):
        return jax.random.normal(nxt(), shape, f32) * scale

    L, D = DEPTH, D_MODEL
    G, N, P = S5_GROUPS, S5_STATE, S5_GROUP
    GK = GLA_HEADS * GLA_DK
    return {
        'x': nrm((BATCH, SEQ, D), 1.0),
        'c': nrm((BATCH, D), 1.0),
        'ctx': nrm((BATCH, CTX_LEN, D), 1.0),
        'c_ctx': nrm((D,), 1.0),
        'ada_w': nrm((L, D, 6 * D), 0.5 * D ** -0.5),
        'ada_b': nrm((L, 6 * D), 0.02),
        'w_in': nrm((L, D, D_PROJ), D ** -0.5),
        'ret_decay': jnp.log(2.0 ** (5.0 + jnp.arange(RET_HEADS, dtype=f32)) - 1.0) + nrm((L, 2, RET_HEADS), 0.01),
        'ret_gn_g': 1.0 + nrm((L, RET_W), 0.02),
        'ret_gn_b': nrm((L, RET_W), 0.02),
        'gla_wa': nrm((L, 2, GLA_LOWRANK, GK), GLA_LOWRANK ** -0.5),
        'gla_ba': nrm((L, 2, GK), 0.02),
        'gla_norm_g': 1.0 + nrm((L, GLA_W), 0.02),
        's5_lam_re': -0.5 + nrm((L, 2, G, N), 0.01),
        's5_lam_im': math.pi * jnp.arange(N, dtype=f32) + nrm((L, 2, G, N), 0.01),
        's5_log_dt': jax.random.uniform(nxt(), (L, 2, G), f32, math.log(S5_DT_MIN), math.log(S5_DT_MAX)),
        's5_b_re': nrm((L, 2, G, N, P), (2 * P) ** -0.5),
        's5_b_im': nrm((L, 2, G, N, P), (2 * P) ** -0.5),
        's5_c_re': nrm((L, 2, G, P, N), N ** -0.5),
        's5_c_im': nrm((L, 2, G, P, N), N ** -0.5),
        's5_d': nrm((L, S5_W), 1.0),
        's5_glu_w': nrm((L, S5_W, S5_W), S5_W ** -0.5),
        's5_glu_b': nrm((L, S5_W), 0.02),
        'hy_conv_w': nrm((L, HY_CONV, 3 * HY_W), HY_CONV ** -0.5),
        'hy_conv_b': nrm((L, 3 * HY_W), 0.02),
        'hy_fw1': nrm((L, HY_EMB, HY_FFN), HY_EMB ** -0.5),
        'hy_fb1': nrm((L, HY_FFN), 0.02),
        'hy_freq': 1.0 + nrm((L, HY_FFN), 0.02),
        'hy_fw2': nrm((L, HY_FFN, HY_FFN), HY_FFN ** -0.5),
        'hy_fb2': nrm((L, HY_FFN), 0.02),
        'hy_fw3': nrm((L, HY_FFN, 2 * HY_W), HY_FFN ** -0.5),
        'hy_decay': jnp.linspace(HY_DECAY_SLOW, HY_DECAY_FAST, HY_W, dtype=f32) * jnp.exp(nrm((L, 2, HY_W), 0.01)),
        'hy_bias': nrm((L, HY_W), 1.0),
        'w_out': nrm((L, D_MIX, D), BETA * D_MIX ** -0.5),
        'ln_mix_g': 1.0 + nrm((L, D), 0.02),
        'ln_mix_b': nrm((L, D), 0.02),
        'ln_ffn_g': 1.0 + nrm((L, D), 0.02),
        'ln_ffn_b': nrm((L, D), 0.02),
        'ffn_w1': nrm((N_DENSE, D, D_FF), D ** -0.5),
        'ffn_w3': nrm((N_DENSE, D, D_FF), D ** -0.5),
        'ffn_w2': nrm((N_DENSE, D_FF, D), BETA * D_FF ** -0.5),
        'router_w': nrm((N_MOE, D, N_EXPERTS), D ** -0.5),
        'router_b': nrm((N_MOE, N_EXPERTS), 0.01),
        'moe_w1': nrm((N_MOE, N_EXPERTS, D, D_FF), D ** -0.5),
        'moe_w3': nrm((N_MOE, N_EXPERTS, D, D_FF), D ** -0.5),
        'moe_w2': nrm((N_MOE, N_EXPERTS, D_FF, D), BETA * D_FF ** -0.5),
    }


def reference(x, c, ctx, c_ctx, ada_w, ada_b, w_in, ret_decay, ret_gn_g, ret_gn_b, gla_wa, gla_ba, gla_norm_g,
              s5_lam_re, s5_lam_im, s5_log_dt, s5_b_re, s5_b_im, s5_c_re, s5_c_im, s5_d, s5_glu_w, s5_glu_b,
              hy_conv_w, hy_conv_b, hy_fw1, hy_fb1, hy_freq, hy_fw2, hy_fb2, hy_fw3, hy_decay, hy_bias,
              w_out, ln_mix_g, ln_mix_b, ln_ffn_g, ln_ffn_b, ffn_w1, ffn_w3, ffn_w2,
              router_w, router_b, moe_w1, moe_w3, moe_w2):
    h_ctx = ctx
    for i in range(DEPTH):
        last = i == DEPTH - 1
        lp = {
            'w_in': w_in[i], 'ret_decay': ret_decay[i], 'ret_gn_g': ret_gn_g[i], 'ret_gn_b': ret_gn_b[i],
            'gla_wa': gla_wa[i], 'gla_ba': gla_ba[i], 'gla_norm_g': gla_norm_g[i],
            's5_lam_re': s5_lam_re[i], 's5_lam_im': s5_lam_im[i], 's5_log_dt': s5_log_dt[i],
            's5_b_re': s5_b_re[i], 's5_b_im': s5_b_im[i], 's5_c_re': s5_c_re[i], 's5_c_im': s5_c_im[i],
            's5_d': s5_d[i], 's5_glu_w': s5_glu_w[i], 's5_glu_b': s5_glu_b[i],
            'hy_conv_w': hy_conv_w[i], 'hy_conv_b': hy_conv_b[i], 'hy_fw1': hy_fw1[i], 'hy_fb1': hy_fb1[i],
            'hy_freq': hy_freq[i], 'hy_fw2': hy_fw2[i], 'hy_fb2': hy_fb2[i], 'hy_fw3': hy_fw3[i],
            'hy_decay': hy_decay[i], 'hy_bias': hy_bias[i], 'w_out': w_out[i],
        }
        j = i // 2
        if i % 2 == 0:
            ffn = lambda h, j=j: _swiglu(h, ffn_w1[j], ffn_w3[j], ffn_w2[j])
        else:
            ffn = lambda h, j=j: _moe_swiglu(h, router_w[j], router_b[j], moe_w1[j], moe_w3[j], moe_w2[j])
        mod = (jax.nn.silu(c) @ ada_w[i] + ada_b[i])[:, None, :]
        sh_m, sc_m, g_m, sh_f, sc_f, g_f = jnp.split(mod, 6, axis=-1)
        n_ctx_mod = 2 if last else 6
        mod_c = jax.nn.silu(c_ctx) @ ada_w[i][:, :n_ctx_mod * D_MODEL] + ada_b[i][:n_ctx_mod * D_MODEL]
        mods_c = jnp.split(mod_c, n_ctx_mod)
        u_lat = _ln(x) * (1.0 + sc_m) + sh_m
        u_ctx = _ln(h_ctx) * (1.0 + mods_c[1]) + mods_c[0]
        y_lat, y_ctx = _token_mixer(u_lat, u_ctx, lp, not last)
        x = _ln(ALPHA * x + g_m * y_lat, ln_mix_g[i], ln_mix_b[i])
        v_lat = _ln(x) * (1.0 + sc_f) + sh_f
        x = _ln(ALPHA * x + g_f * ffn(v_lat), ln_ffn_g[i], ln_ffn_b[i])
        if not last:
            h_ctx = _ln(ALPHA * h_ctx + mods_c[2] * y_ctx, ln_mix_g[i], ln_mix_b[i])
            v_ctx = _ln(h_ctx) * (1.0 + mods_c[4]) + mods_c[3]
            h_ctx = _ln(ALPHA * h_ctx + mods_c[5] * ffn(v_ctx), ln_ffn_g[i], ln_ffn_b[i])
    return x
```

```cpp
#ifndef EMU
#include <hip/hip_runtime.h>
#include <hip/hip_cooperative_groups.h>
#endif
#include <stdint.h>
#include <math.h>

#ifndef BATCH
#define BATCH 8
#endif
#ifndef SEQ
#define SEQ 4096
#endif
#ifndef CTXL
#define CTXL 256
#endif
#define DM 1024
#define DEPTH 2
#define GRID_W 64
#define DPROJ 2848
#define DFF 2816
#define NEXP 8
#define NLAT (BATCH * SEQ)
#define NCTX (BATCH * CTXL)
#define NTOK (NLAT + NCTX)
#define MOE_CAP (2 * NLAT + NEXP * 256)
#define MOE_PASSES 4
#define MOE_R (MOE_CAP / MOE_PASSES)
#define LN_EPS 1e-5f
#define ALPHA 1.4142135623730951f
#define O_RQ 0
#define O_RK 256
#define O_RV 512
#define O_RG 768
#define O_GQ 1024
#define O_GK 1152
#define O_GV 1280
#define O_GR 1536
#define O_GA 1792
#define O_SU 1824
#define O_HP 2080

enum { I_X, I_C, I_CTX, I_CCTX, I_ADA_W, I_ADA_B, I_W_IN, I_RET_DECAY, I_RET_GN_G, I_RET_GN_B, I_GLA_WA, I_GLA_BA,
       I_GLA_NORM_G, I_S5_LAM_RE, I_S5_LAM_IM, I_S5_LOG_DT, I_S5_B_RE, I_S5_B_IM, I_S5_C_RE, I_S5_C_IM, I_S5_D,
       I_S5_GLU_W, I_S5_GLU_B, I_HY_CONV_W, I_HY_CONV_B, I_HY_FW1, I_HY_FB1, I_HY_FREQ, I_HY_FW2, I_HY_FB2, I_HY_FW3,
       I_HY_DECAY, I_HY_BIAS, I_W_OUT, I_LN_MIX_G, I_LN_MIX_B, I_LN_FFN_G, I_LN_FFN_B, I_FFN_W1, I_FFN_W3, I_FFN_W2,
       I_ROUTER_W, I_ROUTER_B, I_MOE_W1, I_MOE_W3, I_MOE_W2, N_IN };

#ifdef EMU_F32ACT
typedef float act_t;
__device__ __forceinline__ float a2f(act_t v) { return v; }
__device__ __forceinline__ act_t f2a(float f) { return f; }
#else
typedef unsigned short act_t;
__device__ __forceinline__ float a2f(act_t v) { union { unsigned u; float f; } c; c.u = ((unsigned)v) << 16; return c.f; }
__device__ __forceinline__ act_t f2a(float f) { union { unsigned u; float f; } c; c.f = f; unsigned u = c.u; u += 0x7fffu + ((u >> 16) & 1u); return (act_t)(u >> 16); }
#endif

struct Params {
    const float* in[N_IN];
    float* out;
    float* mod;
    act_t* proj;
    act_t* u;
    act_t* y;
    act_t* mix;
    float* osum;
    act_t* ys;
    float* hctx;
    float* loga;
    float* hz;
    float* filt;
    float* fnorm;
    float* rot;
    int* moe_cnt;
    int* tok_e;
    float* tok_g;
    int* slot_asg;
};

#define FILT_LAYER_FLOATS ((2 * SEQ + 2 * CTXL) * 256)

__device__ __forceinline__ float* smem_base() {
    __shared__ float smem[3 * 16 * 68 + 64];
    return smem;
}
__device__ __forceinline__ float wave_sum(float v) {
    for (int o = 32; o > 0; o >>= 1) v += __shfl_xor(v, o);
    return v;
}
__device__ __forceinline__ float silu_f(float x) { return x / (1.0f + expf(-x)); }
__device__ __forceinline__ float sigmoid_f(float x) { return 1.0f / (1.0f + expf(-x)); }
__device__ __forceinline__ float log_sigmoid_f(float x) { return fminf(x, 0.0f) - log1pf(expf(-fabsf(x))); }
__device__ __forceinline__ float gelu_tanh_f(float x) {
    return 0.5f * x * (1.0f + tanhf(0.7978845608028654f * (x + 0.044715f * x * x * x)));
}
__device__ __forceinline__ void ln_stats16(const float* v, float& mu, float& rstd) {
    float s = 0.f;
    for (int i = 0; i < 16; ++i) s += v[i];
    s = wave_sum(s);
    mu = s * (1.0f / DM);
    float q = 0.f;
    for (int i = 0; i < 16; ++i) { float d = v[i] - mu; q += d * d; }
    q = wave_sum(q);
    rstd = 1.0f / sqrtf(q * (1.0f / DM) + LN_EPS);
}
__device__ __forceinline__ int row_modidx(int row) { return row < NLAT ? row / SEQ : BATCH; }

__device__ void st_prep(const Params& p) {
    const int tid = threadIdx.x, nb = gridDim.x, bid = blockIdx.x;
    for (long it = (long)bid * 256 + tid; it < (long)DEPTH * (BATCH + 1) * 6 * DM; it += (long)nb * 256) {
        int col = it % (6 * DM);
        int bb = (it / (6 * DM)) % (BATCH + 1);
        int l = it / (6 * DM * (BATCH + 1));
        const float* cv = bb < BATCH ? p.in[I_C] + bb * DM : p.in[I_CCTX];
        const float* w = p.in[I_ADA_W] + (long)l * DM * 6 * DM + col;
        float acc = p.in[I_ADA_B][l * 6 * DM + col];
        for (int k = 0; k < DM; ++k) acc += silu_f(cv[k]) * w[(long)k * 6 * DM];
        p.mod[it] = acc;
    }
    for (int it = bid * 256 + tid; it < SEQ * 32; it += nb * 256) {
        int t = it / 32, f = it % 32;
        double pos = f < 16 ? (double)(t / GRID_W) : (double)(t % GRID_W);
        double inv = pow(10000.0, -(double)(f & 15) / 16.0);
        double ang = pos * inv;
        p.rot[it * 2] = (float)cos(ang);
        p.rot[it * 2 + 1] = (float)sin(ang);
    }
    if (bid == 0 && tid < 16) p.moe_cnt[tid] = 0;
    {
        double* sh = (double*)smem_base();
        const int wave = tid >> 6, lane = tid & 63;
        double* h1 = sh + wave * 128;
        double* h2 = h1 + 64;
        const int per_layer = SEQ + CTXL;
        for (int base = bid * 4; base < DEPTH * per_layer; base += nb * 4) {
            int it = base + wave;
            int l = it / per_layer;
            int r = it % per_layer;
            int which = r < SEQ ? 0 : 1;
            int n = which ? CTXL : SEQ;
            int t = which ? r - SEQ : r;
            float* circ = p.filt + (long)l * FILT_LAYER_FLOATS + (which ? 2 * SEQ * 256 : 0);
            double tn = (double)t / (double)(n - 1);
            const float* fw1 = p.in[I_HY_FW1] + l * 33 * 64;
            const float* fw2 = p.in[I_HY_FW2] + l * 64 * 64;
            const float* fw3 = p.in[I_HY_FW3] + l * 64 * 512;
            double fr = p.in[I_HY_FREQ][l * 64 + lane];
            double a = (double)p.in[I_HY_FB1][l * 64 + lane] + tn * fw1[lane];
            for (int k = 0; k < 16; ++k) {
                double band = 1e-4 + (double)k * ((15.0 - 1e-4) / 15.0);
                double ang = (2.0 * M_PI / (double)n) * band * (double)t;
                a += cos(ang) * fw1[(1 + k) * 64 + lane];
                a += -sin(ang) * fw1[(17 + k) * 64 + lane];
            }
            h1[lane] = sin(fr * a);
            __syncthreads();
            double a2 = p.in[I_HY_FB2][l * 64 + lane];
            for (int i = 0; i < 64; ++i) a2 += h1[i] * fw2[i * 64 + lane];
            h2[lane] = sin(fr * a2);
            __syncthreads();
            for (int cc = 0; cc < 8; ++cc) {
                int c = cc * 64 + lane;
                double f = 0.0;
                for (int i = 0; i < 64; ++i) f += h2[i] * fw3[i * 512 + c];
                int w = c >> 8, ch = c & 255;
                double dec = fabs((double)p.in[I_HY_DECAY][(l * 2 + w) * 256 + ch]);
                f *= exp(-tn * dec);
                if (w == 0) circ[(long)t * 256 + ch] = (float)f;
                else if (t >= 1) circ[(long)(2 * n - t) * 256 + ch] = (float)f;
                if (t == 0 && w == 1) circ[(long)n * 256 + ch] = 0.0f;
            }
            __syncthreads();
        }
    }
}

__device__ void st_prep2(const Params& p) {
    const int tid = threadIdx.x, wave = tid >> 6, lane = tid & 63;
    for (int base = blockIdx.x * 4; base < DEPTH * 2 * 256; base += gridDim.x * 4) {
        int it = base + wave;
        int ch = it & 255, which = (it >> 8) & 1, l = it >> 9;
        int n = which ? CTXL : SEQ;
        const float* circ = p.filt + (long)l * FILT_LAYER_FLOATS + (which ? 2 * SEQ * 256 : 0);
        double s = 0.0;
        for (int i = lane; i < 2 * n; i += 64) s += fabs((double)circ[(long)i * 256 + ch]);
        float hi = (float)s, lo = (float)(s - (double)hi);
        hi = wave_sum(hi); lo = wave_sum(lo);
        if (lane == 0) p.fnorm[it] = (float)(1.0 / ((double)hi + (double)lo));
    }
}

__device__ void st_ln(const Params& p, int l, int mode) {
    const int tid = threadIdx.x, wave = tid >> 6, lane = tid & 63;
    const bool last = (l == DEPTH - 1);
    const int nrows = (mode == 0) ? NTOK : (last ? NLAT : NTOK);
    const bool moe = (l & 1);
    for (int base = blockIdx.x * 4; base < nrows; base += gridDim.x * 4) {
        const int row = base + wave;
        const bool lat = row < NLAT;
        const float* modp = p.mod + ((long)l * (BATCH + 1) + row_modidx(row)) * 6 * DM;
        float v[16];
        float mu, rstd;
        if (mode == 0) {
            const float* src = lat ? p.in[I_X] + (long)row * DM : p.in[I_CTX] + (long)(row - NLAT) * DM;
            for (int i = 0; i < 16; ++i) v[i] = src[i * 64 + lane];
            ln_stats16(v, mu, rstd);
            for (int i = 0; i < 16; ++i) {
                int c = i * 64 + lane;
                p.u[(long)row * DM + c] = f2a((v[i] - mu) * rstd * (1.0f + modp[DM + c]) + modp[c]);
            }
        } else if (mode == 1) {
            const float* src = lat ? ((l == 0 ? p.in[I_X] : p.out) + (long)row * DM)
                                   : ((l == 0 ? p.in[I_CTX] : p.hctx) + (long)(row - NLAT) * DM);
            float* dst = lat ? p.out + (long)row * DM : p.hctx + (long)(row - NLAT) * DM;
            for (int i = 0; i < 16; ++i) {
                int c = i * 64 + lane;
                v[i] = ALPHA * src[c] + modp[2 * DM + c] * a2f(p.y[(long)row * DM + c]);
            }
            ln_stats16(v, mu, rstd);
            for (int i = 0; i < 16; ++i) {
                int c = i * 64 + lane;
                v[i] = (v[i] - mu) * rstd * p.in[I_LN_MIX_G][l * DM + c] + p.in[I_LN_MIX_B][l * DM + c];
                dst[c] = v[i];
            }
            ln_stats16(v, mu, rstd);
            for (int i = 0; i < 16; ++i) {
                int c = i * 64 + lane;
                p.u[(long)row * DM + c] = f2a((v[i] - mu) * rstd * (1.0f + modp[4 * DM + c]) + modp[3 * DM + c]);
            }
        } else {
            float* dst = lat ? p.out + (long)row * DM : p.hctx + (long)(row - NLAT) * DM;
            for (int i = 0; i < 16; ++i) {
                int c = i * 64 + lane;
                float f = moe ? (a2f(p.ys[(long)(row * 2) * DM + c]) + a2f(p.ys[(long)(row * 2 + 1) * DM + c]))
                              : a2f(p.y[(long)row * DM + c]);
                v[i] = ALPHA * dst[c] + modp[5 * DM + c] * f;
            }
            ln_stats16(v, mu, rstd);
            for (int i = 0; i < 16; ++i) {
                int c = i * 64 + lane;
                v[i] = (v[i] - mu) * rstd * p.in[I_LN_FFN_G][l * DM + c] + p.in[I_LN_FFN_B][l * DM + c];
                dst[c] = v[i];
            }
            if (l + 1 < DEPTH) {
                const float* modn = p.mod + ((long)(l + 1) * (BATCH + 1) + row_modidx(row)) * 6 * DM;
                ln_stats16(v, mu, rstd);
                for (int i = 0; i < 16; ++i) {
                    int c = i * 64 + lane;
                    p.u[(long)row * DM + c] = f2a((v[i] - mu) * rstd * (1.0f + modn[DM + c]) + modn[c]);
                }
            }
        }
    }
}

__device__ void st_router(const Params& p, int l) {
    const int tid = threadIdx.x, wave = tid >> 6, lane = tid & 63;
    const int j = l / 2;
    const float* rw = p.in[I_ROUTER_W] + (long)j * DM * NEXP;
    const float* rb = p.in[I_ROUTER_B] + j * NEXP;
    for (int i = blockIdx.x * 256 + tid; i < MOE_CAP; i += gridDim.x * 256) p.slot_asg[i] = -1;
    for (int base = blockIdx.x * 4; base < NLAT; base += gridDim.x * 4) {
        const int row = base + wave;
        const float* modp = p.mod + ((long)l * (BATCH + 1) + row_modidx(row)) * 6 * DM;
        float v[16], mu, rstd;
        for (int i = 0; i < 16; ++i) v[i] = p.out[(long)row * DM + i * 64 + lane];
        ln_stats16(v, mu, rstd);
        float lg[NEXP];
        for (int e = 0; e < NEXP; ++e) lg[e] = 0.f;
        for (int i = 0; i < 16; ++i) {
            int c = i * 64 + lane;
            float vv = (v[i] - mu) * rstd * (1.0f + modp[4 * DM + c]) + modp[3 * DM + c];
            for (int e = 0; e < NEXP; ++e) lg[e] += vv * rw[c * NEXP + e];
        }
        for (int e = 0; e < NEXP; ++e) lg[e] = wave_sum(lg[e]) + rb[e];
        if (lane == 0) {
            int e1 = 0;
            for (int e = 1; e < NEXP; ++e) if (lg[e] > lg[e1]) e1 = e;
            int e2 = (e1 == 0) ? 1 : 0;
            for (int e = 0; e < NEXP; ++e) if (e != e1 && lg[e] > lg[e2]) e2 = e;
            float ex = expf(lg[e2] - lg[e1]);
            float g1 = 1.0f / (1.0f + ex);
            p.tok_e[row * 2] = e1; p.tok_e[row * 2 + 1] = e2;
            p.tok_g[row * 2] = g1; p.tok_g[row * 2 + 1] = ex * g1;
            atomicAdd(&p.moe_cnt[e1], 1);
            atomicAdd(&p.moe_cnt[e2], 1);
        }
    }
}
__device__ __forceinline__ void moe_offsets(const Params& p, int* pstart, int* pend) {
    int acc = 0;
    for (int e = 0; e < NEXP; ++e) {
        int c = p.moe_cnt[e];
        pstart[e] = acc;
        acc += (c + 255) / 256 * 256;
        pend[e] = acc;
    }
}
__device__ void st_place(const Params& p) {
    int pstart[NEXP], pend[NEXP];
    moe_offsets(p, pstart, pend);
    for (int a = blockIdx.x * 256 + threadIdx.x; a < 2 * NLAT; a += gridDim.x * 256) {
        int e = p.tok_e[a];
        int pos = atomicAdd(&p.moe_cnt[8 + e], 1);
        p.slot_asg[pstart[e] + pos] = a;
    }
}

template <bool DUAL, class AL, class BL, class BL2, class EP>
__device__ __forceinline__ void gemm_tile64(int m0, int n0, int K, AL aload, BL bload, BL2 bload2, EP epi) {
    float* sm = smem_base();
    float(*As)[68] = (float(*)[68])sm;
    float(*Bs)[68] = (float(*)[68])(sm + 16 * 68);
    float(*Bs2)[68] = (float(*)[68])(sm + 2 * 16 * 68);
    const int tid = threadIdx.x, ty = tid >> 4, tx = tid & 15;
    float acc[4][4], acc2[4][4];
    for (int i = 0; i < 4; ++i) for (int j = 0; j < 4; ++j) { acc[i][j] = 0.f; acc2[i][j] = 0.f; }
    const int ar = tid >> 2, ak = (tid & 3) * 4;
    const int bk = tid >> 4, bc = (tid & 15) * 4;
    for (int k0 = 0; k0 < K; k0 += 16) {
        for (int q = 0; q < 4; ++q) As[ak + q][ar] = aload(m0 + ar, k0 + ak + q);
        for (int q = 0; q < 4; ++q) Bs[bk][bc + q] = bload(k0 + bk, n0 + bc + q);
        if (DUAL) for (int q = 0; q < 4; ++q) Bs2[bk][bc + q] = bload2(k0 + bk, n0 + bc + q);
        __syncthreads();
        for (int k = 0; k < 16; ++k) {
            float a[4], b[4];
            for (int i = 0; i < 4; ++i) a[i] = As[k][ty * 4 + i];
            for (int j = 0; j < 4; ++j) b[j] = Bs[k][tx * 4 + j];
            for (int i = 0; i < 4; ++i) for (int j = 0; j < 4; ++j) acc[i][j] += a[i] * b[j];
            if (DUAL) {
                for (int j = 0; j < 4; ++j) b[j] = Bs2[k][tx * 4 + j];
                for (int i = 0; i < 4; ++i) for (int j = 0; j < 4; ++j) acc2[i][j] += a[i] * b[j];
            }
        }
        __syncthreads();
    }
    for (int i = 0; i < 4; ++i) for (int j = 0; j < 4; ++j) epi(m0 + ty * 4 + i, n0 + tx * 4 + j, acc[i][j], acc2[i][j]);
}

enum { G_PROJ, G_GLU, G_OUT, G_FFN1, G_FFN2, G_MFFN1, G_MFFN2 };

template <int MODE>
__device__ void st_gemm(const Params& p, int l, int pass) {
    const bool last = (l == DEPTH - 1);
    const int j = l / 2;
    int M, N, K;
    if (MODE == G_PROJ) { M = NTOK; N = DPROJ; K = DM; }
    else if (MODE == G_GLU) { M = last ? NLAT : NTOK; N = 256; K = 256; }
    else if (MODE == G_OUT) { M = last ? NLAT : NTOK; N = DM; K = DM; }
    else if (MODE == G_FFN1) { M = NTOK; N = DFF; K = DM; }
    else if (MODE == G_FFN2) { M = NTOK; N = DM; K = DFF; }
    else if (MODE == G_MFFN1) { M = MOE_R; N = DFF; K = DM; }
    else { M = MOE_R; N = DM; K = DFF; }
    const int ntm = M / 64, ntn = (N + 63) / 64;
    int pstart[NEXP], pend[NEXP];
    if (MODE == G_MFFN1 || MODE == G_MFFN2) moe_offsets(p, pstart, pend);
    for (int tile = blockIdx.x; tile < ntm * ntn; tile += gridDim.x) {
        const int tm = tile / ntn, tn = tile % ntn;
        const int m0 = tm * 64, n0 = tn * 64;
        auto nob = [](int, int) { return 0.f; };
        if (MODE == G_PROJ) {
            const float* W = p.in[I_W_IN] + (long)l * DM * DPROJ;
            gemm_tile64<false>(m0, n0, K,
                [&](int r, int k) { return a2f(p.u[(long)r * DM + k]); },
                [&](int k, int c) { return c < DPROJ ? W[(long)k * DPROJ + c] : 0.f; }, nob,
                [&](int r, int c, float a, float) { if (c < DPROJ) p.proj[(long)r * DPROJ + c] = f2a(a); });
        } else if (MODE == G_GLU) {
            const float* W = p.in[I_S5_GLU_W] + (long)l * 256 * 256;
            const float* g = p.osum + (long)2 * NTOK * 256;
            gemm_tile64<false>(m0, n0, K,
                [&](int r, int k) { return g[(long)r * 256 + k]; },
                [&](int k, int c) { return W[k * 256 + c]; }, nob,
                [&](int r, int c, float a, float) {
                    float gv = g[(long)r * 256 + c];
                    p.mix[(long)r * DM + 512 + c] = f2a(gv * sigmoid_f(a + p.in[I_S5_GLU_B][l * 256 + c]));
                });
        } else if (MODE == G_OUT) {
            const float* W = p.in[I_W_OUT] + (long)l * DM * DM;
            gemm_tile64<false>(m0, n0, K,
                [&](int r, int k) { return a2f(p.mix[(long)r * DM + k]); },
                [&](int k, int c) { return W[(long)k * DM + c]; }, nob,
                [&](int r, int c, float a, float) { p.y[(long)r * DM + c] = f2a(a); });
        } else if (MODE == G_FFN1) {
            const float* W1 = p.in[I_FFN_W1] + (long)j * DM * DFF;
            const float* W3 = p.in[I_FFN_W3] + (long)j * DM * DFF;
            gemm_tile64<true>(m0, n0, K,
                [&](int r, int k) { return a2f(p.u[(long)r * DM + k]); },
                [&](int k, int c) { return W1[(long)k * DFF + c]; },
                [&](int k, int c) { return W3[(long)k * DFF + c]; },
                [&](int r, int c, float a, float b) { p.proj[(long)r * DFF + c] = f2a(silu_f(a) * b); });
        } else if (MODE == G_FFN2) {
            const float* W = p.in[I_FFN_W2] + (long)j * DFF * DM;
            gemm_tile64<false>(m0, n0, K,
                [&](int r, int k) { return a2f(p.proj[(long)r * DFF + k]); },
                [&](int k, int c) { return W[(long)k * DM + c]; }, nob,
                [&](int r, int c, float a, float) { p.y[(long)r * DM + c] = f2a(a); });
        } else {
            const int slot0 = pass * MOE_R + m0;
            if (slot0 >= pend[NEXP - 1]) continue;
            int e = 0;
            while (slot0 >= pend[e]) ++e;
            if (MODE == G_MFFN1) {
                const float* W1 = p.in[I_MOE_W1] + ((long)j * NEXP + e) * DM * DFF;
                const float* W3 = p.in[I_MOE_W3] + ((long)j * NEXP + e) * DM * DFF;
                gemm_tile64<true>(m0, n0, K,
                    [&](int r, int k) { int a = p.slot_asg[pass * MOE_R + r]; return a >= 0 ? a2f(p.u[(long)(a >> 1) * DM + k]) : 0.f; },
                    [&](int k, int c) { return W1[(long)k * DFF + c]; },
                    [&](int k, int c) { return W3[(long)k * DFF + c]; },
                    [&](int r, int c, float a, float b) { p.proj[(long)r * DFF + c] = f2a(silu_f(a) * b); });
            } else {
                const float* W = p.in[I_MOE_W2] + ((long)j * NEXP + e) * DFF * DM;
                gemm_tile64<false>(m0, n0, K,
                    [&](int r, int k) { return a2f(p.proj[(long)r * DFF + k]); },
                    [&](int k, int c) { return W[(long)k * DM + c]; }, nob,
                    [&](int r, int c, float a, float) {
                        int as = p.slot_asg[pass * MOE_R + r];
                        if (as >= 0) p.ys[(long)as * DM + c] = f2a(p.tok_g[as] * a);
                    });
            }
        }
    }
}

__device__ void st_rotary(const Params& p) {
    for (long it = (long)blockIdx.x * 256 + threadIdx.x; it < (long)NLAT * 256; it += (long)gridDim.x * 256) {
        int row = it >> 8, r = it & 255;
        int which = r >> 7, h = (r >> 5) & 3, f = r & 31;
        int t = row % SEQ;
        float cs = p.rot[(t * 32 + f) * 2], sn = p.rot[(t * 32 + f) * 2 + 1];
        act_t* base = p.proj + (long)row * DPROJ + (which ? O_RK : O_RQ) + h * 64;
        float t1 = a2f(base[f]), t2 = a2f(base[f + 32]);
        base[f] = f2a(t1 * cs - t2 * sn);
        base[f + 32] = f2a(t1 * sn + t2 * cs);
    }
}
__device__ void st_gla_gate(const Params& p, int l) {
    for (long it = (long)blockIdx.x * 256 + threadIdx.x; it < (long)2 * NTOK * 128; it += (long)gridDim.x * 256) {
        int jj = it & 127;
        int row = (it >> 7) % NTOK;
        int dir = it / ((long)NTOK * 128);
        const float* wa = p.in[I_GLA_WA] + ((long)(l * 2 + dir) * 16) * 128;
        float g = p.in[I_GLA_BA][(l * 2 + dir) * 128 + jj];
        const act_t* a = p.proj + (long)row * DPROJ + O_GA + dir * 16;
        for (int i = 0; i < 16; ++i) g += a2f(a[i]) * wa[i * 128 + jj];
        p.loga[it] = log_sigmoid_f(g) * (1.0f / 16.0f);
    }
}
__device__ __forceinline__ float hy_short(const Params& p, int l, int row, int c) {
    const bool lat = row < NLAT;
    const int n = lat ? SEQ : CTXL;
    const int t = lat ? row % SEQ : (row - NLAT) % CTXL;
    const float* cw = p.in[I_HY_CONV_W] + (long)l * 3 * 768;
    float s = p.in[I_HY_CONV_B][l * 768 + c];
    for (int jj = 0; jj < 3; ++jj) {
        int tt = t + jj - 1;
        if (tt >= 0 && tt < n) s += a2f(p.proj[(long)(row + jj - 1) * DPROJ + O_HP + c]) * cw[jj * 768 + c];
    }
    return s;
}
__device__ void st_hy_pre(const Params& p, int l) {
    const int nrows = (l == DEPTH - 1) ? NLAT : NTOK;
    for (long it = (long)blockIdx.x * 256 + threadIdx.x; it < (long)nrows * 256; it += (long)gridDim.x * 256) {
        int row = it >> 8, ch = it & 255;
        p.hz[it] = hy_short(p, l, row, 256 + ch) * hy_short(p, l, row, 512 + ch);
    }
}
__device__ void st_hy_conv(const Params& p, int l) {
    const int nrows = (l == DEPTH - 1) ? NLAT : NTOK;
    for (long it = (long)blockIdx.x * 256 + threadIdx.x; it < (long)nrows * 256; it += (long)gridDim.x * 256) {
        int row = it >> 8, ch = it & 255;
        const bool lat = row < NLAT;
        const int n = lat ? SEQ : CTXL;
        const int t = lat ? row % SEQ : (row - NLAT) % CTXL;
        const int rbase = row - t;
        const float* circ = p.filt + (long)l * FILT_LAYER_FLOATS + (lat ? 0 : 2 * SEQ * 256);
        float acc = 0.f;
        for (int s = 0; s < n; ++s) {
            int idx = t - s; if (idx < 0) idx += 2 * n;
            acc += circ[(long)idx * 256 + ch] * p.hz[(long)(rbase + s) * 256 + ch];
        }
        float yv = acc * p.fnorm[(l * 2 + (lat ? 0 : 1)) * 256 + ch];
        float z = p.hz[it];
        float x0 = hy_short(p, l, row, ch);
        p.mix[(long)row * DM + 768 + ch] = f2a(x0 * (yv + z * p.in[I_HY_BIAS][l * 256 + ch]));
    }
}

__device__ void st_scan_ret(const Params& p, int l) {
    const bool need_ctx = (l != DEPTH - 1);
    for (int it = blockIdx.x * 256 + threadIdx.x; it < BATCH * 256; it += gridDim.x * 256) {
        const int b = it >> 8, h = (it >> 6) & 3, e = it & 63;
        float* os = p.osum;
        for (int dir = 0; dir < 2; ++dir) {
            float dec = p.in[I_RET_DECAY][(l * 2 + dir) * 4 + h];
            float g = expf(log_sigmoid_f(dec));
            float S[64];
            for (int d = 0; d < 64; ++d) S[d] = 0.f;
            for (int step = 0; step < CTXL + SEQ; ++step) {
                const bool isctx = step < CTXL;
                int row;
                if (isctx) { int t = dir ? CTXL - 1 - step : step; row = NLAT + b * CTXL + t; }
                else { int s2 = step - CTXL; int t = dir ? SEQ - 1 - s2 : s2; row = b * SEQ + t; }
                const act_t* pr = p.proj + (long)row * DPROJ;
                float v = a2f(pr[O_RV + h * 64 + e]);
                float o = 0.f;
                for (int d = 0; d < 64; ++d) {
                    float k = a2f(pr[O_RK + h * 64 + d]) * 0.125f;
                    float q = a2f(pr[O_RQ + h * 64 + d]);
                    S[d] = g * S[d] + k * v;
                    o += q * S[d];
                }
                if (!isctx || need_ctx) {
                    float* dst = os + (long)row * 256 + h * 64 + e;
                    if (dir == 0) *dst = o; else *dst += o;
                }
            }
        }
    }
}
__device__ void st_scan_gla(const Params& p, int l) {
    const bool need_ctx = (l != DEPTH - 1);
    const float qscale = 0.17677669529663687f;
    for (int it = blockIdx.x * 256 + threadIdx.x; it < BATCH * 256; it += gridDim.x * 256) {
        const int b = it >> 8, h = (it >> 6) & 3, e = it & 63;
        float* os = p.osum + (long)NTOK * 256;
        for (int dir = 0; dir < 2; ++dir) {
            float S[32];
            for (int d = 0; d < 32; ++d) S[d] = 0.f;
            for (int step = 0; step < CTXL + SEQ; ++step) {
                const bool isctx = step < CTXL;
                int row;
                if (isctx) { int t = dir ? CTXL - 1 - step : step; row = NLAT + b * CTXL + t; }
                else { int s2 = step - CTXL; int t = dir ? SEQ - 1 - s2 : s2; row = b * SEQ + t; }
                const act_t* pr = p.proj + (long)row * DPROJ;
                const float* la = p.loga + ((long)dir * NTOK + row) * 128 + h * 32;
                float v = a2f(pr[O_GV + h * 64 + e]);
                float o = 0.f;
                for (int d = 0; d < 32; ++d) {
                    float k = a2f(pr[O_GK + h * 32 + d]);
                    float q = a2f(pr[O_GQ + h * 32 + d]) * qscale;
                    S[d] = expf(la[d]) * S[d] + k * v;
                    o += q * S[d];
                }
                if (!isctx || need_ctx) {
                    float* dst = os + (long)row * 256 + h * 64 + e;
                    if (dir == 0) *dst = o; else *dst += o;
                }
            }
        }
    }
}
__device__ void st_scan_s5(const Params& p, int l) {
    const bool need_ctx = (l != DEPTH - 1);
    float* sh = smem_base();
    const int tid = threadIdx.x, gl = tid >> 6, n = tid & 63;
    float* hsh = sh + gl * 128;
    float* os = p.osum + (long)2 * NTOK * 256;
    for (int blk = blockIdx.x; blk < BATCH * 4; blk += gridDim.x) {
        const int b = blk >> 2, g = (blk & 3) * 4 + gl;
        for (int dir = 0; dir < 2; ++dir) {
            const int pg = (l * 2 + dir) * 16 + g;
            double lre = p.in[I_S5_LAM_RE][pg * 64 + n], lim = p.in[I_S5_LAM_IM][pg * 64 + n];
            double dt = exp((double)p.in[I_S5_LOG_DT][pg]);
            double mag = exp(lre * dt);
            double lbr = mag * cos(lim * dt), lbi = mag * sin(lim * dt);
            double den = lre * lre + lim * lim;
            double cr = ((lbr - 1.0) * lre + lbi * lim) / den;
            double ci = (lbi * lre - (lbr - 1.0) * lim) / den;
            float bbr[16], bbi[16];
            for (int q = 0; q < 16; ++q) {
                double br = p.in[I_S5_B_RE][((long)pg * 64 + n) * 16 + q], bi = p.in[I_S5_B_IM][((long)pg * 64 + n) * 16 + q];
                bbr[q] = (float)(cr * br - ci * bi);
                bbi[q] = (float)(cr * bi + ci * br);
            }
            const float flr = (float)lbr, fli = (float)lbi;
            const float* cre = p.in[I_S5_C_RE] + ((long)pg * 16 + (n & 15)) * 64;
            const float* cim = p.in[I_S5_C_IM] + ((long)pg * 16 + (n & 15)) * 64;
            float hr = 0.f, hi = 0.f;
            for (int step = 0; step < CTXL + SEQ; ++step) {
                const bool isctx = step < CTXL;
                int row;
                if (isctx) { int t = dir ? CTXL - 1 - step : step; row = NLAT + b * CTXL + t; }
                else { int s2 = step - CTXL; int t = dir ? SEQ - 1 - s2 : s2; row = b * SEQ + t; }
                const act_t* uu = p.proj + (long)row * DPROJ + O_SU + g * 16;
                float br = 0.f, bi = 0.f;
                for (int q = 0; q < 16; ++q) { float uv = a2f(uu[q]); br += bbr[q] * uv; bi += bbi[q] * uv; }
                float nr = flr * hr - fli * hi + br;
                float ni = flr * hi + fli * hr + bi;
                hr = nr; hi = ni;
                hsh[n] = hr; hsh[64 + n] = hi;
                __syncthreads();
                if (n < 16 && (!isctx || need_ctx)) {
                    float yv = 0.f;
                    for (int m = 0; m < 64; ++m) yv += cre[m] * hsh[m] - cim[m] * hsh[64 + m];
                    float* dst = os + (long)row * 256 + g * 16 + n;
                    if (dir == 0) *dst = yv; else *dst += yv;
                }
                __syncthreads();
            }
        }
    }
}
__device__ void st_finish(const Params& p, int l) {
    const int tid = threadIdx.x, wave = tid >> 6, lane = tid & 63;
    const int nrows = (l == DEPTH - 1) ? NLAT : NTOK;
    for (int base = blockIdx.x * 4; base < nrows; base += gridDim.x * 4) {
        const int row = base + wave;
        const act_t* pr = p.proj + (long)row * DPROJ;
        for (int h = 0; h < 4; ++h) {
            int c = h * 64 + lane;
            float o = p.osum[(long)row * 256 + c];
            float mu = wave_sum(o) * (1.0f / 64.0f);
            float d = o - mu;
            float var = wave_sum(d * d) * (1.0f / 64.0f);
            float yv = d * (1.0f / sqrtf(var + LN_EPS)) * p.in[I_RET_GN_G][l * 256 + c] + p.in[I_RET_GN_B][l * 256 + c];
            p.mix[(long)row * DM + c] = f2a(yv * silu_f(a2f(pr[O_RG + c])));
        }
        for (int h = 0; h < 4; ++h) {
            int c = h * 64 + lane;
            float o = p.osum[((long)NTOK + row) * 256 + c];
            float ms = wave_sum(o * o) * (1.0f / 64.0f);
            float yv = o * (1.0f / sqrtf(ms + LN_EPS)) * p.in[I_GLA_NORM_G][l * 256 + c];
            p.mix[(long)row * DM + 256 + c] = f2a(yv * silu_f(a2f(pr[O_GR + c])));
        }
        for (int h = 0; h < 4; ++h) {
            int c = h * 64 + lane;
            float* yp = p.osum + ((long)2 * NTOK + row) * 256 + c;
            float yv = *yp + p.in[I_S5_D][l * 256 + c] * a2f(pr[O_SU + c]);
            *yp = gelu_tanh_f(yv);
        }
    }
}

#ifdef EMU
#define GRID_SYNC()
#else
#define GRID_SYNC() grid.sync()
#endif

#define STAGE_KERNEL(name, call) \
    __global__ void __launch_bounds__(256) name(Params p, int l, int a) { call; }
STAGE_KERNEL(k_prep, st_prep(p))
STAGE_KERNEL(k_prep2, st_prep2(p))
STAGE_KERNEL(k_ln, st_ln(p, l, a))
STAGE_KERNEL(k_router, st_router(p, l))
STAGE_KERNEL(k_place, st_place(p))
STAGE_KERNEL(k_g_proj, st_gemm<G_PROJ>(p, l, a))
STAGE_KERNEL(k_g_glu, st_gemm<G_GLU>(p, l, a))
STAGE_KERNEL(k_g_out, st_gemm<G_OUT>(p, l, a))
STAGE_KERNEL(k_g_ffn1, st_gemm<G_FFN1>(p, l, a))
STAGE_KERNEL(k_g_ffn2, st_gemm<G_FFN2>(p, l, a))
STAGE_KERNEL(k_g_mffn1, st_gemm<G_MFFN1>(p, l, a))
STAGE_KERNEL(k_g_mffn2, st_gemm<G_MFFN2>(p, l, a))
STAGE_KERNEL(k_rotary, st_rotary(p))
STAGE_KERNEL(k_gla_gate, st_gla_gate(p, l))
STAGE_KERNEL(k_hy_pre, st_hy_pre(p, l))
STAGE_KERNEL(k_hy_conv, st_hy_conv(p, l))
STAGE_KERNEL(k_scan_ret, st_scan_ret(p, l))
STAGE_KERNEL(k_scan_gla, st_scan_gla(p, l))
STAGE_KERNEL(k_scan_s5, st_scan_s5(p, l))
STAGE_KERNEL(k_finish, st_finish(p, l))

#ifdef EMU
#define LAUNCH(k, grid, l, a) emu_launch(grid, 256, [&]() { k(p, l, a); })
#else
#define LAUNCH(k, grid, l, a) hipLaunchKernelGGL(k, dim3(grid), dim3(256), 0, stream, p, l, a)
#endif

static inline size_t align_up(size_t v, size_t a) { return (v + a - 1) / a * a; }

#ifdef EMU
Params g_dbg_params;
#endif

extern "C" void kernel_launch(void* const* d_in, const int* in_sizes, int n_in, void* d_out, int out_size, void* d_ws,
                              size_t ws_size, hipStream_t stream) {
    Params p{};
    for (int i = 0; i < N_IN; ++i) p.in[i] = (const float*)d_in[i];
    p.out = (float*)d_out;
    char* ws = (char*)d_ws;
    size_t off = 0;
    auto take = [&](size_t bytes) { char* r = ws + off; off = align_up(off + bytes, 256); return r; };
    p.proj = (act_t*)take((size_t)NTOK * DPROJ * sizeof(act_t));
    p.u = (act_t*)take((size_t)NTOK * DM * sizeof(act_t));
    p.y = (act_t*)take((size_t)NTOK * DM * sizeof(act_t));
    p.mix = (act_t*)take((size_t)NTOK * DM * sizeof(act_t));
    p.osum = (float*)p.u;
    p.ys = (act_t*)p.y;
    p.mod = (float*)take((size_t)DEPTH * (BATCH + 1) * 6 * DM * 4);
    p.hctx = (float*)take((size_t)NCTX * DM * 4);
    p.loga = (float*)take((size_t)2 * NTOK * 128 * 4);
    p.hz = (float*)take((size_t)NTOK * 256 * 4);
    p.filt = (float*)take((size_t)DEPTH * FILT_LAYER_FLOATS * 4);
    p.fnorm = (float*)take((size_t)DEPTH * 2 * 256 * 4);
    p.rot = (float*)take((size_t)SEQ * 32 * 2 * 4);
    p.moe_cnt = (int*)take(16 * 4);
    p.tok_e = (int*)take((size_t)NLAT * 2 * 4);
    p.tok_g = (float*)take((size_t)NLAT * 2 * 4);
    p.slot_asg = (int*)take((size_t)MOE_CAP * 4);
#ifdef EMU
    g_dbg_params = p;
#endif

#ifdef EMU
    const int G = 64;
#else
    const int G = 2048;
#endif
    LAUNCH(k_prep, G, 0, 0);
    LAUNCH(k_prep2, G, 0, 0);
    LAUNCH(k_ln, G, 0, 0);
    for (int l = 0; l < DEPTH; ++l) {
        LAUNCH(k_g_proj, G, l, 0);
        LAUNCH(k_rotary, G, l, 0);
        LAUNCH(k_gla_gate, G, l, 0);
        LAUNCH(k_hy_pre, G, l, 0);
        LAUNCH(k_scan_ret, BATCH, l, 0);
        LAUNCH(k_scan_gla, BATCH, l, 0);
        LAUNCH(k_scan_s5, BATCH * 4, l, 0);
        LAUNCH(k_finish, G, l, 0);
        LAUNCH(k_hy_conv, G, l, 0);
        LAUNCH(k_g_glu, G, l, 0);
        LAUNCH(k_g_out, G, l, 0);
        LAUNCH(k_ln, G, l, 1);
        if ((l & 1) == 0) {
            LAUNCH(k_g_ffn1, G, l, 0);
            LAUNCH(k_g_ffn2, G, l, 0);
        } else {
            LAUNCH(k_router, G, l, 0);
            LAUNCH(k_place, G, l, 0);
            for (int ps = 0; ps < MOE_PASSES; ++ps) {
                LAUNCH(k_g_mffn1, G, l, ps);
                LAUNCH(k_g_mffn2, G, l, ps);
            }
        }
        LAUNCH(k_ln, G, l, 2);
    }
}
```

```cpp
#ifndef EMU
#include <hip/hip_runtime.h>
#include <hip/hip_cooperative_groups.h>
#endif
#include <stdint.h>
#include <math.h>

#ifndef BATCH
#define BATCH 8
#endif
#ifndef SEQ
#define SEQ 4096
#endif
#ifndef CTXL
#define CTXL 256
#endif
#define DM 1024
#define DEPTH 2
#define GRID_W 64
#define DPROJ 2848
#define DFF 2816
#define NEXP 8
#define NLAT (BATCH * SEQ)
#define NCTX (BATCH * CTXL)
#define NTOK (NLAT + NCTX)
#define MOE_CAP (2 * NLAT + NEXP * 256)
#define MOE_PASSES 4
#define MOE_R (MOE_CAP / MOE_PASSES)
#define LN_EPS 1e-5f
#define ALPHA 1.4142135623730951f
#define O_RQ 0
#define O_RK 256
#define O_RV 512
#define O_RG 768
#define O_GQ 1024
#define O_GK 1152
#define O_GV 1280
#define O_GR 1536
#define O_GA 1792
#define O_SU 1824
#define O_HP 2080

enum { I_X, I_C, I_CTX, I_CCTX, I_ADA_W, I_ADA_B, I_W_IN, I_RET_DECAY, I_RET_GN_G, I_RET_GN_B, I_GLA_WA, I_GLA_BA,
       I_GLA_NORM_G, I_S5_LAM_RE, I_S5_LAM_IM, I_S5_LOG_DT, I_S5_B_RE, I_S5_B_IM, I_S5_C_RE, I_S5_C_IM, I_S5_D,
       I_S5_GLU_W, I_S5_GLU_B, I_HY_CONV_W, I_HY_CONV_B, I_HY_FW1, I_HY_FB1, I_HY_FREQ, I_HY_FW2, I_HY_FB2, I_HY_FW3,
       I_HY_DECAY, I_HY_BIAS, I_W_OUT, I_LN_MIX_G, I_LN_MIX_B, I_LN_FFN_G, I_LN_FFN_B, I_FFN_W1, I_FFN_W3, I_FFN_W2,
       I_ROUTER_W, I_ROUTER_B, I_MOE_W1, I_MOE_W3, I_MOE_W2, N_IN };

#ifdef EMU_F32ACT
typedef float act_t;
__device__ __forceinline__ float a2f(act_t v) { return v; }
__device__ __forceinline__ act_t f2a(float f) { return f; }
#else
typedef unsigned short act_t;
__device__ __forceinline__ float a2f(act_t v) { union { unsigned u; float f; } c; c.u = ((unsigned)v) << 16; return c.f; }
__device__ __forceinline__ act_t f2a(float f) { union { unsigned u; float f; } c; c.f = f; unsigned u = c.u; u += 0x7fffu + ((u >> 16) & 1u); return (act_t)(u >> 16); }
#endif

struct Params {
    const float* in[N_IN];
    float* out;
    float* mod;
    act_t* proj;
    act_t* u;
    act_t* y;
    act_t* mix;
    float* osum;
    act_t* ys;
    float* hctx;
    float* loga;
    float* hz;
    float* filt;
    float* fnorm;
    float* rot;
    int* moe_cnt;
    int* tok_e;
    float* tok_g;
    int* slot_asg;
};

#define FILT_LAYER_FLOATS ((2 * SEQ + 2 * CTXL) * 256)

__device__ __forceinline__ float* smem_base() {
    __shared__ float smem[3 * 16 * 68 + 64];
    return smem;
}
__device__ __forceinline__ float wave_sum(float v) {
    for (int o = 32; o > 0; o >>= 1) v += __shfl_xor(v, o);
    return v;
}
__device__ __forceinline__ float silu_f(float x) { return x / (1.0f + expf(-x)); }
__device__ __forceinline__ float sigmoid_f(float x) { return 1.0f / (1.0f + expf(-x)); }
__device__ __forceinline__ float log_sigmoid_f(float x) { return fminf(x, 0.0f) - log1pf(expf(-fabsf(x))); }
__device__ __forceinline__ float gelu_tanh_f(float x) {
    return 0.5f * x * (1.0f + tanhf(0.7978845608028654f * (x + 0.044715f * x * x * x)));
}
__device__ __forceinline__ void ln_stats16(const float* v, float& mu, float& rstd) {
    float s = 0.f;
    for (int i = 0; i < 16; ++i) s += v[i];
    s = wave_sum(s);
    mu = s * (1.0f / DM);
    float q = 0.f;
    for (int i = 0; i < 16; ++i) { float d = v[i] - mu; q += d * d; }
    q = wave_sum(q);
    rstd = 1.0f / sqrtf(q * (1.0f / DM) + LN_EPS);
}
__device__ __forceinline__ int row_modidx(int row) { return row < NLAT ? row / SEQ : BATCH; }

__device__ void st_prep(const Params& p) {
    const int tid = threadIdx.x, nb = gridDim.x, bid = blockIdx.x;
    for (long it = (long)bid * 256 + tid; it < (long)DEPTH * (BATCH + 1) * 6 * DM; it += (long)nb * 256) {
        int col = it % (6 * DM);
        int bb = (it / (6 * DM)) % (BATCH + 1);
        int l = it / (6 * DM * (BATCH + 1));
        const float* cv = bb < BATCH ? p.in[I_C] + bb * DM : p.in[I_CCTX];
        const float* w = p.in[I_ADA_W] + (long)l * DM * 6 * DM + col;
        float acc = p.in[I_ADA_B][l * 6 * DM + col];
        for (int k = 0; k < DM; ++k) acc += silu_f(cv[k]) * w[(long)k * 6 * DM];
        p.mod[it] = acc;
    }
    for (int it = bid * 256 + tid; it < SEQ * 32; it += nb * 256) {
        int t = it / 32, f = it % 32;
        double pos = f < 16 ? (double)(t / GRID_W) : (double)(t % GRID_W);
        double inv = pow(10000.0, -(double)(f & 15) / 16.0);
        double ang = pos * inv;
        p.rot[it * 2] = (float)cos(ang);
        p.rot[it * 2 + 1] = (float)sin(ang);
    }
    if (bid == 0 && tid < 16) p.moe_cnt[tid] = 0;
    {
        double* sh = (double*)smem_base();
        const int wave = tid >> 6, lane = tid & 63;
        double* h1 = sh + wave * 128;
        double* h2 = h1 + 64;
        const int per_layer = SEQ + CTXL;
        for (int base = bid * 4; base < DEPTH * per_layer; base += nb * 4) {
            int it = base + wave;
            int l = it / per_layer;
            int r = it % per_layer;
            int which = r < SEQ ? 0 : 1;
            int n = which ? CTXL : SEQ;
            int t = which ? r - SEQ : r;
            float* circ = p.filt + (long)l * FILT_LAYER_FLOATS + (which ? 2 * SEQ * 256 : 0);
            double tn = (double)t / (double)(n - 1);
            const float* fw1 = p.in[I_HY_FW1] + l * 33 * 64;
            const float* fw2 = p.in[I_HY_FW2] + l * 64 * 64;
            const float* fw3 = p.in[I_HY_FW3] + l * 64 * 512;
            double fr = p.in[I_HY_FREQ][l * 64 + lane];
            double a = (double)p.in[I_HY_FB1][l * 64 + lane] + tn * fw1[lane];
            for (int k = 0; k < 16; ++k) {
                double band = 1e-4 + (double)k * ((15.0 - 1e-4) / 15.0);
                double ang = (2.0 * M_PI / (double)n) * band * (double)t;
                a += cos(ang) * fw1[(1 + k) * 64 + lane];
                a += -sin(ang) * fw1[(17 + k) * 64 + lane];
            }
            h1[lane] = sin(fr * a);
            __syncthreads();
            double a2 = p.in[I_HY_FB2][l * 64 + lane];
            for (int i = 0; i < 64; ++i) a2 += h1[i] * fw2[i * 64 + lane];
            h2[lane] = sin(fr * a2);
            __syncthreads();
            for (int cc = 0; cc < 8; ++cc) {
                int c = cc * 64 + lane;
                double f = 0.0;
                for (int i = 0; i < 64; ++i) f += h2[i] * fw3[i * 512 + c];
                int w = c >> 8, ch = c & 255;
                double dec = fabs((double)p.in[I_HY_DECAY][(l * 2 + w) * 256 + ch]);
                f *= exp(-tn * dec);
                if (w == 0) circ[(long)t * 256 + ch] = (float)f;
                else if (t >= 1) circ[(long)(2 * n - t) * 256 + ch] = (float)f;
                if (t == 0 && w == 1) circ[(long)n * 256 + ch] = 0.0f;
            }
            __syncthreads();
        }
    }
}

__device__ void st_prep2(const Params& p) {
    const int tid = threadIdx.x, wave = tid >> 6, lane = tid & 63;
    for (int base = blockIdx.x * 4; base < DEPTH * 2 * 256; base += gridDim.x * 4) {
        int it = base + wave;
        int ch = it & 255, which = (it >> 8) & 1, l = it >> 9;
        int n = which ? CTXL : SEQ;
        const float* circ = p.filt + (long)l * FILT_LAYER_FLOATS + (which ? 2 * SEQ * 256 : 0);
        double s = 0.0;
        for (int i = lane; i < 2 * n; i += 64) s += fabs((double)circ[(long)i * 256 + ch]);
        float hi = (float)s, lo = (float)(s - (double)hi);
        hi = wave_sum(hi); lo = wave_sum(lo);
        if (lane == 0) p.fnorm[it] = (float)(1.0 / ((double)hi + (double)lo));
    }
}

__device__ void st_ln(const Params& p, int l, int mode) {
    const int tid = threadIdx.x, wave = tid >> 6, lane = tid & 63;
    const bool last = (l == DEPTH - 1);
    const int nrows = (mode == 0) ? NTOK : (last ? NLAT : NTOK);
    const bool moe = (l & 1);
    for (int base = blockIdx.x * 4; base < nrows; base += gridDim.x * 4) {
        const int row = base + wave;
        const bool lat = row < NLAT;
        const float* modp = p.mod + ((long)l * (BATCH + 1) + row_modidx(row)) * 6 * DM;
        float v[16];
        float mu, rstd;
        if (mode == 0) {
            const float* src = lat ? p.in[I_X] + (long)row * DM : p.in[I_CTX] + (long)(row - NLAT) * DM;
            for (int i = 0; i < 16; ++i) v[i] = src[i * 64 + lane];
            ln_stats16(v, mu, rstd);
            for (int i = 0; i < 16; ++i) {
                int c = i * 64 + lane;
                p.u[(long)row * DM + c] = f2a((v[i] - mu) * rstd * (1.0f + modp[DM + c]) + modp[c]);
            }
        } else if (mode == 1) {
            const float* src = lat ? ((l == 0 ? p.in[I_X] : p.out) + (long)row * DM)
                                   : ((l == 0 ? p.in[I_CTX] : p.hctx) + (long)(row - NLAT) * DM);
            float* dst = lat ? p.out + (long)row * DM : p.hctx + (long)(row - NLAT) * DM;
            for (int i = 0; i < 16; ++i) {
                int c = i * 64 + lane;
                v[i] = ALPHA * src[c] + modp[2 * DM + c] * a2f(p.y[(long)row * DM + c]);
            }
            ln_stats16(v, mu, rstd);
            for (int i = 0; i < 16; ++i) {
                int c = i * 64 + lane;
                v[i] = (v[i] - mu) * rstd * p.in[I_LN_MIX_G][l * DM + c] + p.in[I_LN_MIX_B][l * DM + c];
                dst[c] = v[i];
            }
            ln_stats16(v, mu, rstd);
            for (int i = 0; i < 16; ++i) {
                int c = i * 64 + lane;
                p.u[(long)row * DM + c] = f2a((v[i] - mu) * rstd * (1.0f + modp[4 * DM + c]) + modp[3 * DM + c]);
            }
        } else {
            float* dst = lat ? p.out + (long)row * DM : p.hctx + (long)(row - NLAT) * DM;
            for (int i = 0; i < 16; ++i) {
                int c = i * 64 + lane;
                float f = moe ? (a2f(p.ys[(long)(row * 2) * DM + c]) + a2f(p.ys[(long)(row * 2 + 1) * DM + c]))
                              : a2f(p.y[(long)row * DM + c]);
                v[i] = ALPHA * dst[c] + modp[5 * DM + c] * f;
            }
            ln_stats16(v, mu, rstd);
            for (int i = 0; i < 16; ++i) {
                int c = i * 64 + lane;
                v[i] = (v[i] - mu) * rstd * p.in[I_LN_FFN_G][l * DM + c] + p.in[I_LN_FFN_B][l * DM + c];
                dst[c] = v[i];
            }
            if (l + 1 < DEPTH) {
                const float* modn = p.mod + ((long)(l + 1) * (BATCH + 1) + row_modidx(row)) * 6 * DM;
                ln_stats16(v, mu, rstd);
                for (int i = 0; i < 16; ++i) {
                    int c = i * 64 + lane;
                    p.u[(long)row * DM + c] = f2a((v[i] - mu) * rstd * (1.0f + modn[DM + c]) + modn[c]);
                }
            }
        }
    }
}

__device__ void st_router(const Params& p, int l) {
    const int tid = threadIdx.x, wave = tid >> 6, lane = tid & 63;
    const int j = l / 2;
    const float* rw = p.in[I_ROUTER_W] + (long)j * DM * NEXP;
    const float* rb = p.in[I_ROUTER_B] + j * NEXP;
    for (int i = blockIdx.x * 256 + tid; i < MOE_CAP; i += gridDim.x * 256) p.slot_asg[i] = -1;
    for (int base = blockIdx.x * 4; base < NLAT; base += gridDim.x * 4) {
        const int row = base + wave;
        const float* modp = p.mod + ((long)l * (BATCH + 1) + row_modidx(row)) * 6 * DM;
        float v[16], mu, rstd;
        for (int i = 0; i < 16; ++i) v[i] = p.out[(long)row * DM + i * 64 + lane];
        ln_stats16(v, mu, rstd);
        float lg[NEXP];
        for (int e = 0; e < NEXP; ++e) lg[e] = 0.f;
        for (int i = 0; i < 16; ++i) {
            int c = i * 64 + lane;
            float vv = (v[i] - mu) * rstd * (1.0f + modp[4 * DM + c]) + modp[3 * DM + c];
            for (int e = 0; e < NEXP; ++e) lg[e] += vv * rw[c * NEXP + e];
        }
        for (int e = 0; e < NEXP; ++e) lg[e] = wave_sum(lg[e]) + rb[e];
        if (lane == 0) {
            int e1 = 0;
            for (int e = 1; e < NEXP; ++e) if (lg[e] > lg[e1]) e1 = e;
            int e2 = (e1 == 0) ? 1 : 0;
            for (int e = 0; e < NEXP; ++e) if (e != e1 && lg[e] > lg[e2]) e2 = e;
            float ex = expf(lg[e2] - lg[e1]);
            float g1 = 1.0f / (1.0f + ex);
            p.tok_e[row * 2] = e1; p.tok_e[row * 2 + 1] = e2;
            p.tok_g[row * 2] = g1; p.tok_g[row * 2 + 1] = ex * g1;
            atomicAdd(&p.moe_cnt[e1], 1);
            atomicAdd(&p.moe_cnt[e2], 1);
        }
    }
}
__device__ __forceinline__ void moe_offsets(const Params& p, int* pstart, int* pend) {
    int acc = 0;
    for (int e = 0; e < NEXP; ++e) {
        int c = p.moe_cnt[e];
        pstart[e] = acc;
        acc += (c + 255) / 256 * 256;
        pend[e] = acc;
    }
}
__device__ void st_place(const Params& p) {
    int pstart[NEXP], pend[NEXP];
    moe_offsets(p, pstart, pend);
    for (int a = blockIdx.x * 256 + threadIdx.x; a < 2 * NLAT; a += gridDim.x * 256) {
        int e = p.tok_e[a];
        int pos = atomicAdd(&p.moe_cnt[8 + e], 1);
        p.slot_asg[pstart[e] + pos] = a;
    }
}

template <bool DUAL, class AL, class BL, class BL2, class EP>
__device__ __forceinline__ void gemm_tile64(int m0, int n0, int K, AL aload, BL bload, BL2 bload2, EP epi) {
    float* sm = smem_base();
    float(*As)[68] = (float(*)[68])sm;
    float(*Bs)[68] = (float(*)[68])(sm + 16 * 68);
    float(*Bs2)[68] = (float(*)[68])(sm + 2 * 16 * 68);
    const int tid = threadIdx.x, ty = tid >> 4, tx = tid & 15;
    float acc[4][4], acc2[4][4];
    for (int i = 0; i < 4; ++i) for (int j = 0; j < 4; ++j) { acc[i][j] = 0.f; acc2[i][j] = 0.f; }
    const int ar = tid >> 2, ak = (tid & 3) * 4;
    const int bk = tid >> 4, bc = (tid & 15) * 4;
    for (int k0 = 0; k0 < K; k0 += 16) {
        for (int q = 0; q < 4; ++q) As[ak + q][ar] = aload(m0 + ar, k0 + ak + q);
        for (int q = 0; q < 4; ++q) Bs[bk][bc + q] = bload(k0 + bk, n0 + bc + q);
        if (DUAL) for (int q = 0; q < 4; ++q) Bs2[bk][bc + q] = bload2(k0 + bk, n0 + bc + q);
        __syncthreads();
        for (int k = 0; k < 16; ++k) {
            float a[4], b[4];
            for (int i = 0; i < 4; ++i) a[i] = As[k][ty * 4 + i];
            for (int j = 0; j < 4; ++j) b[j] = Bs[k][tx * 4 + j];
            for (int i = 0; i < 4; ++i) for (int j = 0; j < 4; ++j) acc[i][j] += a[i] * b[j];
            if (DUAL) {
                for (int j = 0; j < 4; ++j) b[j] = Bs2[k][tx * 4 + j];
                for (int i = 0; i < 4; ++i) for (int j = 0; j < 4; ++j) acc2[i][j] += a[i] * b[j];
            }
        }
        __syncthreads();
    }
    for (int i = 0; i < 4; ++i) for (int j = 0; j < 4; ++j) epi(m0 + ty * 4 + i, n0 + tx * 4 + j, acc[i][j], acc2[i][j]);
}

enum { G_PROJ, G_GLU, G_OUT, G_FFN1, G_FFN2, G_MFFN1, G_MFFN2 };

template <int MODE>
__device__ void st_gemm(const Params& p, int l, int pass) {
    const bool last = (l == DEPTH - 1);
    const int j = l / 2;
    int M, N, K;
    if (MODE == G_PROJ) { M = NTOK; N = DPROJ; K = DM; }
    else if (MODE == G_GLU) { M = last ? NLAT : NTOK; N = 256; K = 256; }
    else if (MODE == G_OUT) { M = last ? NLAT : NTOK; N = DM; K = DM; }
    else if (MODE == G_FFN1) { M = NTOK; N = DFF; K = DM; }
    else if (MODE == G_FFN2) { M = NTOK; N = DM; K = DFF; }
    else if (MODE == G_MFFN1) { M = MOE_R; N = DFF; K = DM; }
    else { M = MOE_R; N = DM; K = DFF; }
    const int ntm = M / 64, ntn = (N + 63) / 64;
    int pstart[NEXP], pend[NEXP];
    if (MODE == G_MFFN1 || MODE == G_MFFN2) moe_offsets(p, pstart, pend);
    for (int tile = blockIdx.x; tile < ntm * ntn; tile += gridDim.x) {
        const int tm = tile / ntn, tn = tile % ntn;
        const int m0 = tm * 64, n0 = tn * 64;
        auto nob = [](int, int) { return 0.f; };
        if (MODE == G_PROJ) {
            const float* W = p.in[I_W_IN] + (long)l * DM * DPROJ;
            gemm_tile64<false>(m0, n0, K,
                [&](int r, int k) { return a2f(p.u[(long)r * DM + k]); },
                [&](int k, int c) { return c < DPROJ ? W[(long)k * DPROJ + c] : 0.f; }, nob,
                [&](int r, int c, float a, float) { if (c < DPROJ) p.proj[(long)r * DPROJ + c] = f2a(a); });
        } else if (MODE == G_GLU) {
            const float* W = p.in[I_S5_GLU_W] + (long)l * 256 * 256;
            const float* g = p.osum + (long)2 * NTOK * 256;
            gemm_tile64<false>(m0, n0, K,
                [&](int r, int k) { return g[(long)r * 256 + k]; },
                [&](int k, int c) { return W[k * 256 + c]; }, nob,
                [&](int r, int c, float a, float) {
                    float gv = g[(long)r * 256 + c];
                    p.mix[(long)r * DM + 512 + c] = f2a(gv * sigmoid_f(a + p.in[I_S5_GLU_B][l * 256 + c]));
                });
        } else if (MODE == G_OUT) {
            const float* W = p.in[I_W_OUT] + (long)l * DM * DM;
            gemm_tile64<false>(m0, n0, K,
                [&](int r, int k) { return a2f(p.mix[(long)r * DM + k]); },
                [&](int k, int c) { return W[(long)k * DM + c]; }, nob,
                [&](int r, int c, float a, float) { p.y[(long)r * DM + c] = f2a(a); });
        } else if (MODE == G_FFN1) {
            const float* W1 = p.in[I_FFN_W1] + (long)j * DM * DFF;
            const float* W3 = p.in[I_FFN_W3] + (long)j * DM * DFF;
            gemm_tile64<true>(m0, n0, K,
                [&](int r, int k) { return a2f(p.u[(long)r * DM + k]); },
                [&](int k, int c) { return W1[(long)k * DFF + c]; },
                [&](int k, int c) { return W3[(long)k * DFF + c]; },
                [&](int r, int c, float a, float b) { p.proj[(long)r * DFF + c] = f2a(silu_f(a) * b); });
        } else if (MODE == G_FFN2) {
            const float* W = p.in[I_FFN_W2] + (long)j * DFF * DM;
            gemm_tile64<false>(m0, n0, K,
                [&](int r, int k) { return a2f(p.proj[(long)r * DFF + k]); },
                [&](int k, int c) { return W[(long)k * DM + c]; }, nob,
                [&](int r, int c, float a, float) { p.y[(long)r * DM + c] = f2a(a); });
        } else {
            const int slot0 = pass * MOE_R + m0;
            if (slot0 >= pend[NEXP - 1]) continue;
            int e = 0;
            while (slot0 >= pend[e]) ++e;
            if (MODE == G_MFFN1) {
                const float* W1 = p.in[I_MOE_W1] + ((long)j * NEXP + e) * DM * DFF;
                const float* W3 = p.in[I_MOE_W3] + ((long)j * NEXP + e) * DM * DFF;
                gemm_tile64<true>(m0, n0, K,
                    [&](int r, int k) { int a = p.slot_asg[pass * MOE_R + r]; return a >= 0 ? a2f(p.u[(long)(a >> 1) * DM + k]) : 0.f; },
                    [&](int k, int c) { return W1[(long)k * DFF + c]; },
                    [&](int k, int c) { return W3[(long)k * DFF + c]; },
                    [&](int r, int c, float a, float b) { p.proj[(long)r * DFF + c] = f2a(silu_f(a) * b); });
            } else {
                const float* W = p.in[I_MOE_W2] + ((long)j * NEXP + e) * DFF * DM;
                gemm_tile64<false>(m0, n0, K,
                    [&](int r, int k) { return a2f(p.proj[(long)r * DFF + k]); },
                    [&](int k, int c) { return W[(long)k * DM + c]; }, nob,
                    [&](int r, int c, float a, float) {
                        int as = p.slot_asg[pass * MOE_R + r];
                        if (as >= 0) p.ys[(long)as * DM + c] = f2a(p.tok_g[as] * a);
                    });
            }
        }
    }
}

__device__ void st_rotary(const Params& p) {
    for (long it = (long)blockIdx.x * 256 + threadIdx.x; it < (long)NLAT * 256; it += (long)gridDim.x * 256) {
        int row = it >> 8, r = it & 255;
        int which = r >> 7, h = (r >> 5) & 3, f = r & 31;
        int t = row % SEQ;
        float cs = p.rot[(t * 32 + f) * 2], sn = p.rot[(t * 32 + f) * 2 + 1];
        act_t* base = p.proj + (long)row * DPROJ + (which ? O_RK : O_RQ) + h * 64;
        float t1 = a2f(base[f]), t2 = a2f(base[f + 32]);
        base[f] = f2a(t1 * cs - t2 * sn);
        base[f + 32] = f2a(t1 * sn + t2 * cs);
    }
}
__device__ void st_gla_gate(const Params& p, int l) {
    for (long it = (long)blockIdx.x * 256 + threadIdx.x; it < (long)2 * NTOK * 128; it += (long)gridDim.x * 256) {
        int jj = it & 127;
        int row = (it >> 7) % NTOK;
        int dir = it / ((long)NTOK * 128);
        const float* wa = p.in[I_GLA_WA] + ((long)(l * 2 + dir) * 16) * 128;
        float g = p.in[I_GLA_BA][(l * 2 + dir) * 128 + jj];
        const act_t* a = p.proj + (long)row * DPROJ + O_GA + dir * 16;
        for (int i = 0; i < 16; ++i) g += a2f(a[i]) * wa[i * 128 + jj];
        p.loga[it] = log_sigmoid_f(g) * (1.0f / 16.0f);
    }
}
__device__ __forceinline__ float hy_short(const Params& p, int l, int row, int c) {
    const bool lat = row < NLAT;
    const int n = lat ? SEQ : CTXL;
    const int t = lat ? row % SEQ : (row - NLAT) % CTXL;
    const float* cw = p.in[I_HY_CONV_W] + (long)l * 3 * 768;
    float s = p.in[I_HY_CONV_B][l * 768 + c];
    for (int jj = 0; jj < 3; ++jj) {
        int tt = t + jj - 1;
        if (tt >= 0 && tt < n) s += a2f(p.proj[(long)(row + jj - 1) * DPROJ + O_HP + c]) * cw[jj * 768 + c];
    }
    return s;
}
__device__ void st_hy_pre(const Params& p, int l) {
    const int nrows = (l == DEPTH - 1) ? NLAT : NTOK;
    for (long it = (long)blockIdx.x * 256 + threadIdx.x; it < (long)nrows * 256; it += (long)gridDim.x * 256) {
        int row = it >> 8, ch = it & 255;
        p.hz[it] = hy_short(p, l, row, 256 + ch) * hy_short(p, l, row, 512 + ch);
    }
}
__device__ void st_hy_conv(const Params& p, int l, int bid, int nb) {
    const int nrows = (l == DEPTH - 1) ? NLAT : NTOK;
    for (long it = (long)bid * 256 + threadIdx.x; it < (long)nrows * 256; it += (long)nb * 256) {
        int row = it >> 8, ch = it & 255;
        const bool lat = row < NLAT;
        const int n = lat ? SEQ : CTXL;
        const int t = lat ? row % SEQ : (row - NLAT) % CTXL;
        const int rbase = row - t;
        const float* circ = p.filt + (long)l * FILT_LAYER_FLOATS + (lat ? 0 : 2 * SEQ * 256);
        float acc = 0.f;
        for (int s = 0; s < n; ++s) {
            int idx = t - s; if (idx < 0) idx += 2 * n;
            acc += circ[(long)idx * 256 + ch] * p.hz[(long)(rbase + s) * 256 + ch];
        }
        float yv = acc * p.fnorm[(l * 2 + (lat ? 0 : 1)) * 256 + ch];
        float z = p.hz[it];
        float x0 = hy_short(p, l, row, ch);
        p.mix[(long)row * DM + 768 + ch] = f2a(x0 * (yv + z * p.in[I_HY_BIAS][l * 256 + ch]));
    }
}

__device__ void st_scan_ret(const Params& p, int l, int bid, int nb) {
    const bool need_ctx = (l != DEPTH - 1);
    for (int it = bid * 256 + threadIdx.x; it < BATCH * 256; it += nb * 256) {
        const int b = it >> 8, h = (it >> 6) & 3, e = it & 63;
        float* os = p.osum;
        for (int dir = 0; dir < 2; ++dir) {
            float dec = p.in[I_RET_DECAY][(l * 2 + dir) * 4 + h];
            float g = expf(log_sigmoid_f(dec));
            float S[64];
            for (int d = 0; d < 64; ++d) S[d] = 0.f;
            for (int step = 0; step < CTXL + SEQ; ++step) {
                const bool isctx = step < CTXL;
                int row;
                if (isctx) { int t = dir ? CTXL - 1 - step : step; row = NLAT + b * CTXL + t; }
                else { int s2 = step - CTXL; int t = dir ? SEQ - 1 - s2 : s2; row = b * SEQ + t; }
                const act_t* pr = p.proj + (long)row * DPROJ;
                float v = a2f(pr[O_RV + h * 64 + e]);
                float o = 0.f;
                for (int d = 0; d < 64; ++d) {
                    float k = a2f(pr[O_RK + h * 64 + d]) * 0.125f;
                    float q = a2f(pr[O_RQ + h * 64 + d]);
                    S[d] = g * S[d] + k * v;
                    o += q * S[d];
                }
                if (!isctx || need_ctx) {
                    float* dst = os + (long)row * 256 + h * 64 + e;
                    if (dir == 0) *dst = o; else *dst += o;
                }
            }
        }
    }
}
__device__ void st_scan_gla(const Params& p, int l, int bid, int nb) {
    const bool need_ctx = (l != DEPTH - 1);
    const float qscale = 0.17677669529663687f;
    for (int it = bid * 256 + threadIdx.x; it < BATCH * 256; it += nb * 256) {
        const int b = it >> 8, h = (it >> 6) & 3, e = it & 63;
        float* os = p.osum + (long)NTOK * 256;
        for (int dir = 0; dir < 2; ++dir) {
            float S[32];
            for (int d = 0; d < 32; ++d) S[d] = 0.f;
            for (int step = 0; step < CTXL + SEQ; ++step) {
                const bool isctx = step < CTXL;
                int row;
                if (isctx) { int t = dir ? CTXL - 1 - step : step; row = NLAT + b * CTXL + t; }
                else { int s2 = step - CTXL; int t = dir ? SEQ - 1 - s2 : s2; row = b * SEQ + t; }
                const act_t* pr = p.proj + (long)row * DPROJ;
                const float* la = p.loga + ((long)dir * NTOK + row) * 128 + h * 32;
                float v = a2f(pr[O_GV + h * 64 + e]);
                float o = 0.f;
                for (int d = 0; d < 32; ++d) {
                    float k = a2f(pr[O_GK + h * 32 + d]);
                    float q = a2f(pr[O_GQ + h * 32 + d]) * qscale;
                    S[d] = expf(la[d]) * S[d] + k * v;
                    o += q * S[d];
                }
                if (!isctx || need_ctx) {
                    float* dst = os + (long)row * 256 + h * 64 + e;
                    if (dir == 0) *dst = o; else *dst += o;
                }
            }
        }
    }
}
__device__ void st_scan_s5(const Params& p, int l, int bid, int nb) {
    const bool need_ctx = (l != DEPTH - 1);
    float* sh = smem_base();
    const int tid = threadIdx.x, gl = tid >> 6, n = tid & 63;
    float* hsh = sh + gl * 128;
    float* os = p.osum + (long)2 * NTOK * 256;
    for (int blk = bid; blk < BATCH * 4; blk += nb) {
        const int b = blk >> 2, g = (blk & 3) * 4 + gl;
        for (int dir = 0; dir < 2; ++dir) {
            const int pg = (l * 2 + dir) * 16 + g;
            double lre = p.in[I_S5_LAM_RE][pg * 64 + n], lim = p.in[I_S5_LAM_IM][pg * 64 + n];
            double dt = exp((double)p.in[I_S5_LOG_DT][pg]);
            double mag = exp(lre * dt);
            double lbr = mag * cos(lim * dt), lbi = mag * sin(lim * dt);
            double den = lre * lre + lim * lim;
            double cr = ((lbr - 1.0) * lre + lbi * lim) / den;
            double ci = (lbi * lre - (lbr - 1.0) * lim) / den;
            float bbr[16], bbi[16];
            for (int q = 0; q < 16; ++q) {
                double br = p.in[I_S5_B_RE][((long)pg * 64 + n) * 16 + q], bi = p.in[I_S5_B_IM][((long)pg * 64 + n) * 16 + q];
                bbr[q] = (float)(cr * br - ci * bi);
                bbi[q] = (float)(cr * bi + ci * br);
            }
            const float flr = (float)lbr, fli = (float)lbi;
            const float* cre = p.in[I_S5_C_RE] + ((long)pg * 16 + (n & 15)) * 64;
            const float* cim = p.in[I_S5_C_IM] + ((long)pg * 16 + (n & 15)) * 64;
            float hr = 0.f, hi = 0.f;
            for (int step = 0; step < CTXL + SEQ; ++step) {
                const bool isctx = step < CTXL;
                int row;
                if (isctx) { int t = dir ? CTXL - 1 - step : step; row = NLAT + b * CTXL + t; }
                else { int s2 = step - CTXL; int t = dir ? SEQ - 1 - s2 : s2; row = b * SEQ + t; }
                const act_t* uu = p.proj + (long)row * DPROJ + O_SU + g * 16;
                float br = 0.f, bi = 0.f;
                for (int q = 0; q < 16; ++q) { float uv = a2f(uu[q]); br += bbr[q] * uv; bi += bbi[q] * uv; }
                float nr = flr * hr - fli * hi + br;
                float ni = flr * hi + fli * hr + bi;
                hr = nr; hi = ni;
                hsh[n] = hr; hsh[64 + n] = hi;
                __syncthreads();
                if (n < 16 && (!isctx || need_ctx)) {
                    float yv = 0.f;
                    for (int m = 0; m < 64; ++m) yv += cre[m] * hsh[m] - cim[m] * hsh[64 + m];
                    float* dst = os + (long)row * 256 + g * 16 + n;
                    if (dir == 0) *dst = yv; else *dst += yv;
                }
                __syncthreads();
            }
        }
    }
}
__device__ void st_finish(const Params& p, int l) {
    const int tid = threadIdx.x, wave = tid >> 6, lane = tid & 63;
    const int nrows = (l == DEPTH - 1) ? NLAT : NTOK;
    for (int base = blockIdx.x * 4; base < nrows; base += gridDim.x * 4) {
        const int row = base + wave;
        const act_t* pr = p.proj + (long)row * DPROJ;
        for (int h = 0; h < 4; ++h) {
            int c = h * 64 + lane;
            float o = p.osum[(long)row * 256 + c];
            float mu = wave_sum(o) * (1.0f / 64.0f);
            float d = o - mu;
            float var = wave_sum(d * d) * (1.0f / 64.0f);
            float yv = d * (1.0f / sqrtf(var + LN_EPS)) * p.in[I_RET_GN_G][l * 256 + c] + p.in[I_RET_GN_B][l * 256 + c];
            p.mix[(long)row * DM + c] = f2a(yv * silu_f(a2f(pr[O_RG + c])));
        }
        for (int h = 0; h < 4; ++h) {
            int c = h * 64 + lane;
            float o = p.osum[((long)NTOK + row) * 256 + c];
            float ms = wave_sum(o * o) * (1.0f / 64.0f);
            float yv = o * (1.0f / sqrtf(ms + LN_EPS)) * p.in[I_GLA_NORM_G][l * 256 + c];
            p.mix[(long)row * DM + 256 + c] = f2a(yv * silu_f(a2f(pr[O_GR + c])));
        }
        for (int h = 0; h < 4; ++h) {
            int c = h * 64 + lane;
            float* yp = p.osum + ((long)2 * NTOK + row) * 256 + c;
            float yv = *yp + p.in[I_S5_D][l * 256 + c] * a2f(pr[O_SU + c]);
            *yp = gelu_tanh_f(yv);
        }
    }
}

#ifdef EMU
#define GRID_SYNC()
#else
#define GRID_SYNC() grid.sync()
#endif

#define STAGE_KERNEL(name, call) \
    __global__ void __launch_bounds__(256) name(Params p, int l, int a) { call; }
STAGE_KERNEL(k_prep, st_prep(p))
STAGE_KERNEL(k_prep2, st_prep2(p))
STAGE_KERNEL(k_ln, st_ln(p, l, a))
STAGE_KERNEL(k_router, st_router(p, l))
STAGE_KERNEL(k_place, st_place(p))
STAGE_KERNEL(k_g_proj, st_gemm<G_PROJ>(p, l, a))
STAGE_KERNEL(k_g_glu, st_gemm<G_GLU>(p, l, a))
STAGE_KERNEL(k_g_out, st_gemm<G_OUT>(p, l, a))
STAGE_KERNEL(k_g_ffn1, st_gemm<G_FFN1>(p, l, a))
STAGE_KERNEL(k_g_ffn2, st_gemm<G_FFN2>(p, l, a))
STAGE_KERNEL(k_g_mffn1, st_gemm<G_MFFN1>(p, l, a))
STAGE_KERNEL(k_g_mffn2, st_gemm<G_MFFN2>(p, l, a))
STAGE_KERNEL(k_rotary, st_rotary(p))
STAGE_KERNEL(k_gla_gate, st_gla_gate(p, l))
STAGE_KERNEL(k_hy_pre, st_hy_pre(p, l))
STAGE_KERNEL(k_hy_conv, st_hy_conv(p, l, blockIdx.x, gridDim.x))
STAGE_KERNEL(k_scan_ret, st_scan_ret(p, l, blockIdx.x, gridDim.x))
STAGE_KERNEL(k_scan_gla, st_scan_gla(p, l, blockIdx.x, gridDim.x))
STAGE_KERNEL(k_scan_s5, st_scan_s5(p, l, blockIdx.x, gridDim.x))
STAGE_KERNEL(k_finish, st_finish(p, l))

#ifdef EMU
#define LAUNCH(k, grid, l, a) emu_launch(grid, 256, [&]() { k(p, l, a); })
#else
#define LAUNCH(k, grid, l, a) hipLaunchKernelGGL(k, dim3(grid), dim3(256), 0, stream, p, l, a)
#endif

#ifndef EMU
namespace cg = cooperative_groups;
__global__ void __launch_bounds__(256) fwd_megakernel(Params p) {
    cg::grid_group grid = cg::this_grid();
    st_prep(p);
    grid.sync();
    st_prep2(p);
    st_ln(p, 0, 0);
    grid.sync();
    for (int l = 0; l < DEPTH; ++l) {
        st_gemm<G_PROJ>(p, l, 0);
        grid.sync();
        st_rotary(p);
        st_gla_gate(p, l);
        st_hy_pre(p, l);
        grid.sync();
        {
            const int bid = blockIdx.x, nb = gridDim.x;
            if (bid < BATCH) st_scan_ret(p, l, bid, BATCH);
            else if (bid < 2 * BATCH) st_scan_gla(p, l, bid - BATCH, BATCH);
            else if (bid < 6 * BATCH) st_scan_s5(p, l, bid - 2 * BATCH, 4 * BATCH);
            else st_hy_conv(p, l, bid - 6 * BATCH, nb - 6 * BATCH);
        }
        grid.sync();
        st_finish(p, l);
        grid.sync();
        st_gemm<G_GLU>(p, l, 0);
        grid.sync();
        st_gemm<G_OUT>(p, l, 0);
        grid.sync();
        st_ln(p, l, 1);
        grid.sync();
        if ((l & 1) == 0) {
            st_gemm<G_FFN1>(p, l, 0);
            grid.sync();
            st_gemm<G_FFN2>(p, l, 0);
            grid.sync();
        } else {
            st_router(p, l);
            grid.sync();
            st_place(p);
            grid.sync();
            for (int ps = 0; ps < MOE_PASSES; ++ps) {
                st_gemm<G_MFFN1>(p, l, ps);
                grid.sync();
                st_gemm<G_MFFN2>(p, l, ps);
                grid.sync();
            }
        }
        st_ln(p, l, 2);
        grid.sync();
    }
}
#endif

static inline size_t align_up(size_t v, size_t a) { return (v + a - 1) / a * a; }

#ifdef EMU
Params g_dbg_params;
#endif

extern "C" void kernel_launch(void* const* d_in, const int* in_sizes, int n_in, void* d_out, int out_size, void* d_ws,
                              size_t ws_size, hipStream_t stream) {
    Params p{};
    for (int i = 0; i < N_IN; ++i) p.in[i] = (const float*)d_in[i];
    p.out = (float*)d_out;
    char* ws = (char*)d_ws;
    size_t off = 0;
    auto take = [&](size_t bytes) { char* r = ws + off; off = align_up(off + bytes, 256); return r; };
    p.proj = (act_t*)take((size_t)NTOK * DPROJ * sizeof(act_t));
    p.u = (act_t*)take((size_t)NTOK * DM * sizeof(act_t));
    p.y = (act_t*)take((size_t)NTOK * DM * sizeof(act_t));
    p.mix = (act_t*)take((size_t)NTOK * DM * sizeof(act_t));
    p.osum = (float*)p.u;
    p.ys = (act_t*)p.y;
    p.mod = (float*)take((size_t)DEPTH * (BATCH + 1) * 6 * DM * 4);
    p.hctx = (float*)take((size_t)NCTX * DM * 4);
    p.loga = (float*)take((size_t)2 * NTOK * 128 * 4);
    p.hz = (float*)take((size_t)NTOK * 256 * 4);
    p.filt = (float*)take((size_t)DEPTH * FILT_LAYER_FLOATS * 4);
    p.fnorm = (float*)take((size_t)DEPTH * 2 * 256 * 4);
    p.rot = (float*)take((size_t)SEQ * 32 * 2 * 4);
    p.moe_cnt = (int*)take(16 * 4);
    p.tok_e = (int*)take((size_t)NLAT * 2 * 4);
    p.tok_g = (float*)take((size_t)NLAT * 2 * 4);
    p.slot_asg = (int*)take((size_t)MOE_CAP * 4);
#ifdef EMU
    g_dbg_params = p;
    const int G = 64;
    LAUNCH(k_prep, G, 0, 0);
    LAUNCH(k_prep2, G, 0, 0);
    LAUNCH(k_ln, G, 0, 0);
    for (int l = 0; l < DEPTH; ++l) {
        LAUNCH(k_g_proj, G, l, 0);
        LAUNCH(k_rotary, G, l, 0);
        LAUNCH(k_gla_gate, G, l, 0);
        LAUNCH(k_hy_pre, G, l, 0);
        LAUNCH(k_scan_ret, BATCH, l, 0);
        LAUNCH(k_scan_gla, BATCH, l, 0);
        LAUNCH(k_scan_s5, BATCH * 4, l, 0);
        LAUNCH(k_finish, G, l, 0);
        LAUNCH(k_hy_conv, G, l, 0);
        LAUNCH(k_g_glu, G, l, 0);
        LAUNCH(k_g_out, G, l, 0);
        LAUNCH(k_ln, G, l, 1);
        if ((l & 1) == 0) {
            LAUNCH(k_g_ffn1, G, l, 0);
            LAUNCH(k_g_ffn2, G, l, 0);
        } else {
            LAUNCH(k_router, G, l, 0);
            LAUNCH(k_place, G, l, 0);
            for (int ps = 0; ps < MOE_PASSES; ++ps) {
                LAUNCH(k_g_mffn1, G, l, ps);
                LAUNCH(k_g_mffn2, G, l, ps);
            }
        }
        LAUNCH(k_ln, G, l, 2);
    }
#else
    static int grid_blocks = 0;
    if (!grid_blocks) {
        int dev = 0, cus = 0, per_cu = 0;
        hipGetDevice(&dev);
        hipDeviceGetAttribute(&cus, hipDeviceAttributeMultiprocessorCount, dev);
        hipOccupancyMaxActiveBlocksPerMultiprocessor(&per_cu, fwd_megakernel, 256, 0);
        if (per_cu > 2) per_cu = 2;
        grid_blocks = cus * per_cu;
    }
    void* args[] = {&p};
    hipLaunchCooperativeKernel((void*)fwd_megakernel, dim3(grid_blocks), dim3(256), args, 0, stream);
#endif
}
```

```cpp
#ifndef EMU
#include <hip/hip_runtime.h>
#endif
#include <stdint.h>
#include <math.h>

#ifndef BATCH
#define BATCH 8
#endif
#ifndef SEQ
#define SEQ 4096
#endif
#ifndef CTXL
#define CTXL 256
#endif
#define NT 512
#define NW 8
#define DM 1024
#define DEPTH 2
#define GRID_W 64
#define DPROJ_IN 2848
#define PROJ_W 2816
#define NPROJ_T 3072
#define DFF 2816
#define NEXP 8
#define NLAT (BATCH * SEQ)
#define NCTX (BATCH * CTXL)
#define NTOK (NLAT + NCTX)
#define MOE_CAP (2 * NLAT + NEXP * 256)
#define MOE_TILES (MOE_CAP / 256)
#ifndef MOE_PT
#define MOE_PT 64
#endif
#define MOE_NPASS ((MOE_TILES + MOE_PT - 1) / MOE_PT)
#define LN_EPS 1e-5f
#define ALPHA 1.4142135623730951f
#define O_RQ 0
#define O_RK 256
#define O_RV 512
#define O_RG 768
#define O_GQ 1024
#define O_GK 1152
#define O_GV 1280
#define O_GR 1536
#define O_SU 1792
#define O_HP 2048

enum { I_X, I_C, I_CTX, I_CCTX, I_ADA_W, I_ADA_B, I_W_IN, I_RET_DECAY, I_RET_GN_G, I_RET_GN_B, I_GLA_WA, I_GLA_BA,
       I_GLA_NORM_G, I_S5_LAM_RE, I_S5_LAM_IM, I_S5_LOG_DT, I_S5_B_RE, I_S5_B_IM, I_S5_C_RE, I_S5_C_IM, I_S5_D,
       I_S5_GLU_W, I_S5_GLU_B, I_HY_CONV_W, I_HY_CONV_B, I_HY_FW1, I_HY_FB1, I_HY_FREQ, I_HY_FW2, I_HY_FB2, I_HY_FW3,
       I_HY_DECAY, I_HY_BIAS, I_W_OUT, I_LN_MIX_G, I_LN_MIX_B, I_LN_FFN_G, I_LN_FFN_B, I_FFN_W1, I_FFN_W3, I_FFN_W2,
       I_ROUTER_W, I_ROUTER_B, I_MOE_W1, I_MOE_W3, I_MOE_W2, N_IN };

typedef float f32x4 __attribute__((ext_vector_type(4)));
typedef unsigned u32x4 __attribute__((ext_vector_type(4)));

#ifdef EMU_F32ACT
typedef float act_t;
__device__ __forceinline__ float a2f(act_t v) { return v; }
__device__ __forceinline__ act_t f2a(float f) { return f; }
#else
typedef unsigned short act_t;
__device__ __forceinline__ float a2f(act_t v) { union { unsigned u; float f; } c; c.u = ((unsigned)v) << 16; return c.f; }
__device__ __forceinline__ act_t f2a(float f) { union { unsigned u; float f; } c; c.f = f; unsigned u = c.u; u += 0x7fffu + ((u >> 16) & 1u); return (act_t)(u >> 16); }
#endif
__device__ __forceinline__ void store8(act_t* p, const float* v) {
#if defined(EMU)
    for (int i = 0; i < 8; ++i) p[i] = f2a(v[i]);
#else
    u32x4 w;
    w.x = (unsigned)f2a(v[0]) | ((unsigned)f2a(v[1]) << 16); w.y = (unsigned)f2a(v[2]) | ((unsigned)f2a(v[3]) << 16);
    w.z = (unsigned)f2a(v[4]) | ((unsigned)f2a(v[5]) << 16); w.w = (unsigned)f2a(v[6]) | ((unsigned)f2a(v[7]) << 16);
    *(u32x4*)p = w;
#endif
}

struct Params {
    const float* in[N_IN];
    float* out;
    unsigned* ctl;
    float* mod;
    act_t* proj;
    act_t* hz;
    act_t* wmoe13;
    act_t* wmoe2;
    act_t* hch;
    act_t* u;
    float* retD;
    float* glaD;
    float* glaE;
    act_t* mix;
    float* osum;
    float* loga;
    act_t* ys;
    act_t* win_t;
    act_t* wout_t;
    act_t* w13_t;
    act_t* w2_t;
    float* hctx;
    float* filt;
    float* fnorm;
    float* hdn2;
    float* fft_tw;
    float* hspec;
    float* rot;
    float* s5tab;
    float* s5pw;
    act_t* s5Tc;
    act_t* s5Win;
    act_t* s5Wend;
    float* s5S;
    int* tok_e;
    float* tok_g;
    int* slot_asg;
};
#define CTL_MOE 4096
#define CTL_WORDS 4224
#define FILT_LAYER_FLOATS (2 * CTXL * 256)
#define FN (2 * SEQ)
#if SEQ == 4096
#define FLOG 13
#elif SEQ == 512
#define FLOG 10
#elif SEQ == 256
#define FLOG 9
#endif

#define LDS_RING 131072
#define LDS_BYTES 147456
#ifdef EMU
#define GRID_BAR()
#else
#define LAS __attribute__((address_space(3)))
#define XB_TMO      128
#define XB_XCNT(j)  (256  + 64 * (j))
#define XB_XSUB(j)  (1280 + 64 * (j))
#define XB_XGEN(j)  (2304 + 64 * (j))
#define XB_TOP      3328
#define XB_TOPGEN   3392
#define XCD_BAR_WORDS 3456
#define XB_SPIN_CAP (1u << 26)
__device__ __forceinline__ unsigned xb_ld(unsigned* p)              { return __hip_atomic_load(p, __ATOMIC_RELAXED, __HIP_MEMORY_SCOPE_AGENT); }
__device__ __forceinline__ unsigned xb_add(unsigned* p, unsigned v) { return __hip_atomic_fetch_add(p, v, __ATOMIC_RELAXED, __HIP_MEMORY_SCOPE_AGENT); }
__device__ __forceinline__ unsigned xb_xcc_id() { return (unsigned)__builtin_amdgcn_s_getreg((3 << 11) | 20) & 0xFu; }
#define XB_SPIN(cond, bar) do { unsigned _sp = 0; while (cond) { __builtin_amdgcn_s_sleep(1); \
    if ((++_sp & 255u) == 0u) { if (xb_ld(&(bar)[XB_TMO])) break; if (_sp > XB_SPIN_CAP) { atomicAdd(&(bar)[XB_TMO], 1u); break; } } } } while (0)
struct XcdBarrier { unsigned* bar; unsigned x; volatile LAS unsigned* st; };
__device__ __forceinline__ XcdBarrier xcd_barrier_post(unsigned* bar, volatile LAS unsigned* st) {
    XcdBarrier b; b.bar = bar; b.x = xb_xcc_id(); b.st = st;
    if (threadIdx.x == 0) (void)xb_add(&bar[XB_XCNT(b.x)], 1u);
    return b;
}
__device__ __forceinline__ void xcd_barrier_complete(unsigned* bar, unsigned x, unsigned& nloc, unsigned& nx) {
    const unsigned G = gridDim.x * gridDim.y * gridDim.z;
    unsigned sum, cnt, mine, sp = 0u;
    for (;;) {
        sum = 0u; cnt = 0u; mine = 0u;
#pragma unroll
        for (unsigned j = 0; j < 16; ++j) { const unsigned c = xb_ld(&bar[XB_XCNT(j)]); sum += c; cnt += (c > 0u) ? 1u : 0u; mine = (j == x) ? c : mine; }
        if (sum == G) break;
        __builtin_amdgcn_s_sleep(1);
        if ((++sp & 255u) == 0u) { if (xb_ld(&bar[XB_TMO])) break; if (sp > XB_SPIN_CAP) { atomicAdd(&bar[XB_TMO], 1u); break; } }
    }
    nloc = mine > 0u ? mine : 1u; nx = cnt > 0u ? cnt : 1u;
}
__device__ __forceinline__ void xcd_barrier(const XcdBarrier& b) {
    asm volatile("s_waitcnt vmcnt(0)" ::: "memory");
    __syncthreads();
    if (threadIdx.x == 0) {
        unsigned* bar = b.bar;
        __builtin_amdgcn_s_waitcnt(0);
        unsigned nloc = b.st[0], nx = b.st[1];
        if (nloc == 0u) { xcd_barrier_complete(bar, b.x, nloc, nx); b.st[0] = nloc; b.st[1] = nx; }
        const unsigned old = xb_add(&bar[XB_XSUB(b.x)], 1u);
        const unsigned gen = old / nloc;
        if (old + 1u == (gen + 1u) * nloc) {
            __builtin_amdgcn_fence(__ATOMIC_RELEASE, "agent");
            asm volatile("s_waitcnt vmcnt(0)" ::: "memory");
            const unsigned og = xb_add(&bar[XB_TOP], 1u);
            const unsigned tg = og / nx;
            if (og + 1u == (tg + 1u) * nx) xb_add(&bar[XB_TOPGEN], 1u);
            else XB_SPIN(xb_ld(&bar[XB_TOPGEN]) == tg, bar);
            __builtin_amdgcn_fence(__ATOMIC_ACQUIRE, "agent");
            xb_add(&bar[XB_XGEN(b.x)], 1u);
            asm volatile("s_waitcnt vmcnt(0)" ::: "memory");
        } else {
            XB_SPIN(xb_ld(&bar[XB_XGEN(b.x)]) == gen, bar);
            __builtin_amdgcn_fence(__ATOMIC_ACQUIRE, "agent");
            asm volatile("s_waitcnt vmcnt(0)" ::: "memory");
        }
    }
    __syncthreads();
}
#define GRID_BAR() do { XcdBarrier _b; _b.bar = p.ctl; _b.x = xb_xcc_id(); _b.st = (volatile LAS unsigned*)((LAS unsigned char*)lds + LDS_RING) + 8; xcd_barrier(_b); } while (0)
#endif

#ifdef EMU
#define TIDX() ((int)threadIdx.x)
#define BIDX() ((int)blockIdx.x)
#define NBLK() ((int)gridDim.x)
#else
#define BIDX() bid_opaque()
#define NBLK() nblk_opaque()
__device__ __forceinline__ int tid_opaque(int wv) { int t; asm volatile("v_mbcnt_lo_u32_b32 %0, -1, 0\n\tv_mbcnt_hi_u32_b32 %0, -1, %0\n\tv_lshl_add_u32 %0, %1, 6, %0" : "=&v"(t) : "s"(wv)); return t; }
#define TIDX() tid_opaque(wv)
__device__ __forceinline__ int bid_opaque() { int t = blockIdx.x; asm volatile("" : "+s"(t)); return t; }
__device__ __forceinline__ int nblk_opaque() { int t = gridDim.x; asm volatile("" : "+s"(t)); return t; }
#endif
#ifdef EMU
__device__ __forceinline__ float wave_sum(float v) {
    for (int o = 32; o > 0; o >>= 1) v += __shfl_xor(v, o);
    return v;
}
#else
__device__ __forceinline__ float wave_sum(float v) {
#define WS_STEP(m) v += __builtin_bit_cast(float, __builtin_amdgcn_ds_swizzle(__builtin_bit_cast(int, v), ((m) << 10) | 0x1f))
    WS_STEP(1); WS_STEP(2); WS_STEP(4); WS_STEP(8); WS_STEP(16);
#undef WS_STEP
    float a = v, b = v;
    asm volatile("s_nop 1\n\tv_permlane32_swap_b32 %0, %1" : "+v"(a), "+v"(b));
    return a + b;
}
#endif
__device__ __forceinline__ float silu_f(float x) { return x / (1.0f + expf(-x)); }
__device__ __forceinline__ float sigmoid_f(float x) { return 1.0f / (1.0f + expf(-x)); }
__device__ __forceinline__ float log_sigmoid_f(float x) { return fminf(x, 0.0f) - log1pf(expf(-fabsf(x))); }
#ifdef EMU
#define EPI_FENCE()
__device__ __forceinline__ float log_sigmoid_fast(float x) { return log_sigmoid_f(x); }
#else
#define EPI_FENCE() asm volatile("" ::: "memory")
__device__ __forceinline__ float log_sigmoid_fast(float x) { return fminf(x, 0.0f) - __logf(1.0f + __expf(-fabsf(x))); }
#endif
__device__ __forceinline__ float gelu_tanh_f(float x) {
    return 0.5f * x * (1.0f + tanhf(0.7978845608028654f * (x + 0.044715f * x * x * x)));
}
__device__ __forceinline__ void ln_stats16(const float* v, float& mu, float& rstd) {
    float s = 0.f;
    for (int i = 0; i < 16; ++i) s += v[i];
    s = wave_sum(s);
    mu = s * (1.0f / DM);
    float q = 0.f;
    for (int i = 0; i < 16; ++i) { float d = v[i] - mu; q += d * d; }
    q = wave_sum(q);
    rstd = 1.0f / sqrtf(q * (1.0f / DM) + LN_EPS);
}
__device__ __forceinline__ int row_modidx(int row) { return row < NLAT ? row / SEQ : BATCH; }

struct Unit { int pm, pn; };
struct Gemm { const act_t* A; const act_t* Bt; int M, N, K; const int* rowmap; };
#define GBM 256
#define GNXCD 8
#define GWGM 8
struct StaticOrder {
    int nM, nN, nwg, G, c;
    __device__ void init(int M, int N, int G_, int c_) { nM = M / GBM; nN = N / GBM; nwg = nM * nN; G = G_; c = c_; }
    __device__ bool next(int i, Unit& u) const {
        const long L = (long)i * G + c; if (L >= nwg) return false;
        int wgid = (int)L; { const int q = nwg / GNXCD, r = nwg % GNXCD, xcd = wgid % GNXCD, off = wgid / GNXCD; wgid = (xcd < r ? xcd * (q + 1) : r * (q + 1) + (xcd - r) * q) + off; }
        const int nig = GWGM * nN, gid = wgid / nig, fm = gid * GWGM, gsz = (nM - fm) < GWGM ? (nM - fm) : GWGM;
        u.pm = fm + ((wgid % nig) % gsz); u.pn = (wgid % nig) / gsz; return true;
    }
    __device__ __forceinline__ const act_t* b_base(const Unit& u, const Gemm& g) const { return g.Bt + (size_t)u.pn * GBM * g.K; }
};
struct MoeOrder {
    StaticOrder so; int t0; int pend[NEXP]; size_t estride;
    __device__ bool next(int i, Unit& u) const { if (!so.next(i, u)) return false; u.pm += t0; return true; }
    __device__ __forceinline__ const act_t* b_base(const Unit& u, const Gemm& g) const {
        int e = 0;
#pragma unroll
        for (int q = 0; q < NEXP - 1; ++q) e += (u.pm * 256 >= pend[q]) ? 1 : 0;
        return g.Bt + (size_t)e * estride + (size_t)u.pn * GBM * g.K;
    }
};

template <class Epi, class Sched, bool GATHER>
__device__ __forceinline__ void gemm_phase_ref(int wv, const Gemm g, const Sched& S, const Epi& E) {
    const int tid = TIDX(), wid = tid >> 6, lane = tid & 63, wr = wid >> 2, wc = wid & 3, fr = lane & 15, fq = lane >> 4;
    Unit cur;
    for (int ui = 0; S.next(ui, cur); ++ui) {
        f32x4 acc[2][2][4][2];
        const act_t* Bt = S.b_base(cur, g);
        _Pragma("unroll") for (int ai = 0; ai < 2; ++ai) _Pragma("unroll") for (int bj = 0; bj < 2; ++bj) _Pragma("unroll") for (int m = 0; m < 4; ++m) _Pragma("unroll") for (int n = 0; n < 2; ++n) _Pragma("unroll") for (int j = 0; j < 4; ++j) {
            int r = cur.pm * 256 + ai * 128 + wr * 64 + m * 16 + fr;
            int cl = Epi::PERM ? (bj * 128 + wc * 32 + 8 * fq + 4 * n + j) : (bj * 128 + wc * 32 + 16 * n + 4 * fq + j);
            long ar = r;
            if (GATHER) { int a = g.rowmap[r]; ar = a >= 0 ? (a >> 1) : 0; }
            const act_t* ap = g.A + ar * g.K; const act_t* bp = Bt + (long)cl * g.K;
            float s = 0.f;
            _Pragma("unroll 4") for (int k = 0; k < g.K; ++k) s += a2f(ap[k]) * a2f(bp[k]);
            acc[ai][bj][m][n][j] = s;
        }
        E(acc, cur, wr, wc, fr, fq);
    }
}
#ifdef EMU
template <class Epi, class Sched, bool GATHER>
void gemm_phase(unsigned char*, int wv, const Gemm g, const Sched& S, const Epi& E) { gemm_phase_ref<Epi, Sched, GATHER>(wv, g, S, E); }
#else
namespace pg8 {
#define PG8_LAS __attribute__((address_space(3)))
typedef short bf16x8 __attribute__((ext_vector_type(8)));
constexpr int BM = 256, BK = 64, HALF = 128, HTB = HALF * BK * 2, STAGE_BYTES = 8 * HTB;
__device__ __forceinline__ int lds_byte(int r, int c) { const int st = (r >> 4) * 2 + (c >> 5), rr = r & 15, cc = c & 31, ob = rr * 64 + cc * 2; return st * 1024 + (ob ^ (((ob >> 9) & 1) << 5)); }
__device__ __forceinline__ void stage_rc(int b, int& R, int& C) { const int st = b / 1024, sb = b % 1024, swz = sb ^ (((sb >> 9) & 1) << 5); R = (st >> 1) * 16 + swz / 64; C = (st & 1) * 32 + (swz % 64) / 2; }
__device__ __forceinline__ int perm32(int rho) { const int n = rho >> 4, i = rho & 15; return 8 * (i >> 2) + 4 * n + (i & 3); }
template <class Epi, class Sched, bool GATHER>
__device__ __forceinline__ void gemm_phase(PG8_LAS unsigned char* lds, int wv, const Gemm g, const Sched& S, const Epi& E) {
    const int tid = TIDX(), wid = __builtin_amdgcn_readfirstlane(tid >> 6), lane = tid & 63, wr = wid >> 2, wc = wid & 3, fr = lane & 15, fq = lane >> 4;
    const int K = g.K, nt = K / BK;
    unsigned voffA[2], voffB[2];
    unsigned gc0[2], gc1[2], gn0[2], gn1[2];
    int sR[2], sC[2];
#pragma unroll
    for (int i = 0; i < 2; ++i) { int R, C; stage_rc(tid * 16 + i * 8192, R, C); sR[i] = R; sC[i] = C; const int Rb = Epi::PERM ? ((R & ~31) + perm32(R & 31)) : R;
        voffA[i] = (unsigned)(R * K + C) * 2u; voffB[i] = (unsigned)(Rb * K + C) * 2u; }
    const size_t kstep = (size_t)(BK * 2);
    const size_t hstep = (size_t)HALF * K * 2;
    const size_t tstep = 2 * hstep;
    const unsigned ldsw = (unsigned)wid * 1024u;
    const int aoff = lds_byte(wr * 64 + fr, fq * 8), boff = lds_byte(wc * 32 + fr, fq * 8);
    auto g_offs = [&](const Unit& u, unsigned (&o0)[2], unsigned (&o1)[2]) {
#pragma unroll
        for (int i = 0; i < 2; ++i) {
            const int a0 = g.rowmap[u.pm * BM + sR[i]], a1 = g.rowmap[u.pm * BM + HALF + sR[i]];
            const int r0 = a0 >= 0 ? (a0 >> 1) : 0, r1 = a1 >= 0 ? (a1 >> 1) : 0;
            o0[i] = (unsigned)(r0 * K + sC[i]) * 2u; o1[i] = (unsigned)(r1 * K + sC[i]) * 2u;
        }
    };
#define PG8_SA(b, h) (((b) * 2 + (h)) * HTB)
#define PG8_SB(b, h) ((4 + (b) * 2 + (h)) * HTB)
#define PG8_STAGE(bufoff, gbase, voff) do { _Pragma("unroll") for (int _i = 0; _i < 2; ++_i) { unsigned _o = (voff)[_i]; if (GATHER) asm volatile("" : "+v"(_o)); \
        __builtin_amdgcn_global_load_lds((const unsigned*)((const char*)(gbase) + _o), (PG8_LAS unsigned*)(lds + (bufoff) + ldsw + _i * 8192), 16, 0, 0); } } while (0)
#define PG8_STAGE_A(bufoff, h, tile, koff, o0, o1) do { if constexpr (GATHER) { if (h) PG8_STAGE(bufoff, gA + (koff), o1); else PG8_STAGE(bufoff, gA + (koff), o0); } \
        else PG8_STAGE(bufoff, (tile) + (koff) + (h) * hstep, voffA); } while (0)
#define PG8_LDA(dst, b, h) do { _Pragma("unroll") for (int m = 0; m < 4; ++m) _Pragma("unroll") for (int k = 0; k < 2; ++k) dst[m][k] = *(const PG8_LAS bf16x8*)(lds + PG8_SA(b, h) + aoff + m * 2048 + k * 1024); } while (0)
#define PG8_LDB(dst, b, h) do { _Pragma("unroll") for (int n = 0; n < 2; ++n) _Pragma("unroll") for (int k = 0; k < 2; ++k) dst[n][k] = *(const PG8_LAS bf16x8*)(lds + PG8_SB(b, h) + boff + n * 2048 + k * 1024); } while (0)
#define PG8_MMA(ai, bj, At, Bt) do { __builtin_amdgcn_s_setprio(1); _Pragma("unroll") for (int m = 0; m < 4; ++m) _Pragma("unroll") for (int n = 0; n < 2; ++n) _Pragma("unroll") for (int k = 0; k < 2; ++k) \
        acc[ai][bj][m][n] = __builtin_amdgcn_mfma_f32_16x16x32_bf16(Bt[n][k], At[m][k], acc[ai][bj][m][n], 0, 0, 0); __builtin_amdgcn_s_setprio(0); } while (0)
#define PG8_WAIT_V(n) asm volatile("s_waitcnt vmcnt(" #n ")" ::: "memory")
#define PG8_WAIT_L(n) asm volatile("s_waitcnt lgkmcnt(" #n ")" ::: "memory")
#define PG8_BAR __builtin_amdgcn_s_barrier()
#define PG8_SCHED __builtin_amdgcn_sched_barrier(0)
    Unit cur, nxt; int ui = 0;
    if (!S.next(0, cur)) return;
    f32x4 acc[2][2][4][2];
#pragma unroll
    for (int a = 0; a < 2; ++a)
#pragma unroll
        for (int b = 0; b < 2; ++b)
#pragma unroll
            for (int m = 0; m < 4; ++m)
#pragma unroll
                for (int n = 0; n < 2; ++n) acc[a][b][m][n] = (f32x4){0.f, 0.f, 0.f, 0.f};
    bf16x8 At[4][2], B0[2][2], B1[2][2];
    const char* gA = (const char*)g.A;
    const char* cA = gA + (size_t)cur.pm * tstep;
    const char* cB = (const char*)S.b_base(cur, g);
    if constexpr (GATHER) g_offs(cur, gc0, gc1);
    {
        PG8_STAGE(PG8_SB(0, 0), cB, voffB); PG8_STAGE(PG8_SB(0, 1), cB + hstep, voffB); PG8_STAGE_A(PG8_SA(0, 0), 0, cA, 0, gc0, gc1); PG8_STAGE_A(PG8_SA(0, 1), 1, cA, 0, gc0, gc1);
        if (wr == 1) PG8_BAR;
        PG8_WAIT_V(2); PG8_BAR;
        PG8_STAGE(PG8_SB(1, 0), cB + kstep, voffB); PG8_STAGE_A(PG8_SA(1, 0), 0, cA, kstep, gc0, gc1); PG8_STAGE(PG8_SB(1, 1), cB + hstep + kstep, voffB);
        PG8_WAIT_V(6); PG8_BAR;
    }
    for (;;) {
        const bool has_next = S.next(ui + 1, nxt);
        const char* nA = has_next ? gA + (size_t)nxt.pm * tstep : cA;
        const char* nB = has_next ? (const char*)S.b_base(nxt, g) : cB;
        if constexpr (GATHER) { if (has_next) g_offs(nxt, gn0, gn1); else { gn0[0] = gc0[0]; gn0[1] = gc0[1]; gn1[0] = gc1[0]; gn1[1] = gc1[1]; } }
        for (int t = 0; t < nt; t += 2) {
            const bool last = (t == nt - 2);
            const size_t k1 = (size_t)(t + 1) * kstep;
            const char* tA = last ? nA : cA;
            const size_t k2 = last ? 0 : (size_t)(t + 2) * kstep, k3 = k2 + kstep;
            const char* b2 = last ? nB : cB + (size_t)(t + 2) * kstep; const char* b3 = b2 + kstep;
            unsigned w0[2], w1[2];
            if constexpr (GATHER) { w0[0] = last ? gn0[0] : gc0[0]; w0[1] = last ? gn0[1] : gc0[1]; w1[0] = last ? gn1[0] : gc1[0]; w1[1] = last ? gn1[1] : gc1[1]; }
            PG8_LDB(B0, 0, 0); PG8_LDB(B1, 0, 1); PG8_SCHED; PG8_LDA(At, 0, 0); PG8_STAGE_A(PG8_SA(1, 1), 1, cA, k1, gc0, gc1);
            PG8_WAIT_V(8); PG8_WAIT_L(0); PG8_BAR; PG8_MMA(0, 0, At, B0); PG8_MMA(0, 1, At, B1); PG8_BAR; PG8_SCHED;
            PG8_LDA(At, 0, 1); PG8_STAGE(PG8_SB(0, 0), b2, voffB); PG8_STAGE(PG8_SB(0, 1), b2 + hstep, voffB); PG8_STAGE_A(PG8_SA(0, 0), 0, tA, k2, w0, w1);
            PG8_WAIT_V(8); PG8_WAIT_L(0); PG8_BAR; PG8_MMA(1, 0, At, B0); PG8_MMA(1, 1, At, B1); PG8_BAR; PG8_SCHED;
            PG8_LDB(B0, 1, 0); PG8_LDB(B1, 1, 1); PG8_SCHED; PG8_LDA(At, 1, 0); PG8_STAGE_A(PG8_SA(0, 1), 1, tA, k2, w0, w1);
            PG8_WAIT_V(8); PG8_WAIT_L(0); PG8_BAR; PG8_MMA(0, 0, At, B0); PG8_MMA(0, 1, At, B1); PG8_BAR; PG8_SCHED;
            PG8_LDA(At, 1, 1); PG8_STAGE(PG8_SB(1, 0), b3, voffB); PG8_STAGE(PG8_SB(1, 1), b3 + hstep, voffB); PG8_STAGE_A(PG8_SA(1, 0), 0, tA, k3, w0, w1);
            PG8_WAIT_V(8); PG8_WAIT_L(0); PG8_BAR; PG8_MMA(1, 0, At, B0); PG8_MMA(1, 1, At, B1); PG8_BAR; PG8_SCHED;
        }
        if (wr == 0) PG8_BAR;
        { int fr2 = fr, fq2 = fq; asm volatile("" : "+v"(fr2), "+v"(fq2)); E(acc, cur, wr, wc, fr2, fq2); }
        if (!has_next) break;
#pragma unroll
        for (int a = 0; a < 2; ++a)
#pragma unroll
            for (int b = 0; b < 2; ++b)
#pragma unroll
                for (int m = 0; m < 4; ++m)
#pragma unroll
                    for (int n = 0; n < 2; ++n) acc[a][b][m][n] = (f32x4){0.f, 0.f, 0.f, 0.f};
        cur = nxt; cA = nA; cB = nB; ++ui;
        if constexpr (GATHER) { gc0[0] = gn0[0]; gc0[1] = gn0[1]; gc1[0] = gn1[0]; gc1[1] = gn1[1]; }
        if (wr == 1) PG8_BAR;
    }
    PG8_WAIT_V(0);
    PG8_BAR;
#undef PG8_SA
#undef PG8_SB
#undef PG8_STAGE
#undef PG8_STAGE_A
#undef PG8_LDA
#undef PG8_LDB
#undef PG8_MMA
#undef PG8_WAIT_V
#undef PG8_WAIT_L
#undef PG8_BAR
#undef PG8_SCHED
}
}
template <class Epi, class Sched, bool GATHER>
__device__ __forceinline__ void gemm_phase(unsigned char* lds, int wv, const Gemm g, const Sched& S, const Epi& E) {
    pg8::gemm_phase<Epi, Sched, GATHER>((PG8_LAS unsigned char*)lds, wv, g, S, E);
}
#endif

struct EpiPlain {
    static constexpr bool PERM = true;
    act_t* O; int ldc;
    __device__ __forceinline__ void operator()(const f32x4 (&acc)[2][2][4][2], const Unit& u, int wr, int wc, int fr, int fq) const {
        const int row0 = u.pm * 256 + wr * 64 + fr, col0 = u.pn * 256 + wc * 32 + 8 * fq;
        for (int ai = 0; ai < 2; ++ai) for (int m = 0; m < 4; ++m) {
            act_t* rowp = O + (size_t)(row0 + ai * 128 + m * 16) * ldc + col0;
            for (int bj = 0; bj < 2; ++bj) {
                float v[8];
                for (int j = 0; j < 4; ++j) { v[j] = acc[ai][bj][m][0][j]; v[4 + j] = acc[ai][bj][m][1][j]; }
                store8(rowp + bj * 128, v);
            }
            EPI_FENCE();
        }
    }
};
struct EpiProj {
    static constexpr bool PERM = true;
    act_t* O; float* loga; const float* rot; const float* ba;
    __device__ __forceinline__ void operator()(const f32x4 (&acc)[2][2][4][2], const Unit& u, int wr, int wc, int fr, int fq) const {
        const int row0 = u.pm * 256 + wr * 64 + fr;
        if (u.pn == 11) {
            const int col0 = wc * 32 + 8 * fq;
            for (int ai = 0; ai < 2; ++ai) for (int m = 0; m < 4; ++m) {
                float* rowp = loga + (size_t)(row0 + ai * 128 + m * 16) * 256 + col0;
                for (int bj = 0; bj < 2; ++bj) for (int n = 0; n < 2; ++n) {
                    f32x4 o;
                    for (int j = 0; j < 4; ++j) o[j] = log_sigmoid_fast(acc[ai][bj][m][n][j] + ba[col0 + bj * 128 + 4 * n + j]) * (1.0f / 16.0f);
                    *(f32x4*)(rowp + bj * 128 + 4 * n) = o;
                    EPI_FENCE();
                }
            }
        } else if (u.pn <= 1) {
            const bool lat = u.pm * 256 < NLAT;
            for (int ai = 0; ai < 2; ++ai) for (int m = 0; m < 4; ++m) {
                const int row = row0 + ai * 128 + m * 16;
                act_t* rowp = O + (size_t)row * PROJ_W + u.pn * 256 + wc * 64 + 8 * fq;
                float o1[8], o2[8];
                const float* rt = rot + ((size_t)(row % SEQ) * 32 + 8 * fq) * 2;
                for (int n = 0; n < 2; ++n) for (int j = 0; j < 4; ++j) {
                    float t1 = acc[ai][0][m][n][j], t2 = acc[ai][1][m][n][j];
                    float cs = 1.f, sn = 0.f;
                    if (lat) { cs = rt[(4 * n + j) * 2]; sn = rt[(4 * n + j) * 2 + 1]; }
                    o1[4 * n + j] = t1 * cs - t2 * sn;
                    o2[4 * n + j] = t1 * sn + t2 * cs;
                }
                store8(rowp, o1);
                store8(rowp + 32, o2);
                EPI_FENCE();
            }
        } else {
            const int col0 = u.pn * 256 + wc * 32 + 8 * fq;
            for (int ai = 0; ai < 2; ++ai) for (int m = 0; m < 4; ++m) {
                act_t* rowp = O + (size_t)(row0 + ai * 128 + m * 16) * PROJ_W + col0;
                for (int bj = 0; bj < 2; ++bj) {
                    float v[8];
                    for (int j = 0; j < 4; ++j) { v[j] = acc[ai][bj][m][0][j]; v[4 + j] = acc[ai][bj][m][1][j]; }
                    store8(rowp + bj * 128, v);
                }
                EPI_FENCE();
            }
        }
    }
};
struct EpiSwiglu {
    static constexpr bool PERM = true;
    act_t* H; int row_off;
    __device__ __forceinline__ void operator()(const f32x4 (&acc)[2][2][4][2], const Unit& u, int wr, int wc, int fr, int fq) const {
        const int row0 = u.pm * 256 + wr * 64 + fr - row_off, col0 = u.pn * 128 + wc * 32 + 8 * fq;
        for (int ai = 0; ai < 2; ++ai) for (int m = 0; m < 4; ++m) {
            float v[8];
            for (int n = 0; n < 2; ++n) for (int j = 0; j < 4; ++j) v[4 * n + j] = silu_f(acc[ai][0][m][n][j]) * acc[ai][1][m][n][j];
            store8(H + (size_t)(row0 + ai * 128 + m * 16) * DFF + col0, v);
            EPI_FENCE();
        }
    }
};
struct EpiMoeOut {
    static constexpr bool PERM = true;
    act_t* ys; const int* slot_asg; const float* tok_g;
    __device__ __forceinline__ void operator()(const f32x4 (&acc)[2][2][4][2], const Unit& u, int wr, int wc, int fr, int fq) const {
        const int row0 = u.pm * 256 + wr * 64 + fr, col0 = u.pn * 256 + wc * 32 + 8 * fq;
        for (int ai = 0; ai < 2; ++ai) for (int m = 0; m < 4; ++m) {
            const int as = slot_asg[row0 + ai * 128 + m * 16];
            if (as < 0) continue;
            const float gt = tok_g[as];
            act_t* rowp = ys + (size_t)as * DM + col0;
            for (int bj = 0; bj < 2; ++bj) {
                float v[8];
                for (int j = 0; j < 4; ++j) { v[j] = gt * acc[ai][bj][m][0][j]; v[4 + j] = gt * acc[ai][bj][m][1][j]; }
                store8(rowp + bj * 128, v);
            }
            EPI_FENCE();
        }
    }
};

__device__ __forceinline__ void transpose_item(const float* W, int Nsrc, int K, int k0, int n0, act_t* WT, int drow0, float scale, float* scr, int lane) {
    for (int i = 0; i < 32; ++i) { const int kk = 2 * i + (lane >> 5); scr[kk * 33 + (lane & 31)] = W[(size_t)(k0 + kk) * Nsrc + n0 + (lane & 31)]; }
    __syncthreads();
    const int c = lane & 7;
    for (int j = 0; j < 4; ++j) {
        const int n = (lane >> 3) + 8 * j; const float* s = scr + (8 * c) * 33 + n;
        float v[8];
        for (int q = 0; q < 8; ++q) v[q] = s[q * 33] * scale;
        store8(WT + (size_t)(drow0 + n) * K + k0 + 8 * c, v);
    }
    __syncthreads();
}
__device__ __forceinline__ int win_dest(int n0, float& scale) {
    scale = 1.0f;
    if (n0 < 512) {
        const int base = n0 & ~255, s = n0 & 255, h = s >> 6, hi = (s >> 5) & 1;
        if (n0 >= 256) scale = 0.125f;
        return base + hi * 128 + h * 32;
    }
    if (n0 >= O_GQ && n0 < O_GK) scale = 0.17677669529663687f;
    if (n0 < 1792) return n0;
    if (n0 == 1792) return -1;
    return n0 - 32;
}
__device__ __forceinline__ void st_convert_items(const Params& p, int wv, unsigned char* lds, int which  ) {
    const int tid = TIDX(), wave = tid >> 6, lane = tid & 63;
    float* scr = (float*)lds + wave * (64 * 33 + 16);
    const int gw = BIDX() * NW + wave, NGW = NBLK() * NW;
    const int I_IN = (DM / 64) * (DPROJ_IN / 32), I_OUT = (DM / 64) * (DM / 32), I_F1 = (DM / 64) * (DFF / 32), I_F2 = (DFF / 64) * (DM / 32);
    const int total = which == 0 ? (DEPTH * (I_IN + I_OUT) + 2 * I_F1 + I_F2) : NEXP * (2 * I_F1 + I_F2);
    const int trips = (total + NGW - 1) / NGW;
    for (int tr = 0; tr < trips; ++tr) {
        int it = tr * NGW + gw;
        const bool valid = it < total;
        if (!valid) it = 0;
        const float* W; int Nsrc, K, k0, n0, drow0; act_t* WT; float scale = 1.0f;
        if (which == 0) {
            if (it < DEPTH * I_IN) {
                const int l = it / I_IN, r = it % I_IN; const int nblk = DPROJ_IN / 32;
                W = p.in[I_W_IN] + (size_t)l * DM * DPROJ_IN; Nsrc = DPROJ_IN; K = DM; k0 = 64 * (r / nblk); n0 = 32 * (r % nblk);
                WT = p.win_t + (size_t)l * NPROJ_T * DM; drow0 = win_dest(n0, scale);
            } else if (it < DEPTH * (I_IN + I_OUT)) {
                const int q = it - DEPTH * I_IN; const int l = q / I_OUT, r = q % I_OUT; const int nblk = DM / 32;
                W = p.in[I_W_OUT] + (size_t)l * DM * DM; Nsrc = DM; K = DM; k0 = 64 * (r / nblk); n0 = 32 * (r % nblk);
                WT = p.wout_t + (size_t)l * DM * DM; drow0 = n0;
            } else {
                int q = it - DEPTH * (I_IN + I_OUT);
                if (q < 2 * I_F1) {
                    const int w3 = q / I_F1, r = q % I_F1; const int nblk = DFF / 32;
                    W = p.in[w3 ? I_FFN_W3 : I_FFN_W1]; Nsrc = DFF; K = DM; k0 = 64 * (r / nblk); n0 = 32 * (r % nblk);
                    WT = p.w13_t; drow0 = (n0 / 128) * 256 + w3 * 128 + (n0 % 128);
                } else {
                    const int r = q - 2 * I_F1; const int nblk = DM / 32;
                    W = p.in[I_FFN_W2]; Nsrc = DM; K = DFF; k0 = 64 * (r / nblk); n0 = 32 * (r % nblk);
                    WT = p.w2_t; drow0 = n0;
                }
            }
        } else {
            const int per = 2 * I_F1 + I_F2; const int e = it / per; int q = it % per;
            if (q < 2 * I_F1) {
                const int w3 = q / I_F1, r = q % I_F1; const int nblk = DFF / 32;
                W = p.in[w3 ? I_MOE_W3 : I_MOE_W1] + (size_t)e * DM * DFF; Nsrc = DFF; K = DM; k0 = 64 * (r / nblk); n0 = 32 * (r % nblk);
                WT = p.wmoe13 + (size_t)e * 2 * DFF * DM; drow0 = (n0 / 128) * 256 + w3 * 128 + (n0 % 128);
            } else {
                const int r = q - 2 * I_F1; const int nblk = DM / 32;
                W = p.in[I_MOE_W2] + (size_t)e * DFF * DM; Nsrc = DM; K = DFF; k0 = 64 * (r / nblk); n0 = 32 * (r % nblk);
                WT = p.wmoe2 + (size_t)e * DM * DFF; drow0 = n0;
            }
        }
        if (!valid || drow0 < 0) { __syncthreads(); __syncthreads(); continue; }
        transpose_item(W, Nsrc, K, k0, n0, WT, drow0, scale, scr, lane);
    }
}

__device__ __forceinline__ void st_prep(const Params& p, int wv, unsigned char* lds) {
    const int tid = TIDX(), nb = NBLK(), bid = BIDX();
    for (long it = (long)bid * NT + tid; it < (long)DEPTH * (BATCH + 1) * 6 * DM; it += (long)nb * NT) {
        int col = it % (6 * DM);
        int bb = (it / (6 * DM)) % (BATCH + 1);
        int l = it / (6 * DM * (BATCH + 1));
        const float* cv = bb < BATCH ? p.in[I_C] + bb * DM : p.in[I_CCTX];
        const float* w = p.in[I_ADA_W] + (long)l * DM * 6 * DM + col;
        float acc = p.in[I_ADA_B][l * 6 * DM + col];
#pragma unroll 4
        for (int k = 0; k < DM; ++k) acc += silu_f(cv[k]) * w[(long)k * 6 * DM];
        p.mod[it] = acc;
    }
    for (int it = bid * NT + tid; it < SEQ * 32; it += nb * NT) {
        int t = it / 32, f = it % 32;
        float pos = f < 16 ? (float)(t / GRID_W) : (float)(t % GRID_W);
        float inv = exp2f(-(float)(f & 15) * (13.287712379549449f / 16.0f));
        float ang = pos * inv;
        p.rot[it * 2] = cosf(ang);
        p.rot[it * 2 + 1] = sinf(ang);
    }
    for (int it = bid * NT + tid; it < FN / 2; it += nb * NT) {
        double ang = -2.0 * M_PI * (double)it / (double)FN;
        p.fft_tw[it * 2] = (float)cos(ang); p.fft_tw[it * 2 + 1] = (float)sin(ang);
    }
    for (long it = (long)bid * NT + tid; it < (long)DEPTH * 256 * DM; it += (long)nb * NT) {
        int k = it % DM; int c = (it / DM) % 256; int l = it / (DM * 256);
        int dir = c >> 7, j = c & 127;
        const float* wi = p.in[I_W_IN] + ((size_t)l * DM + k) * DPROJ_IN + 1792 + 16 * dir;
        const float* wa = p.in[I_GLA_WA] + ((size_t)(l * 2 + dir) * 16) * 128 + j;
        float s = 0.f;
        for (int i = 0; i < 16; ++i) s += wi[i] * wa[i * 128];
        p.win_t[((size_t)l * NPROJ_T + 2816 + c) * DM + k] = f2a(s);
    }
    {
        const int wave = tid >> 6, lane = tid & 63;
        float* h1 = (float*)lds + wave * 128;
        float* h2 = h1 + 64;
        const int per_layer = SEQ + CTXL;
        for (int base = bid * NW; base < DEPTH * per_layer; base += nb * NW) {
            int it = base + wave;
            int l = it / per_layer;
            int r = it % per_layer;
            int which = r < SEQ ? 0 : 1;
            int n = which ? CTXL : SEQ;
            int t = which ? r - SEQ : r;
            float* circ = p.filt + (long)l * FILT_LAYER_FLOATS;
            const float tn = (float)((double)t / (double)(n - 1));
            const float* fw1 = p.in[I_HY_FW1] + l * 33 * 64;
            const float* fw2 = p.in[I_HY_FW2] + l * 64 * 64;
            const float* fw3 = p.in[I_HY_FW3] + l * 64 * 512;
            const float fr = p.in[I_HY_FREQ][l * 64 + lane];
            float a = p.in[I_HY_FB1][l * 64 + lane] + tn * fw1[lane];
#pragma unroll 2
            for (int k = 0; k < 16; ++k) {
                double band = 1e-4 + (double)k * ((15.0 - 1e-4) / 15.0);
                double turns = band * (double)t / (double)n;
                float ang = (float)((turns - floor(turns)) * (2.0 * M_PI));
                a += cosf(ang) * fw1[(1 + k) * 64 + lane];
                a += -sinf(ang) * fw1[(17 + k) * 64 + lane];
            }
            h1[lane] = sinf(fr * a);
            __syncthreads();
            float a2 = p.in[I_HY_FB2][l * 64 + lane];
#pragma unroll 8
            for (int i = 0; i < 64; ++i) a2 += h1[i] * fw2[i * 64 + lane];
            h2[lane] = sinf(fr * a2);
            if (!which) p.hdn2[((size_t)l * SEQ + t) * 64 + lane] = h2[lane];
            __syncthreads();
#pragma unroll 1
            for (int cc = 0; cc < (which ? 8 : 0); ++cc) {
                int c = cc * 64 + lane;
                float f = 0.0f;
#pragma unroll 8
                for (int i = 0; i < 64; ++i) f += h2[i] * fw3[i * 512 + c];
                int w = c >> 8, ch = c & 255;
                float dec = fabsf(p.in[I_HY_DECAY][(l * 2 + w) * 256 + ch]);
                f *= expf(-tn * dec);
                if (w == 0) circ[(long)t * 256 + ch] = f;
                else if (t >= 1) circ[(long)(2 * n - t) * 256 + ch] = f;
                if (t == 0 && w == 1) circ[(long)n * 256 + ch] = 0.0f;
            }
            __syncthreads();
        }
    }
    for (int it = bid * NT + tid; it < DEPTH * 2 * 16 * 64; it += nb * NT) {
        const int n = it & 63, pg = it >> 6;
        double lre = p.in[I_S5_LAM_RE][it], lim = p.in[I_S5_LAM_IM][it];
        double dt = exp((double)p.in[I_S5_LOG_DT][pg]);
        double mag = exp(lre * dt);
        double lbr = mag * cos(lim * dt), lbi = mag * sin(lim * dt);
        double den = lre * lre + lim * lim;
        double cr = ((lbr - 1.0) * lre + lbi * lim) / den;
        double ci = (lbi * lre - (lbr - 1.0) * lim) / den;
        float* tb = p.s5tab + (size_t)it * 34;
        tb[0] = (float)lbr; tb[1] = (float)lbi;
#pragma unroll 1
        for (int q = 0; q < 16; ++q) {
            double br = p.in[I_S5_B_RE][((long)pg * 64 + n) * 16 + q], bi = p.in[I_S5_B_IM][((long)pg * 64 + n) * 16 + q];
            tb[2 + q] = (float)(cr * br - ci * bi);
            tb[18 + q] = (float)(cr * bi + ci * br);
        }
    }
    for (int it = bid * NT + tid; it < DEPTH * 2 * 16 * 65 * 64; it += nb * NT) {
        const int n = it & 63, tau = (it >> 6) % 65, pg = it / (65 * 64);
        const double lre = p.in[I_S5_LAM_RE][pg * 64 + n], lim = p.in[I_S5_LAM_IM][pg * 64 + n];
        const double dt = exp((double)p.in[I_S5_LOG_DT][pg]);
        const double mag = exp(lre * dt * (double)tau), ph = lim * dt * (double)tau;
        p.s5pw[(size_t)it * 2] = (float)(mag * cos(ph)); p.s5pw[(size_t)it * 2 + 1] = (float)(mag * sin(ph));
    }
    st_convert_items(p, wv, lds, 0);
}

__device__ __forceinline__ void st_prep2(const Params& p, int wv) {
    const int tid = TIDX(), wave = tid >> 6, lane = tid & 63;
    for (int base = BIDX() * NW; base < DEPTH * 256; base += NBLK() * NW) {
        int it = base + wave;
        int ch = it & 255, l = it >> 8;
        int n = CTXL;
        const float* circ = p.filt + (long)l * FILT_LAYER_FLOATS;
        double s = 0.0;
        for (int i = lane; i < 2 * n; i += 64) s += fabs((double)circ[(long)i * 256 + ch]);
        float hi = (float)s, lo = (float)(s - (double)hi);
        hi = wave_sum(hi); lo = wave_sum(lo);
        if (lane == 0) p.fnorm[it] = (float)(1.0 / ((double)hi + (double)lo));
    }
}

__device__ __forceinline__ void st_ln(const Params& p, int wv, int l, int mode) {
    const int tid = TIDX(), wave = tid >> 6, lane = tid & 63;
    const bool last = (l == DEPTH - 1);
    const int nrows = (mode == 0) ? NTOK : (last ? NLAT : NTOK);
    const bool moe = (l & 1);
    for (int base = BIDX() * NW; base < nrows; base += NBLK() * NW) {
        const int row = base + wave;
        const bool lat = row < NLAT;
        const float* modp = p.mod + ((long)l * (BATCH + 1) + row_modidx(row)) * 6 * DM;
        float v[16];
        float mu, rstd;
        if (mode == 0) {
            const float* src = lat ? p.in[I_X] + (long)row * DM : p.in[I_CTX] + (long)(row - NLAT) * DM;
            for (int i = 0; i < 16; ++i) v[i] = src[i * 64 + lane];
            ln_stats16(v, mu, rstd);
            for (int i = 0; i < 16; ++i) {
                int c = i * 64 + lane;
                p.u[(long)row * DM + c] = f2a((v[i] - mu) * rstd * (1.0f + modp[DM + c]) + modp[c]);
            }
        } else if (mode == 1) {
            const float* src = lat ? ((l == 0 ? p.in[I_X] : p.out) + (long)row * DM)
                                   : ((l == 0 ? p.in[I_CTX] : p.hctx) + (long)(row - NLAT) * DM);
            float* dst = lat ? p.out + (long)row * DM : p.hctx + (long)(row - NLAT) * DM;
            for (int i = 0; i < 16; ++i) {
                int c = i * 64 + lane;
                v[i] = ALPHA * src[c] + modp[2 * DM + c] * a2f(p.u[(long)row * DM + c]);
            }
            ln_stats16(v, mu, rstd);
            for (int i = 0; i < 16; ++i) {
                int c = i * 64 + lane;
                v[i] = (v[i] - mu) * rstd * p.in[I_LN_MIX_G][l * DM + c] + p.in[I_LN_MIX_B][l * DM + c];
                dst[c] = v[i];
            }
            ln_stats16(v, mu, rstd);
            for (int i = 0; i < 16; ++i) {
                int c = i * 64 + lane;
                p.u[(long)row * DM + c] = f2a((v[i] - mu) * rstd * (1.0f + modp[4 * DM + c]) + modp[3 * DM + c]);
            }
        } else {
            float* dst = lat ? p.out + (long)row * DM : p.hctx + (long)(row - NLAT) * DM;
            for (int i = 0; i < 16; ++i) {
                int c = i * 64 + lane;
                float f = moe ? (a2f(p.ys[(long)(row * 2) * DM + c]) + a2f(p.ys[(long)(row * 2 + 1) * DM + c]))
                              : a2f(p.u[(long)row * DM + c]);
                v[i] = ALPHA * dst[c] + modp[5 * DM + c] * f;
            }
            ln_stats16(v, mu, rstd);
            for (int i = 0; i < 16; ++i) {
                int c = i * 64 + lane;
                v[i] = (v[i] - mu) * rstd * p.in[I_LN_FFN_G][l * DM + c] + p.in[I_LN_FFN_B][l * DM + c];
                dst[c] = v[i];
            }
            if (l + 1 < DEPTH) {
                const float* modn = p.mod + ((long)(l + 1) * (BATCH + 1) + row_modidx(row)) * 6 * DM;
                ln_stats16(v, mu, rstd);
                for (int i = 0; i < 16; ++i) {
                    int c = i * 64 + lane;
                    p.u[(long)row * DM + c] = f2a((v[i] - mu) * rstd * (1.0f + modn[DM + c]) + modn[c]);
                }
            }
        }
    }
}

__device__ __forceinline__ void st_router(const Params& p, int wv, int l) {
    const int tid = TIDX(), wave = tid >> 6, lane = tid & 63;
    const int j = l / 2;
    const float* rw = p.in[I_ROUTER_W] + (long)j * DM * NEXP;
    const float* rb = p.in[I_ROUTER_B] + j * NEXP;
    int* cnt = (int*)(p.ctl + CTL_MOE);
    for (int i = BIDX() * NT + tid; i < MOE_CAP; i += NBLK() * NT) p.slot_asg[i] = -1;
    for (int base = BIDX() * NW; base < NLAT; base += NBLK() * NW) {
        const int row = base + wave;
        const float* modp = p.mod + ((long)l * (BATCH + 1) + row_modidx(row)) * 6 * DM;
        float v[16], mu, rstd;
        for (int i = 0; i < 16; ++i) v[i] = p.out[(long)row * DM + i * 64 + lane];
        ln_stats16(v, mu, rstd);
        float lg[NEXP];
        for (int e = 0; e < NEXP; ++e) lg[e] = 0.f;
        for (int i = 0; i < 16; ++i) {
            int c = i * 64 + lane;
            float vv = (v[i] - mu) * rstd * (1.0f + modp[4 * DM + c]) + modp[3 * DM + c];
            for (int e = 0; e < NEXP; ++e) lg[e] += vv * rw[c * NEXP + e];
        }
        for (int e = 0; e < NEXP; ++e) lg[e] = wave_sum(lg[e]) + rb[e];
        if (lane == 0) {
            int e1 = 0;
            for (int e = 1; e < NEXP; ++e) if (lg[e] > lg[e1]) e1 = e;
            int e2 = (e1 == 0) ? 1 : 0;
            for (int e = 0; e < NEXP; ++e) if (e != e1 && lg[e] > lg[e2]) e2 = e;
            float ex = expf(lg[e2] - lg[e1]);
            float g1 = 1.0f / (1.0f + ex);
            p.tok_e[row * 2] = e1; p.tok_e[row * 2 + 1] = e2;
            p.tok_g[row * 2] = g1; p.tok_g[row * 2 + 1] = ex * g1;
            atomicAdd(&cnt[e1], 1);
            atomicAdd(&cnt[e2], 1);
        }
    }
}
__device__ __forceinline__ void moe_offsets(const Params& p, int* pstart, int* pend) {
    const int* cnt = (const int*)(p.ctl + CTL_MOE);
    int acc = 0;
    for (int e = 0; e < NEXP; ++e) {
        int c = cnt[e];
        pstart[e] = acc;
        acc += (c + 255) / 256 * 256;
        pend[e] = acc;
    }
}
__device__ __forceinline__ void st_place(const Params& p, int wv) {
    const int tid = TIDX();
    int pstart[NEXP], pend[NEXP];
    moe_offsets(p, pstart, pend);
    int* fill = (int*)(p.ctl + CTL_MOE) + 8;
    for (int a = BIDX() * NT + tid; a < 2 * NLAT; a += NBLK() * NT) {
        int e = p.tok_e[a];
        int pos = atomicAdd(&fill[e], 1);
        int ps = 0;
        for (int q = 0; q < NEXP; ++q) ps = (q == e) ? pstart[q] : ps;
        p.slot_asg[ps + pos] = a;
    }
}

enum { G_PROJ, G_OUT, G_FFN1, G_FFN2, G_MFFN1, G_MFFN2 };
#ifndef REFMASK
#define REFMASK 0
#endif
#if defined(EMU)
#define GEMM_CALL(mode, EPI, SCH, GA) gemm_phase<EPI, SCH, GA>(lds, wv, g, S, E)
#else
#define GEMM_CALL(mode, EPI, SCH, GA) do { if ((REFMASK >> (mode)) & 1) gemm_phase_ref<EPI, SCH, GA>(wv, g, S, E); else gemm_phase<EPI, SCH, GA>(lds, wv, g, S, E); } while (0)
#endif
template <int MODE>
__device__ __forceinline__ void st_gemm(const Params& p, int wv, unsigned char* lds, int l, int pass) {
    const bool last = (l == DEPTH - 1);
    const int G = NBLK(), c = BIDX();
    if (MODE == G_PROJ) {
        Gemm g{p.u, p.win_t + (size_t)l * NPROJ_T * DM, NTOK, NPROJ_T, DM, nullptr};
        StaticOrder S; S.init(NTOK, NPROJ_T, G, c);
        EpiProj E{p.proj, p.loga, p.rot, p.in[I_GLA_BA] + l * 256};
        GEMM_CALL(G_PROJ, EpiProj, StaticOrder, false);
    } else if (MODE == G_OUT) {
        const int M = last ? NLAT : NTOK;
        Gemm g{p.mix, p.wout_t + (size_t)l * DM * DM, M, DM, DM, nullptr};
        StaticOrder S; S.init(M, DM, G, c);
        EpiPlain E{p.u, DM};
        GEMM_CALL(G_OUT, EpiPlain, StaticOrder, false);
    } else if (MODE == G_FFN1) {
        Gemm g{p.u, p.w13_t, NTOK, 2 * DFF, DM, nullptr};
        StaticOrder S; S.init(NTOK, 2 * DFF, G, c);
        EpiSwiglu E{p.proj, 0};
        GEMM_CALL(G_FFN1, EpiSwiglu, StaticOrder, false);
    } else if (MODE == G_FFN2) {
        Gemm g{p.proj, p.w2_t, NTOK, DM, DFF, nullptr};
        StaticOrder S; S.init(NTOK, DM, G, c);
        EpiPlain E{p.u, DM};
        GEMM_CALL(G_FFN2, EpiPlain, StaticOrder, false);
    } else {
        int pstart[NEXP], pend[NEXP];
        moe_offsets(p, pstart, pend);
        const int used = pend[NEXP - 1] / 256;
        const int t0 = pass * MOE_PT;
        int nt = used - t0; if (nt > MOE_PT) nt = MOE_PT;
        if (nt <= 0) return;
        MoeOrder S; S.t0 = t0;
        for (int e = 0; e < NEXP; ++e) S.pend[e] = pend[e];
        if (MODE == G_MFFN1) {
            S.so.init(nt * 256, 2 * DFF, G, c); S.estride = (size_t)2 * DFF * DM;
            Gemm g{p.u, p.wmoe13, nt * 256, 2 * DFF, DM, p.slot_asg};
            EpiSwiglu E{p.hch, t0 * 256};
            GEMM_CALL(G_MFFN1, EpiSwiglu, MoeOrder, true);
        } else {
            S.so.init(nt * 256, DM, G, c); S.estride = (size_t)DM * DFF;
            Gemm g{p.hch - (size_t)t0 * 256 * DFF, p.wmoe2, nt * 256, DM, DFF, nullptr};
            EpiMoeOut E{p.ys, p.slot_asg, p.tok_g};
            GEMM_CALL(G_MFFN2, EpiMoeOut, MoeOrder, false);
        }
    }
}

__device__ __forceinline__ void st_glu(const Params& p, int wv, unsigned char* lds, int l) {
    const int M = (l == DEPTH - 1) ? NLAT : NTOK;
    float(*As)[132] = (float(*)[132])lds;
    float(*Bs)[68] = (float(*)[68])(lds + 16 * 132 * 4);
    const float* W = p.in[I_S5_GLU_W] + (long)l * 256 * 256;
    const float* g = p.osum;
    const int tid = TIDX(), ty = tid >> 4, tx = tid & 15;
    const int ar = tid >> 2, ak = (tid & 3) * 4;
    const int bk = (tid >> 4) & 15, bc = (tid & 15) * 4;
    const int ntm = M / 128, ntn = 4;
    for (int tile = BIDX(); tile < ntm * ntn; tile += NBLK()) {
        const int m0 = (tile / ntn) * 128, n0 = (tile % ntn) * 64;
        float acc[4][4];
        for (int i = 0; i < 4; ++i) for (int j = 0; j < 4; ++j) acc[i][j] = 0.f;
        for (int k0 = 0; k0 < 256; k0 += 16) {
            for (int q = 0; q < 4; ++q) As[ak + q][ar] = g[(long)(m0 + ar) * 256 + k0 + ak + q];
            if (tid < 256) for (int q = 0; q < 4; ++q) Bs[bk][bc + q] = W[(k0 + bk) * 256 + n0 + bc + q];
            __syncthreads();
            for (int k = 0; k < 16; ++k) {
                float a[4], b[4];
                for (int i = 0; i < 4; ++i) a[i] = As[k][ty * 4 + i];
                for (int j = 0; j < 4; ++j) b[j] = Bs[k][tx * 4 + j];
                for (int i = 0; i < 4; ++i) for (int j = 0; j < 4; ++j) acc[i][j] += a[i] * b[j];
            }
            __syncthreads();
        }
        for (int i = 0; i < 4; ++i) for (int j = 0; j < 4; ++j) {
            int r = m0 + ty * 4 + i, c = n0 + tx * 4 + j;
            float gv = g[(long)r * 256 + c];
            p.mix[(long)r * DM + 512 + c] = f2a(gv * sigmoid_f(acc[i][j] + p.in[I_S5_GLU_B][l * 256 + c]));
        }
    }
}

__device__ __forceinline__ float hy_short(const Params& p, int l, int row, int c) {
    const bool lat = row < NLAT;
    const int n = lat ? SEQ : CTXL;
    const int t = lat ? row % SEQ : (row - NLAT) % CTXL;
    const float* cw = p.in[I_HY_CONV_W] + (long)l * 3 * 768;
    float s = p.in[I_HY_CONV_B][l * 768 + c];
    for (int jj = 0; jj < 3; ++jj) {
        int tt = t + jj - 1;
        if (tt >= 0 && tt < n) s += a2f(p.proj[(long)(row + jj - 1) * PROJ_W + O_HP + c]) * cw[jj * 768 + c];
    }
    return s;
}
__device__ __forceinline__ void st_hy_ctx_pre(const Params& p, int wv, int l, int bid, int nb) {
    const int tid = TIDX();
    for (long it = (long)bid * NT + tid; it < (long)NCTX * 256; it += (long)nb * NT) {
        int row = NLAT + (int)(it >> 8), ch = it & 255;
        p.hz[(long)row * 256 + ch] = f2a(hy_short(p, l, row, 256 + ch) * hy_short(p, l, row, 512 + ch));
    }
}
__device__ __forceinline__ void st_hy_ctx_conv(const Params& p, int wv, int l, int bid, int nb) {
    const int tid = TIDX();
    for (long it = (long)bid * NT + tid; it < (long)NCTX * 256; it += (long)nb * NT) {
        int row = NLAT + (int)(it >> 8), ch = it & 255;
        const int n = CTXL;
        const int t = (row - NLAT) % CTXL;
        const int rbase = row - t;
        const float* circ = p.filt + (long)l * FILT_LAYER_FLOATS;
        float acc = 0.f;
        for (int s2 = 0; s2 < n; ++s2) {
            int idx = t - s2; if (idx < 0) idx += 2 * n;
            acc += circ[(long)idx * 256 + ch] * a2f(p.hz[(long)(rbase + s2) * 256 + ch]);
        }
        float yv = acc * p.fnorm[l * 256 + ch];
        float z = a2f(p.hz[(long)row * 256 + ch]);
        float x0 = hy_short(p, l, row, ch);
        p.mix[(long)row * DM + 768 + ch] = f2a(x0 * (yv + z * p.in[I_HY_BIAS][l * 256 + ch]));
    }
}
struct cpx { float x, y; };
__device__ __forceinline__ cpx cmul(cpx a, cpx b) { cpx r; r.x = a.x * b.x - a.y * b.y; r.y = a.x * b.y + a.y * b.x; return r; }
__device__ __forceinline__ cpx cmulc(cpx a, cpx b) { cpx r; r.x = a.x * b.x + a.y * b.y; r.y = a.y * b.x - a.x * b.y; return r; }
__device__ __forceinline__ int fslot(int i) { return i + (i >> 5); }
#define FSLOTS (FN + (FN >> 5))
template <int NB, bool INV>
__device__ __forceinline__ void fft_pass(cpx* x, const cpx* tw, int shift, int tid) {
    for (int g = tid; g < (FN >> NB); g += NT) {
        const int low = g & ((1 << shift) - 1), high = g >> shift;
        const int base = (high << (shift + NB)) | low;
        cpx v[1 << NB];
#pragma unroll
        for (int j = 0; j < (1 << NB); ++j) v[j] = x[fslot(base | (j << shift))];
#pragma unroll
        for (int q = 0; q < NB; ++q) {
            const int lb = INV ? q : NB - 1 - q, ml = 1 << lb, gb = shift + lb;
#pragma unroll
            for (int j = 0; j < (1 << NB); ++j) {
                if (j & ml) continue;
                const int e = ((base | (j << shift)) & ((1 << gb) - 1)) << (FLOG - 1 - gb);
                const cpx w = tw[e];
                if (!INV) { cpx a = v[j], b2 = v[j + ml], d; v[j].x = a.x + b2.x; v[j].y = a.y + b2.y; d.x = a.x - b2.x; d.y = a.y - b2.y; v[j + ml] = cmul(d, w); }
                else { cpx a = v[j], b2 = cmulc(v[j + ml], w); v[j].x = a.x + b2.x; v[j].y = a.y + b2.y; v[j + ml].x = a.x - b2.x; v[j + ml].y = a.y - b2.y; }
            }
        }
#pragma unroll
        for (int j = 0; j < (1 << NB); ++j) x[fslot(base | (j << shift))] = v[j];
    }
    __syncthreads();
}
__device__ __forceinline__ void fft_fwd(cpx* x, const cpx* tw, int tid) {
#if FLOG == 13
    fft_pass<3, false>(x, tw, 10, tid); fft_pass<3, false>(x, tw, 7, tid); fft_pass<3, false>(x, tw, 4, tid); fft_pass<4, false>(x, tw, 0, tid);
#elif FLOG == 10
    fft_pass<3, false>(x, tw, 7, tid); fft_pass<3, false>(x, tw, 4, tid); fft_pass<4, false>(x, tw, 0, tid);
#else
    fft_pass<3, false>(x, tw, 6, tid); fft_pass<3, false>(x, tw, 3, tid); fft_pass<3, false>(x, tw, 0, tid);
#endif
}
__device__ __forceinline__ void fft_inv(cpx* x, const cpx* tw, int tid) {
#if FLOG == 13
    fft_pass<4, true>(x, tw, 0, tid); fft_pass<3, true>(x, tw, 4, tid); fft_pass<3, true>(x, tw, 7, tid); fft_pass<3, true>(x, tw, 10, tid);
#elif FLOG == 10
    fft_pass<4, true>(x, tw, 0, tid); fft_pass<3, true>(x, tw, 4, tid); fft_pass<3, true>(x, tw, 7, tid);
#else
    fft_pass<3, true>(x, tw, 0, tid); fft_pass<3, true>(x, tw, 3, tid); fft_pass<3, true>(x, tw, 6, tid);
#endif
}
__device__ __forceinline__ void fft_load_tw(const Params& p, cpx* tw, int tid) {
    for (int i = tid; i < FN / 2; i += NT) { tw[i].x = p.fft_tw[2 * i]; tw[i].y = p.fft_tw[2 * i + 1]; }
}
__device__ __forceinline__ void st_hy_spec(const Params& p, int wv, unsigned char* lds, int l, int bid, int nb) {
    const int tid = TIDX();
    cpx* x = (cpx*)lds; cpx* tw = x + FSLOTS; float* red = (float*)(tw + FN / 2);
    float* fwc = red; float* part = red + 128;
    if (bid < 256) fft_load_tw(p, tw, tid);
    for (int c = bid; c < 256; c += nb) {
        if (tid < 128) fwc[tid] = p.in[I_HY_FW3][(long)l * 64 * 512 + (tid & 63) * 512 + (tid >> 6) * 256 + c];
        __syncthreads();
        const float d0 = fabsf(p.in[I_HY_DECAY][(l * 2 + 0) * 256 + c]), d1 = fabsf(p.in[I_HY_DECAY][(l * 2 + 1) * 256 + c]);
        float asum = 0.f;
        for (int i = tid; i < FN; i += NT) {
            float val = 0.f;
            if (i != SEQ) {
                const int w = i > SEQ, t = w ? FN - i : i;
                const float* hd = p.hdn2 + ((size_t)l * SEQ + t) * 64;
                const float* fc = fwc + w * 64;
                float f = 0.f;
#pragma unroll 8
                for (int j = 0; j < 64; ++j) f += hd[j] * fc[j];
                const float tn = (float)((double)t / (double)(SEQ - 1));
                val = f * expf(-tn * (w ? d1 : d0));
            }
            x[fslot(i)].x = val; x[fslot(i)].y = 0.f;
            asum += fabsf(val);
        }
        asum = wave_sum(asum);
        if ((tid & 63) == 0) part[tid >> 6] = asum;
        __syncthreads();
        float tot = 0.f;
        for (int q = 0; q < NW; ++q) tot += part[q];
        const float sc = 1.0f / (tot * (float)FN);
        fft_fwd(x, tw, tid);
        float* H = p.hspec + (size_t)c * FN * 2;
        for (int i = tid; i < FN; i += NT) { cpx v = x[fslot(i)]; H[2 * i] = v.x * sc; H[2 * i + 1] = v.y * sc; }
        __syncthreads();
    }
}
__device__ __forceinline__ void st_hy_pre(const Params& p, int wv, unsigned char* lds, int l, int bid, int nb) {
    const int tid = TIDX(), wave = tid >> 6, lane = tid & 63;
    float* tile = (float*)lds;
    for (int u = bid; u < BATCH * (SEQ / 64); u += nb) {
        const int b = u / (SEQ / 64), t0 = (u % (SEQ / 64)) * 64;
        for (int e = tid; e < 64 * 256; e += NT) {
            const int r = e >> 8, ch = e & 255, row = b * SEQ + t0 + r;
            tile[r * 257 + ch] = hy_short(p, l, row, 256 + ch) * hy_short(p, l, row, 512 + ch);
        }
        __syncthreads();
        for (int c = wave; c < 256; c += NW) p.hz[((size_t)(b * 256 + c)) * SEQ + t0 + lane] = f2a(tile[lane * 257 + c]);
        __syncthreads();
    }
}
__device__ __forceinline__ void st_hy_fft(const Params& p, int wv, unsigned char* lds, int l, int bid, int nb) {
    const int tid = TIDX();
    cpx* x = (cpx*)lds; cpx* tw = x + FSLOTS;
    const int NPAIR = (BATCH + 1) / 2;
    if (bid < 256 * NPAIR) fft_load_tw(p, tw, tid);
    for (int u = bid; u < 256 * NPAIR; u += nb) {
        const int c = u / NPAIR, q = u % NPAIR, b1 = 2 * q, b2 = 2 * q + 1;
        act_t* z1 = p.hz + ((size_t)(b1 * 256 + c)) * SEQ;
        act_t* z2 = p.hz + ((size_t)((b2 < BATCH ? b2 : b1) * 256 + c)) * SEQ;
        for (int i = tid; i < FN; i += NT) {
            cpx v; v.x = 0.f; v.y = 0.f;
            if (i < SEQ) { v.x = a2f(z1[i]); v.y = (b2 < BATCH) ? a2f(z2[i]) : 0.f; }
            x[fslot(i)] = v;
        }
        __syncthreads();
        fft_fwd(x, tw, tid);
        const float* H = p.hspec + (size_t)c * FN * 2;
        for (int i = tid; i < FN; i += NT) { cpx h; h.x = H[2 * i]; h.y = H[2 * i + 1]; x[fslot(i)] = cmul(x[fslot(i)], h); }
        __syncthreads();
        fft_inv(x, tw, tid);
        for (int i = tid; i < SEQ; i += NT) { cpx v = x[fslot(i)]; z1[i] = f2a(v.x); if (b2 < BATCH) z2[i] = f2a(v.y); }
        __syncthreads();
    }
}
__device__ __forceinline__ void st_hy_post(const Params& p, int wv, unsigned char* lds, int l, int bid, int nb) {
    const int tid = TIDX(), wave = tid >> 6, lane = tid & 63;
    float* tile = (float*)lds;
    for (int u = bid; u < BATCH * (SEQ / 64); u += nb) {
        const int b = u / (SEQ / 64), t0 = (u % (SEQ / 64)) * 64;
        for (int c = wave; c < 256; c += NW) tile[lane * 257 + c] = a2f(p.hz[((size_t)(b * 256 + c)) * SEQ + t0 + lane]);
        __syncthreads();
        for (int e = tid; e < 64 * 256; e += NT) {
            const int r = e >> 8, ch = e & 255, row = b * SEQ + t0 + r;
            const float z = hy_short(p, l, row, 256 + ch) * hy_short(p, l, row, 512 + ch);
            const float x0 = hy_short(p, l, row, ch);
            p.mix[(long)row * DM + 768 + ch] = f2a(x0 * (tile[r * 257 + ch] + z * p.in[I_HY_BIAS][l * 256 + ch]));
        }
        __syncthreads();
    }
}
#define RC 128
#define NCH_CTX (CTXL / RC)
#define NCH_LAT (SEQ / RC)
#define NCHK (NCH_CTX + NCH_LAT)
__device__ __forceinline__ int chunk_row0(int b, int cidx) { return cidx < NCH_CTX ? NLAT + b * CTXL + cidx * RC : b * SEQ + (cidx - NCH_CTX) * RC; }
__device__ __forceinline__ int chunk_at(int dir, int k) { if (!dir) return k; return k < NCH_CTX ? NCH_CTX - 1 - k : NCH_CTX + (NCH_LAT - 1 - (k - NCH_CTX)); }
typedef short bf16x8v __attribute__((ext_vector_type(8)));
__device__ __forceinline__ f32x4 mm16(f32x4 acc, const act_t* A, int pa, const act_t* Bt, int pb, int K, int lane) {
#if defined(EMU)
    for (int r = 0; r < 4; ++r) {
        const act_t* ap = A + (4 * (lane >> 4) + r) * pa; const act_t* bp = Bt + (lane & 15) * pb;
        float sacc = 0.f;
        for (int k = 0; k < K; ++k) sacc += a2f(ap[k]) * a2f(bp[k]);
        acc[r] += sacc;
    }
    return acc;
#else
    const act_t* ap = A + (lane & 15) * pa + 8 * (lane >> 4); const act_t* bp = Bt + (lane & 15) * pb + 8 * (lane >> 4);
    for (int k0 = 0; k0 < K; k0 += 32) {
        const bf16x8v a = *(const bf16x8v*)(ap + k0), b = *(const bf16x8v*)(bp + k0);
        acc = __builtin_amdgcn_mfma_f32_16x16x32_bf16(a, b, acc, 0, 0, 0);
    }
    return acc;
#endif
}
#define RPK (RC + 8)
#define RPQ 72
__device__ __forceinline__ void st_ret_a(const Params& p, int wv, unsigned char* lds, int l, int bid, int nb) {
    const int tid = TIDX(), wave = tid >> 6, lane = tid & 63;
    act_t* kTf = (act_t*)lds; act_t* kTb = kTf + 64 * RPK; act_t* vT = kTb + 64 * RPK;
    for (int u = bid; u < BATCH * 4 * NCHK; u += nb) {
        const int cidx = u % NCHK, h = (u / NCHK) & 3, b = u / (NCHK * 4);
        const int row0 = chunk_row0(b, cidx);
        const float lgf = log_sigmoid_f(p.in[I_RET_DECAY][(l * 2 + 0) * 4 + h]), lgb = log_sigmoid_f(p.in[I_RET_DECAY][(l * 2 + 1) * 4 + h]);
        for (int e = tid; e < RC * 64; e += NT) {
            const int sx = e >> 6, d = e & 63;
            const act_t* pr = p.proj + (long)(row0 + sx) * PROJ_W;
            const float kv = a2f(pr[O_RK + h * 64 + d]);
            kTf[d * RPK + sx] = f2a(kv * expf(lgf * (float)(RC - 1 - sx)));
            kTb[d * RPK + sx] = f2a(kv * expf(lgb * (float)sx));
            vT[d * RPK + sx] = pr[O_RV + h * 64 + d];
        }
        __syncthreads();
        {
            const int dir = wave >> 2, db = wave & 3;
            const act_t* Ak = (dir ? kTb : kTf) + 16 * db * RPK;
            float* D = p.retD + ((size_t)(((b * 4 + h) * 2 + dir) * NCHK + cidx)) * 4096;
            for (int n = 0; n < 4; ++n) {
                f32x4 acc = (f32x4){0.f, 0.f, 0.f, 0.f};
                acc = mm16(acc, Ak, RPK, vT + 16 * n * RPK, RPK, RC, lane);
                for (int r = 0; r < 4; ++r) D[(16 * db + 4 * (lane >> 4) + r) * 64 + 16 * n + (lane & 15)] = acc[r];
            }
        }
        __syncthreads();
    }
}
__device__ __forceinline__ void st_ret_b(const Params& p, int wv, int l, int bid, int nb) {
    const int tid = TIDX();
    for (int it = bid * NT + tid; it < BATCH * 4 * 2 * 4096; it += nb * NT) {
        const int el = it & 4095, seq = it >> 12, dir = seq & 1, h = (seq >> 1) & 3;
        const float gC = expf((float)RC * log_sigmoid_f(p.in[I_RET_DECAY][(l * 2 + dir) * 4 + h]));
        float S = 0.f;
        for (int k = 0; k < NCHK; ++k) {
            float* ptr = p.retD + ((size_t)(seq * NCHK + chunk_at(dir, k))) * 4096 + el;
            const float Dv = *ptr;
            *ptr = S;
            S = gC * S + Dv;
        }
    }
}
__device__ __forceinline__ void st_ret_c(const Params& p, int wv, unsigned char* lds, int l, int bid, int nb) {
    const int tid = TIDX(), wave = tid >> 6, lane = tid & 63;
    const bool need_ctx = (l != DEPTH - 1);
    act_t* qs = (act_t*)lds; act_t* ks = qs + RC * RPQ; act_t* P = qs;
    act_t* vT = ks + RC * RPQ; act_t* qt = vT + 64 * RPK; act_t* ST = qt + RC * RPK; float* mt = (float*)(ST + 64 * RPK);
    float* of = (float*)qt;
    for (int u = bid; u < BATCH * 4 * NCHK; u += nb) {
        const int cidx = u % NCHK, h = (u / NCHK) & 3, b = u / (NCHK * 4);
        if (cidx < NCH_CTX && !need_ctx) continue;
        const int row0 = chunk_row0(b, cidx);
        const float lgf = log_sigmoid_f(p.in[I_RET_DECAY][(l * 2 + 0) * 4 + h]), lgb = log_sigmoid_f(p.in[I_RET_DECAY][(l * 2 + 1) * 4 + h]);
        for (int e = tid; e < RC * 64; e += NT) {
            const int sx = e >> 6, d = e & 63;
            const act_t* pr = p.proj + (long)(row0 + sx) * PROJ_W;
            const act_t qa = pr[O_RQ + h * 64 + d];
            const float qv = a2f(qa);
            qs[sx * RPQ + d] = qa;
            ks[sx * RPQ + d] = pr[O_RK + h * 64 + d];
            vT[d * RPK + sx] = pr[O_RV + h * 64 + d];
            qt[sx * RPK + d] = f2a(qv * expf(lgf * (float)(sx + 1)));
            qt[sx * RPK + 64 + d] = f2a(qv * expf(lgb * (float)(RC - sx)));
        }
        for (int e = tid; e < 2 * 4096; e += NT) {
            const int dir = e >> 12, d = (e >> 6) & 63, ee = e & 63;
            ST[ee * RPK + dir * 64 + d] = f2a(p.retD[((size_t)(((b * 4 + h) * 2 + dir) * NCHK + cidx)) * 4096 + d * 64 + ee]);
        }
        if (tid < 2 * RC - 1) { const int dl = tid - (RC - 1); mt[tid] = dl > 0 ? expf(lgf * (float)dl) : (dl < 0 ? expf(lgb * (float)(-dl)) : 2.0f); }
        __syncthreads();
        f32x4 racc[8];
        for (int n = 0; n < 8; ++n) { racc[n] = (f32x4){0.f, 0.f, 0.f, 0.f}; racc[n] = mm16(racc[n], qs + 16 * wave * RPQ, RPQ, ks + 16 * n * RPQ, RPQ, 64, lane); }
        __syncthreads();
        for (int n = 0; n < 8; ++n) for (int r = 0; r < 4; ++r) {
            const int t = 16 * wave + 4 * (lane >> 4) + r, sx = 16 * n + (lane & 15);
            P[t * RPK + sx] = f2a(racc[n][r] * mt[t - sx + RC - 1]);
        }
        __syncthreads();
        f32x4 oacc[4];
        for (int n = 0; n < 4; ++n) {
            oacc[n] = (f32x4){0.f, 0.f, 0.f, 0.f};
            oacc[n] = mm16(oacc[n], P + 16 * wave * RPK, RPK, vT + 16 * n * RPK, RPK, RC, lane);
            oacc[n] = mm16(oacc[n], qt + 16 * wave * RPK, RPK, ST + 16 * n * RPK, RPK, 128, lane);
        }
        __syncthreads();
        for (int n = 0; n < 4; ++n) for (int r = 0; r < 4; ++r) of[(16 * wave + 4 * (lane >> 4) + r) * 68 + 16 * n + (lane & 15)] = oacc[n][r];
        __syncthreads();
        for (int rr = 0; rr < 16; ++rr) {
            const int t = 16 * wave + rr, row = row0 + t, c = h * 64 + lane;
            const float o = of[t * 68 + lane];
            const float mu = wave_sum(o) * (1.0f / 64.0f);
            const float dd = o - mu;
            const float var = wave_sum(dd * dd) * (1.0f / 64.0f);
            const float yv = dd * (1.0f / sqrtf(var + LN_EPS)) * p.in[I_RET_GN_G][l * 256 + c] + p.in[I_RET_GN_B][l * 256 + c];
            p.mix[(long)row * DM + c] = f2a(yv * silu_f(a2f(p.proj[(long)row * PROJ_W + O_RG + c])));
        }
        __syncthreads();
    }
}
#define GC 64
#define GNCH_CTX (CTXL / GC)
#define GNCH_LAT (SEQ / GC)
#define GNCHK (GNCH_CTX + GNCH_LAT)
__device__ __forceinline__ int gchunk_row0(int b, int cidx) { return cidx < GNCH_CTX ? NLAT + b * CTXL + cidx * GC : b * SEQ + (cidx - GNCH_CTX) * GC; }
__device__ __forceinline__ int gchunk_at(int dir, int k) { if (!dir) return k; return k < GNCH_CTX ? GNCH_CTX - 1 - k : GNCH_CTX + (GNCH_LAT - 1 - (k - GNCH_CTX)); }
#define GP 72
__device__ __forceinline__ void gla_cumsum(const Params& p, float* cs, int row0, int h, int tid) {
    for (int e = tid; e < 2 * GC * 32; e += NT) {
        const int dir = e >> 11, t = (e >> 5) & 63, d = e & 31;
        cs[e] = p.loga[(long)(row0 + t) * 256 + dir * 128 + h * 32 + d];
    }
    __syncthreads();
    if (tid < 64) {
        const int dir = tid >> 5, d = tid & 31;
        float* c = cs + dir * GC * 32 + d;
        float run = 0.f;
        if (!dir) for (int t = 0; t < GC; ++t) { run += c[t * 32]; c[t * 32] = run; }
        else for (int t = GC - 1; t >= 0; --t) { run += c[t * 32]; c[t * 32] = run; }
    }
    __syncthreads();
}
__device__ __forceinline__ void st_gla_a(const Params& p, int wv, unsigned char* lds, int l, int bid, int nb) {
    const int tid = TIDX(), wave = tid >> 6, lane = tid & 63;
    float* cs = (float*)lds; act_t* kTf = (act_t*)(cs + 2 * GC * 32); act_t* kTb = kTf + 32 * GP; act_t* vT = kTb + 32 * GP;
    for (int u = bid; u < BATCH * 4 * GNCHK; u += nb) {
        const int cidx = u % GNCHK, h = (u / GNCHK) & 3, b = u / (GNCHK * 4);
        const int row0 = gchunk_row0(b, cidx);
        gla_cumsum(p, cs, row0, h, tid);
        for (int e = tid; e < GC * 32; e += NT) {
            const int sx = e >> 5, d = e & 31;
            const float kv = a2f(p.proj[(long)(row0 + sx) * PROJ_W + O_GK + h * 32 + d]);
            kTf[d * GP + sx] = f2a(kv * expf(cs[(GC - 1) * 32 + d] - cs[sx * 32 + d]));
            kTb[d * GP + sx] = f2a(kv * expf(cs[GC * 32 + d] - cs[GC * 32 + sx * 32 + d]));
        }
        for (int e = tid; e < GC * 64; e += NT) { const int sx = e >> 6, ee = e & 63; vT[ee * GP + sx] = p.proj[(long)(row0 + sx) * PROJ_W + O_GV + h * 64 + ee]; }
        const size_t ub = (size_t)(b * 4 + h) * 2;
        if (tid < 64) { const int dir = tid >> 5, d = tid & 31; p.glaE[((ub + dir) * GNCHK + cidx) * 32 + d] = expf(dir ? cs[GC * 32 + d] : cs[(GC - 1) * 32 + d]); }
        __syncthreads();
        {
            const int dir = wave >> 2, db = (wave >> 1) & 1, nh = wave & 1;
            float* D = p.glaD + ((ub + dir) * GNCHK + cidx) * 2048;
            for (int q = 0; q < 2; ++q) {
                const int n = nh * 2 + q;
                f32x4 acc = (f32x4){0.f, 0.f, 0.f, 0.f};
                acc = mm16(acc, (dir ? kTb : kTf) + 16 * db * GP, GP, vT + 16 * n * GP, GP, GC, lane);
                for (int r = 0; r < 4; ++r) D[(16 * db + 4 * (lane >> 4) + r) * 64 + 16 * n + (lane & 15)] = acc[r];
            }
        }
        __syncthreads();
    }
}
__device__ __forceinline__ void st_gla_b(const Params& p, int wv, int l, int bid, int nb) {
    const int tid = TIDX();
    for (int it = bid * NT + tid; it < BATCH * 4 * 2 * 2048; it += nb * NT) {
        const int el = it & 2047, seq = it >> 11, dir = seq & 1, d = el >> 6;
        float S = 0.f;
        for (int k = 0; k < GNCHK; ++k) {
            const int cidx = gchunk_at(dir, k);
            float* ptr = p.glaD + ((size_t)seq * GNCHK + cidx) * 2048 + el;
            const float Dv = *ptr;
            *ptr = S;
            S = p.glaE[((size_t)seq * GNCHK + cidx) * 32 + d] * S + Dv;
        }
    }
}
__device__ __forceinline__ void st_gla_c(const Params& p, int wv, unsigned char* lds, int l, int bid, int nb) {
    const int tid = TIDX(), wave = tid >> 6, lane = tid & 63;
    const bool need_ctx = (l != DEPTH - 1);
    float* cs = (float*)lds; act_t* qt = (act_t*)(cs + 2 * GC * 32); act_t* kt = qt + GC * GP; act_t* vT = kt + GC * GP; act_t* P = vT + 64 * GP; act_t* ST = P + GC * GP;
    float* of = (float*)(ST + 64 * GP);
    for (int u = bid; u < BATCH * 4 * GNCHK; u += nb) {
        const int cidx = u % GNCHK, h = (u / GNCHK) & 3, b = u / (GNCHK * 4);
        if (cidx < GNCH_CTX && !need_ctx) continue;
        const int row0 = gchunk_row0(b, cidx);
        gla_cumsum(p, cs, row0, h, tid);
        for (int e = tid; e < GC * 64; e += NT) {
            const int sx = e >> 6, c = e & 63, dir = c >> 5, d = c & 31;
            const act_t* pr = p.proj + (long)(row0 + sx) * PROJ_W;
            const float cv = cs[dir * GC * 32 + sx * 32 + d];
            qt[sx * GP + c] = f2a(a2f(pr[O_GQ + h * 32 + d]) * expf(cv));
            kt[sx * GP + c] = f2a(a2f(pr[O_GK + h * 32 + d]) * expf(-cv));
            vT[c * GP + sx] = pr[O_GV + h * 64 + c];
        }
        const size_t ub = (size_t)(b * 4 + h) * 2;
        for (int e = tid; e < 2 * 2048; e += NT) {
            const int dir = e >> 11, d = (e >> 6) & 31, ee = e & 63;
            ST[ee * GP + dir * 32 + d] = f2a(p.glaD[((ub + dir) * GNCHK + cidx) * 2048 + d * 64 + ee]);
        }
        __syncthreads();
        {
            const int rb = wave & 3, nh = wave >> 2;
            for (int q = 0; q < 2; ++q) {
                const int n = nh * 2 + q;
                f32x4 rf = (f32x4){0.f, 0.f, 0.f, 0.f}, rbk = (f32x4){0.f, 0.f, 0.f, 0.f};
                rf = mm16(rf, qt + 16 * rb * GP, GP, kt + 16 * n * GP, GP, 32, lane);
                rbk = mm16(rbk, qt + 16 * rb * GP + 32, GP, kt + 16 * n * GP + 32, GP, 32, lane);
                for (int r = 0; r < 4; ++r) {
                    const int t = 16 * rb + 4 * (lane >> 4) + r, sx = 16 * n + (lane & 15);
                    P[t * GP + sx] = f2a((sx <= t ? rf[r] : 0.f) + (sx >= t ? rbk[r] : 0.f));
                }
            }
        }
        __syncthreads();
        {
            const int rb = wave & 3, nh = wave >> 2;
            for (int q = 0; q < 2; ++q) {
                const int n = nh * 2 + q;
                f32x4 acc = (f32x4){0.f, 0.f, 0.f, 0.f};
                acc = mm16(acc, P + 16 * rb * GP, GP, vT + 16 * n * GP, GP, GC, lane);
                acc = mm16(acc, qt + 16 * rb * GP, GP, ST + 16 * n * GP, GP, 64, lane);
                for (int r = 0; r < 4; ++r) of[(16 * rb + 4 * (lane >> 4) + r) * 68 + 16 * n + (lane & 15)] = acc[r];
            }
        }
        __syncthreads();
        for (int rr = 0; rr < 8; ++rr) {
            const int t = 8 * wave + rr, row = row0 + t, c = h * 64 + lane;
            const float o = of[t * 68 + lane];
            const float ms = wave_sum(o * o) * (1.0f / 64.0f);
            const float yv = o * (1.0f / sqrtf(ms + LN_EPS)) * p.in[I_GLA_NORM_G][l * 256 + c];
            p.mix[(long)row * DM + 256 + c] = f2a(yv * silu_f(a2f(p.proj[(long)row * PROJ_W + O_GR + c])));
        }
        __syncthreads();
    }
}
#define SC 64
#define SNCHK ((CTXL + SEQ) / SC)
#define SNCOL (BATCH * SNCHK)
#define SNCT ((SNCOL + 15) / 16)
#define SPU (SC * 16 + 8)
#define SPH 264
__device__ __forceinline__ void st_s5_tables(const Params& p, int wv, int l, int bid, int nb) {
    const int tid = TIDX();
    for (int it = bid * NT + tid; it < 16 * 127 * 256; it += nb * NT) {
        const int pp = it & 15, pq = (it >> 4) & 15, dl = (it >> 8) % 127, g = it / (127 * 256);
        const int delta = dl - 63;
        float val = 0.f;
        for (int d = 0; d < 2; ++d) {
            if (d == 0 ? delta < 0 : delta > 0) continue;
            const int tau = delta < 0 ? -delta : delta, pg = (l * 2 + d) * 16 + g;
            const float* cre = p.in[I_S5_C_RE] + ((size_t)pg * 16 + pq) * 64; const float* cim = p.in[I_S5_C_IM] + ((size_t)pg * 16 + pq) * 64;
            const float* pw = p.s5pw + ((size_t)pg * 65 + tau) * 128;
            float acc = 0.f;
            for (int n = 0; n < 64; ++n) {
                const float* tb = p.s5tab + ((size_t)pg * 64 + n) * 34;
                const float wr = pw[2 * n], wi = pw[2 * n + 1], br = tb[2 + pp], bi = tb[18 + pp];
                const float vr = wr * br - wi * bi, vi = wr * bi + wi * br;
                acc += cre[n] * vr - cim[n] * vi;
            }
            val += acc;
        }
        p.s5Tc[it] = f2a(val);
    }
    for (int it = bid * NT + tid; it < 16 * 1024 * 256; it += nb * NT) {
        const int k = it & 255, row = (it >> 8) & 1023, g = it >> 18;
        const int d = k >> 7, ri = (k >> 6) & 1, n = k & 63, i = row >> 4, pq = row & 15, pg = (l * 2 + d) * 16 + g;
        const int ex = d ? SC - i : i + 1;
        const float cr = p.in[I_S5_C_RE][((size_t)pg * 16 + pq) * 64 + n], ci = p.in[I_S5_C_IM][((size_t)pg * 16 + pq) * 64 + n];
        const float wr = p.s5pw[(((size_t)pg * 65 + ex) * 64 + n) * 2], wi = p.s5pw[(((size_t)pg * 65 + ex) * 64 + n) * 2 + 1];
        p.s5Win[it] = f2a(ri ? -(cr * wi + ci * wr) : (cr * wr - ci * wi));
    }
    for (int it = bid * NT + tid; it < 16 * 2 * 128 * 1024; it += nb * NT) {
        const int k = it & 1023, nri = (it >> 10) & 127, d = (it >> 17) & 1, g = it >> 18;
        const int j = k >> 4, pp = k & 15, ri = nri >> 6, n = nri & 63, pg = (l * 2 + d) * 16 + g;
        const int ex = d ? j : SC - 1 - j;
        const float* tb = p.s5tab + ((size_t)pg * 64 + n) * 34;
        const float wr = p.s5pw[(((size_t)pg * 65 + ex) * 64 + n) * 2], wi = p.s5pw[(((size_t)pg * 65 + ex) * 64 + n) * 2 + 1];
        const float br = tb[2 + pp], bi = tb[18 + pp];
        p.s5Wend[it] = f2a(ri ? (wr * bi + wi * br) : (wr * br - wi * bi));
    }
}
__device__ __forceinline__ void s5_load_cols(const Params& p, act_t* U, int g, int ct, int tid) {
    for (int e = tid; e < 16 * SC * 16; e += NT) {
        const int pp = e & 15, j = (e >> 4) & 63, cl = e >> 10, col = ct * 16 + cl;
        act_t v = f2a(0.f);
        if (col < SNCOL) v = p.proj[(long)(gchunk_row0(col / SNCHK, col % SNCHK) + j) * PROJ_W + O_SU + g * 16 + pp];
        U[cl * SPU + j * 16 + pp] = v;
    }
}
__device__ __forceinline__ void st_s5_a(const Params& p, int wv, unsigned char* lds, int l, int bid, int nb) {
    const int tid = TIDX(), wave = tid >> 6, lane = tid & 63;
    act_t* U = (act_t*)lds;
    for (int u = bid; u < 16 * SNCT; u += nb) {
        const int ct = u % SNCT, g = u / SNCT;
        s5_load_cols(p, U, g, ct, tid);
        __syncthreads();
        for (int dir = 0; dir < 2; ++dir) {
            f32x4 acc = (f32x4){0.f, 0.f, 0.f, 0.f};
            acc = mm16(acc, p.s5Wend + ((size_t)(g * 2 + dir) * 128 + 16 * wave) * 1024, 1024, U, SPU, 1024, lane);
            const int col = ct * 16 + (lane & 15);
            if (col < SNCOL) {
                const int b = col / SNCHK, cidx = col % SNCHK;
                float* S = p.s5S + ((size_t)((b * 16 + g) * 2 + dir) * SNCHK + cidx) * 128;
                for (int r = 0; r < 4; ++r) S[16 * wave + 4 * (lane >> 4) + r] = acc[r];
            }
        }
        __syncthreads();
    }
}
__device__ __forceinline__ void st_s5_b(const Params& p, int wv, int l, int bid, int nb) {
    const int tid = TIDX();
    for (int it = bid * NT + tid; it < BATCH * 16 * 2 * 64; it += nb * NT) {
        const int n = it & 63, seq = it >> 6, dir = seq & 1, g = (seq >> 1) & 15, pg = (l * 2 + dir) * 16 + g;
        const float lr = p.s5pw[(((size_t)pg * 65 + SC) * 64 + n) * 2], li = p.s5pw[(((size_t)pg * 65 + SC) * 64 + n) * 2 + 1];
        float hr = 0.f, hi = 0.f;
        for (int k = 0; k < SNCHK; ++k) {
            float* S = p.s5S + ((size_t)seq * SNCHK + gchunk_at(dir, k)) * 128;
            const float sr = S[n], si = S[64 + n];
            S[n] = hr; S[64 + n] = hi;
            const float nr = lr * hr - li * hi + sr, ni = lr * hi + li * hr + si;
            hr = nr; hi = ni;
        }
    }
}
__device__ __forceinline__ f32x4 mm16_toep(f32x4 acc, const act_t* Tc, int i, const act_t* U, int lane) {
#if defined(EMU)
    for (int r = 0; r < 4; ++r) {
        const int pq = 4 * (lane >> 4) + r, cl = lane & 15;
        float sacc = 0.f;
        for (int j = 0; j < SC; ++j) for (int pp = 0; pp < 16; ++pp) sacc += a2f(Tc[((i - j + 63) * 16 + pq) * 16 + pp]) * a2f(U[cl * SPU + j * 16 + pp]);
        acc[r] += sacc;
    }
    return acc;
#else
    const int pq = lane & 15, kq = lane >> 4;
    const act_t* bp = U + (lane & 15) * SPU + 8 * kq;
    for (int ks = 0; ks < SC / 2; ++ks) {
        const int j = 2 * ks + (kq >> 1);
        const bf16x8v a = *(const bf16x8v*)(Tc + ((i - j + 63) * 16 + pq) * 16 + 8 * (kq & 1)), b = *(const bf16x8v*)(bp + ks * 32);
        acc = __builtin_amdgcn_mfma_f32_16x16x32_bf16(a, b, acc, 0, 0, 0);
    }
    return acc;
#endif
}
__device__ __forceinline__ void st_s5_c(const Params& p, int wv, unsigned char* lds, int l, int bid, int nb) {
    const int tid = TIDX(), wave = tid >> 6, lane = tid & 63;
    const bool need_ctx = (l != DEPTH - 1);
    act_t* U = (act_t*)lds; act_t* Hc = U + 16 * SPU; act_t* Tc = Hc + 16 * SPH;
    for (int u = bid; u < 16 * SNCT; u += nb) {
        const int ct = u % SNCT, g = u / SNCT;
        s5_load_cols(p, U, g, ct, tid);
        for (int e = tid; e < 16 * 256; e += NT) {
            const int k = e & 255, cl = e >> 8, col = ct * 16 + cl;
            float v = 0.f;
            if (col < SNCOL) v = p.s5S[((size_t)(((col / SNCHK) * 16 + g) * 2 + (k >> 7)) * SNCHK + col % SNCHK) * 128 + (k & 127)];
            Hc[cl * SPH + k] = f2a(v);
        }
        for (int e = tid; e < 127 * 256; e += NT) Tc[e] = p.s5Tc[(size_t)g * 127 * 256 + e];
        __syncthreads();
        const int col = ct * 16 + (lane & 15);
        const bool valid = col < SNCOL && (need_ctx || (col % SNCHK) >= GNCH_CTX);
        const int row0 = valid ? gchunk_row0(col / SNCHK, col % SNCHK) : 0;
        for (int i = wave; i < SC; i += NW) {
            f32x4 acc = (f32x4){0.f, 0.f, 0.f, 0.f};
            acc = mm16_toep(acc, Tc, i, U, lane);
            acc = mm16(acc, p.s5Win + ((size_t)g * 1024 + i * 16) * 256, 256, Hc, SPH, 256, lane);
            if (valid) {
                f32x4 o;
                for (int r = 0; r < 4; ++r) {
                    const int pq = 4 * (lane >> 4) + r;
                    const float yv = acc[r] + p.in[I_S5_D][l * 256 + g * 16 + pq] * a2f(U[(lane & 15) * SPU + i * 16 + pq]);
                    o[r] = gelu_tanh_f(yv);
                }
                *(f32x4*)(p.osum + (size_t)(row0 + i) * 256 + g * 16 + 4 * (lane >> 4)) = o;
            }
        }
        __syncthreads();
    }
}
__device__ __forceinline__ int scan_row(int b, int dir, int step, bool& isctx) {
    isctx = step < CTXL;
    if (isctx) { int t = dir ? CTXL - 1 - step : step; return NLAT + b * CTXL + t; }
    int s2 = step - CTXL; int t = dir ? SEQ - 1 - s2 : s2; return b * SEQ + t;
}
__device__ __forceinline__ void st_scan_ret(const Params& p, int wv, int l, int bid, int nb) {
    const int tid = TIDX();
    const bool need_ctx = (l != DEPTH - 1);
    for (int it = bid * NT + tid; it < BATCH * 256; it += nb * NT) {
        const int b = it >> 8, h = (it >> 6) & 3, e = it & 63;
        for (int dir = 0; dir < 2; ++dir) {
            float dec = p.in[I_RET_DECAY][(l * 2 + dir) * 4 + h];
            float g = expf(log_sigmoid_f(dec));
            float S[64];
            for (int d = 0; d < 64; ++d) S[d] = 0.f;
            for (int step = 0; step < CTXL + SEQ; ++step) {
                bool isctx; const int row = scan_row(b, dir, step, isctx);
                const act_t* pr = p.proj + (long)row * PROJ_W;
                float v = a2f(pr[O_RV + h * 64 + e]);
                float o = 0.f;
                for (int d = 0; d < 64; ++d) {
                    float k = a2f(pr[O_RK + h * 64 + d]);
                    float q = a2f(pr[O_RQ + h * 64 + d]);
                    S[d] = g * S[d] + k * v;
                    o += q * S[d];
                }
                if (!isctx || need_ctx) {
                    float* dst = p.osum + (long)row * 256 + h * 64 + e;
                    if (dir == 0) *dst = o; else *dst += o;
                }
            }
        }
    }
}
__device__ __forceinline__ void st_scan_gla(const Params& p, int wv, int l, int bid, int nb) {
    const int tid = TIDX();
    const bool need_ctx = (l != DEPTH - 1);
    for (int it = bid * NT + tid; it < BATCH * 256; it += nb * NT) {
        const int b = it >> 8, h = (it >> 6) & 3, e = it & 63;
        for (int dir = 0; dir < 2; ++dir) {
            float S[32];
            for (int d = 0; d < 32; ++d) S[d] = 0.f;
            for (int step = 0; step < CTXL + SEQ; ++step) {
                bool isctx; const int row = scan_row(b, dir, step, isctx);
                const act_t* pr = p.proj + (long)row * PROJ_W;
                const float* la = p.loga + (long)row * 256 + dir * 128 + h * 32;
                float v = a2f(pr[O_GV + h * 64 + e]);
                float o = 0.f;
                for (int d = 0; d < 32; ++d) {
                    float k = a2f(pr[O_GK + h * 32 + d]);
                    float q = a2f(pr[O_GQ + h * 32 + d]);
                    S[d] = expf(la[d]) * S[d] + k * v;
                    o += q * S[d];
                }
                if (!isctx || need_ctx) {
                    float* dst = p.osum + (long)row * 256 + h * 64 + e;
                    if (dir == 0) *dst = o; else *dst += o;
                }
            }
        }
    }
}
__device__ __forceinline__ void st_scan_s5(const Params& p, int wv, unsigned char* lds, int l, int bid, int nb) {
    const bool need_ctx = (l != DEPTH - 1);
    float* sh = (float*)lds;
    const int tid = TIDX(), gl = tid >> 6, n = tid & 63;
    float* hsh = sh + gl * 128;
    for (int blk = bid; blk < BATCH * 2; blk += nb) {
        const int b = blk >> 1, g = (blk & 1) * 8 + gl;
        for (int dir = 0; dir < 2; ++dir) {
            const int pg = (l * 2 + dir) * 16 + g;
            const float* tb = p.s5tab + ((size_t)pg * 64 + n) * 34;
            float bbr[16], bbi[16];
            for (int q = 0; q < 16; ++q) { bbr[q] = tb[2 + q]; bbi[q] = tb[18 + q]; }
            const float flr = tb[0], fli = tb[1];
            const float* cre = p.in[I_S5_C_RE] + ((long)pg * 16 + (n & 15)) * 64;
            const float* cim = p.in[I_S5_C_IM] + ((long)pg * 16 + (n & 15)) * 64;
            float hr = 0.f, hi = 0.f;
            for (int step = 0; step < CTXL + SEQ; ++step) {
                bool isctx; const int row = scan_row(b, dir, step, isctx);
                const act_t* uu = p.proj + (long)row * PROJ_W + O_SU + g * 16;
                float br = 0.f, bi = 0.f;
                for (int q = 0; q < 16; ++q) { float uv = a2f(uu[q]); br += bbr[q] * uv; bi += bbi[q] * uv; }
                float nr = flr * hr - fli * hi + br;
                float ni = flr * hi + fli * hr + bi;
                hr = nr; hi = ni;
                hsh[n] = hr; hsh[64 + n] = hi;
                __syncthreads();
                if (n < 16 && (!isctx || need_ctx)) {
                    float yv = 0.f;
                    for (int m = 0; m < 64; ++m) yv += cre[m] * hsh[m] - cim[m] * hsh[64 + m];
                    float* dst = p.osum + (long)row * 256 + g * 16 + n;
                    if (dir == 0) *dst = yv; else *dst += yv;
                }
                __syncthreads();
            }
        }
    }
}
__device__ __forceinline__ void st_finish(const Params& p, int wv, int l, int which) {
    const int tid = TIDX(), wave = tid >> 6, lane = tid & 63;
    const int nrows = (l == DEPTH - 1) ? NLAT : NTOK;
    for (int base = BIDX() * NW; base < nrows; base += NBLK() * NW) {
        const int row = base + wave;
        const act_t* pr = p.proj + (long)row * PROJ_W;
        for (int h = 0; h < 4; ++h) {
            int c = h * 64 + lane;
            float* op = p.osum + (long)row * 256 + c;
            float o = *op;
            if (which == 0) {
                float mu = wave_sum(o) * (1.0f / 64.0f);
                float d = o - mu;
                float var = wave_sum(d * d) * (1.0f / 64.0f);
                float yv = d * (1.0f / sqrtf(var + LN_EPS)) * p.in[I_RET_GN_G][l * 256 + c] + p.in[I_RET_GN_B][l * 256 + c];
                p.mix[(long)row * DM + c] = f2a(yv * silu_f(a2f(pr[O_RG + c])));
            } else if (which == 1) {
                float ms = wave_sum(o * o) * (1.0f / 64.0f);
                float yv = o * (1.0f / sqrtf(ms + LN_EPS)) * p.in[I_GLA_NORM_G][l * 256 + c];
                p.mix[(long)row * DM + 256 + c] = f2a(yv * silu_f(a2f(pr[O_GR + c])));
            } else {
                float yv = o + p.in[I_S5_D][l * 256 + c] * a2f(pr[O_SU + c]);
                *op = gelu_tanh_f(yv);
            }
        }
    }
}

#ifdef EMU
#define PHASE(call) emu_launch(EMU_GRID, NT, [&]() { unsigned char* lds = emu_lds(); (void)lds; call; })
#else
#define PHASE(call) do { call; GRID_BAR(); } while (0)
#endif

#ifndef PHMASK
#define PHMASK 0xffffffffu
#endif
#define PHASEN(i, call) do { if ((PHMASK >> (i)) & 1u) PHASE(call); } while (0)
#ifdef EMU
static void forward(const Params& p)
#else
__global__ void __launch_bounds__(NT, 2) fwd_megakernel(Params p)
#endif
{
#ifndef EMU
    extern __shared__ __attribute__((aligned(16))) unsigned char lds[];
    {
        volatile LAS unsigned* misc = (volatile LAS unsigned*)((LAS unsigned char*)lds + LDS_RING);
        if (threadIdx.x < 64) misc[threadIdx.x] = 0u;
        __syncthreads();
    }
    (void)xcd_barrier_post(p.ctl, (volatile LAS unsigned*)((LAS unsigned char*)lds + LDS_RING) + 8);
    const int wv = __builtin_amdgcn_readfirstlane(threadIdx.x >> 6);
#define nbk NBLK()
#define bidx BIDX()
#else
    const int nbk = EMU_GRID; const int wv = 0; (void)wv;
#define bidx ((int)blockIdx.x)
#endif
    PHASEN(1, st_prep(p, wv, lds));
    PHASEN(2, (st_prep2(p, wv), st_ln(p, wv, 0, 0), st_s5_tables(p, wv, 0, bidx, nbk)));
#pragma unroll 1
    for (int l = 0; l < DEPTH; ++l) {
        PHASEN(3, st_gemm<G_PROJ>(p, wv, lds, l, 0));
        PHASEN(4, (st_ret_a(p, wv, lds, l, bidx, nbk), st_gla_a(p, wv, lds, l, bidx, nbk), st_s5_a(p, wv, lds, l, bidx, nbk), st_hy_spec(p, wv, lds, l, bidx, nbk), st_hy_pre(p, wv, lds, l, bidx, nbk), (l == 0 ? st_hy_ctx_pre(p, wv, l, bidx, nbk) : (void)0)));
        PHASEN(5, (st_ret_b(p, wv, l, bidx, nbk), st_gla_b(p, wv, l, bidx, nbk), st_s5_b(p, wv, l, bidx, nbk)));
        PHASEN(6, (st_ret_c(p, wv, lds, l, bidx, nbk), st_gla_c(p, wv, lds, l, bidx, nbk), st_s5_c(p, wv, lds, l, bidx, nbk), st_hy_fft(p, wv, lds, l, bidx, nbk), (l == 0 ? st_hy_ctx_conv(p, wv, l, bidx, nbk) : (void)0)));
        PHASEN(7, st_hy_post(p, wv, lds, l, bidx, nbk));
        PHASEN(10, st_glu(p, wv, lds, l));
        PHASEN(11, st_gemm<G_OUT>(p, wv, lds, l, 0));
        if ((l & 1) == 0) {
            PHASEN(12, st_ln(p, wv, l, 1));
            PHASEN(13, st_gemm<G_FFN1>(p, wv, lds, l, 0));
            PHASEN(14, st_gemm<G_FFN2>(p, wv, lds, l, 0));
        } else {
            PHASEN(15, (st_ln(p, wv, l, 1), st_convert_items(p, wv, lds, 1)));
            PHASEN(16, st_router(p, wv, l));
            PHASEN(17, st_place(p, wv));
#pragma unroll 1
            for (int ps = 0; ps < MOE_NPASS; ++ps) {
                PHASEN(18, st_gemm<G_MFFN1>(p, wv, lds, l, ps));
                PHASEN(19, st_gemm<G_MFFN2>(p, wv, lds, l, ps));
            }
        }
        PHASEN(20, (st_ln(p, wv, l, 2), (l + 1 < DEPTH ? st_s5_tables(p, wv, l + 1, bidx, nbk) : (void)0)));
    }
}

static inline size_t align_up(size_t v, size_t a) { return (v + a - 1) / a * a; }
#ifdef EMU
Params g_dbg_params;
#endif

extern "C" void kernel_launch(void* const* d_in, const int* in_sizes, int n_in, void* d_out, int out_size, void* d_ws,
                              size_t ws_size, hipStream_t stream) {
    Params p{};
    for (int i = 0; i < N_IN; ++i) p.in[i] = (const float*)d_in[i];
    p.out = (float*)d_out;
    char* ws = (char*)d_ws;
    size_t off = 0;
    auto take = [&](size_t bytes) { char* r = ws + off; off = align_up(off + bytes, 256); return r; };
    const size_t A = sizeof(act_t);
    p.ctl = (unsigned*)take(CTL_WORDS * 4);
    const size_t big_a = (size_t)NTOK * PROJ_W * A + (size_t)NTOK * 256 * A;
    const size_t big_b = (size_t)NEXP * 3 * DM * DFF * A + (size_t)MOE_PT * 256 * DFF * A;
    const size_t big_c = big_a + (size_t)2 * 16 * 1024 * 256 * A;
    char* big = take(big_c > big_b ? big_c : big_b);
    p.proj = (act_t*)big;
    p.hz = (act_t*)(big + (size_t)NTOK * PROJ_W * A);
    p.wmoe13 = (act_t*)big;
    p.wmoe2 = p.wmoe13 + (size_t)NEXP * 2 * DFF * DM;
    p.hch = p.wmoe2 + (size_t)NEXP * DM * DFF;
    p.u = (act_t*)take((size_t)NTOK * DM * A > (size_t)NTOK * DM * 2 ? (size_t)NTOK * DM * A : (size_t)NTOK * DM * 2);
    p.retD = (float*)p.u;
    p.glaD = p.retD + (size_t)NTOK * 256;
    p.glaE = (float*)take((size_t)BATCH * 4 * 2 * ((CTXL + SEQ) / 64) * 32 * 4);
    char* mixr = take((size_t)NTOK * DM * A + (size_t)2 * NTOK * 256 * 4);
    p.mix = (act_t*)mixr;
    p.osum = (float*)(mixr + (size_t)NTOK * DM * A);
    p.loga = p.osum + (size_t)NTOK * 256;
    p.ys = (act_t*)mixr;
    p.win_t = (act_t*)take((size_t)DEPTH * NPROJ_T * DM * A);
    p.wout_t = (act_t*)take((size_t)DEPTH * DM * DM * A);
    p.w13_t = (act_t*)take((size_t)2 * DFF * DM * A);
    p.w2_t = (act_t*)take((size_t)DM * DFF * A);
    p.mod = (float*)take((size_t)DEPTH * (BATCH + 1) * 6 * DM * 4);
    p.hctx = (float*)take((size_t)NCTX * DM * 4);
    p.filt = (float*)take((size_t)DEPTH * FILT_LAYER_FLOATS * 4);
    p.fnorm = (float*)take((size_t)DEPTH * 256 * 4);
    p.hdn2 = (float*)take((size_t)DEPTH * SEQ * 64 * 4);
    p.fft_tw = (float*)take((size_t)FN * 4);
    p.hspec = (float*)take((size_t)256 * FN * 2 * 4);
    p.rot = (float*)take((size_t)SEQ * 32 * 2 * 4);
    p.s5tab = (float*)take((size_t)DEPTH * 2 * 16 * 64 * 34 * 4);
    p.s5pw = (float*)take((size_t)DEPTH * 2 * 16 * 65 * 64 * 2 * 4);
    p.s5Tc = (act_t*)take((size_t)16 * 127 * 256 * A);
    p.s5S = (float*)take((size_t)BATCH * 16 * 2 * ((CTXL + SEQ) / 64) * 128 * 4);
    p.s5Win = (act_t*)(big + big_a);
    p.s5Wend = p.s5Win + (size_t)16 * 1024 * 256;
    p.tok_e = (int*)take((size_t)NLAT * 2 * 4);
    p.tok_g = (float*)take((size_t)NLAT * 2 * 4);
    p.slot_asg = (int*)take((size_t)MOE_CAP * 4);
#ifdef EMU
    g_dbg_params = p;
    memset(p.ctl, 0, CTL_WORDS * 4);
    forward(p);
#else
    if (off > ws_size) return;
    static int grid_blocks = 0;
    if (!grid_blocks) {
        int dev = 0, cus = 0;
        (void)hipGetDevice(&dev);
        (void)hipDeviceGetAttribute(&cus, hipDeviceAttributeMultiprocessorCount, dev);
        (void)hipFuncSetAttribute((const void*)fwd_megakernel, hipFuncAttributeMaxDynamicSharedMemorySize, LDS_BYTES);
        grid_blocks = cus;
    }
    (void)hipMemsetAsync(p.ctl, 0, CTL_WORDS * 4, stream);
    hipLaunchKernelGGL(fwd_megakernel, dim3(grid_blocks), dim3(NT), LDS_BYTES, stream, p);
#endif
}
```

```cpp
#ifndef EMU
#include <hip/hip_runtime.h>
#endif
#include <stdint.h>
#include <math.h>

#ifndef BATCH
#define BATCH 8
#endif
#ifndef SEQ
#define SEQ 4096
#endif
#ifndef CTXL
#define CTXL 256
#endif
#define NT 512
#define NW 8
#define DM 1024
#define DEPTH 2
#define GRID_W 64
#define DPROJ_IN 2848
#define PROJ_W 2816
#define NPROJ_T 3072
#define DFF 2816
#define NEXP 8
#define NLAT (BATCH * SEQ)
#define NCTX (BATCH * CTXL)
#define NTOK (NLAT + NCTX)
#define MOE_CAP (2 * NLAT + NEXP * 256)
#define MOE_TILES (MOE_CAP / 256)
#ifndef MOE_PT
#define MOE_PT 64
#endif
#define MOE_NPASS ((MOE_TILES + MOE_PT - 1) / MOE_PT)
#define LN_EPS 1e-5f
#define ALPHA 1.4142135623730951f
#define O_RQ 0
#define O_RK 256
#define O_RV 512
#define O_RG 768
#define O_GQ 1024
#define O_GK 1152
#define O_GV 1280
#define O_GR 1536
#define O_SU 1792
#define O_HP 2048

enum { I_X, I_C, I_CTX, I_CCTX, I_ADA_W, I_ADA_B, I_W_IN, I_RET_DECAY, I_RET_GN_G, I_RET_GN_B, I_GLA_WA, I_GLA_BA,
       I_GLA_NORM_G, I_S5_LAM_RE, I_S5_LAM_IM, I_S5_LOG_DT, I_S5_B_RE, I_S5_B_IM, I_S5_C_RE, I_S5_C_IM, I_S5_D,
       I_S5_GLU_W, I_S5_GLU_B, I_HY_CONV_W, I_HY_CONV_B, I_HY_FW1, I_HY_FB1, I_HY_FREQ, I_HY_FW2, I_HY_FB2, I_HY_FW3,
       I_HY_DECAY, I_HY_BIAS, I_W_OUT, I_LN_MIX_G, I_LN_MIX_B, I_LN_FFN_G, I_LN_FFN_B, I_FFN_W1, I_FFN_W3, I_FFN_W2,
       I_ROUTER_W, I_ROUTER_B, I_MOE_W1, I_MOE_W3, I_MOE_W2, N_IN };

typedef float f32x4 __attribute__((ext_vector_type(4)));
typedef unsigned u32x4 __attribute__((ext_vector_type(4)));

#ifdef EMU_F32ACT
typedef float act_t;
__device__ __forceinline__ float a2f(act_t v) { return v; }
__device__ __forceinline__ act_t f2a(float f) { return f; }
#else
typedef unsigned short act_t;
__device__ __forceinline__ float a2f(act_t v) { union { unsigned u; float f; } c; c.u = ((unsigned)v) << 16; return c.f; }
__device__ __forceinline__ act_t f2a(float f) { union { unsigned u; float f; } c; c.f = f; unsigned u = c.u; u += 0x7fffu + ((u >> 16) & 1u); return (act_t)(u >> 16); }
#endif
__device__ __forceinline__ void store8(act_t* p, const float* v) {
#if defined(EMU)
    for (int i = 0; i < 8; ++i) p[i] = f2a(v[i]);
#else
    u32x4 w;
    w.x = (unsigned)f2a(v[0]) | ((unsigned)f2a(v[1]) << 16); w.y = (unsigned)f2a(v[2]) | ((unsigned)f2a(v[3]) << 16);
    w.z = (unsigned)f2a(v[4]) | ((unsigned)f2a(v[5]) << 16); w.w = (unsigned)f2a(v[6]) | ((unsigned)f2a(v[7]) << 16);
    *(u32x4*)p = w;
#endif
}

__device__ __forceinline__ void copy8(act_t* dst, const act_t* src) {
#if defined(EMU)
    for (int i = 0; i < 8; ++i) dst[i] = src[i];
#else
    *(u32x4*)dst = *(const u32x4*)src;
#endif
}
__device__ __forceinline__ void load8f(float* v, const act_t* src) {
#if defined(EMU)
    for (int i = 0; i < 8; ++i) v[i] = a2f(src[i]);
#else
    const u32x4 w = *(const u32x4*)src;
    v[0] = __builtin_bit_cast(float, w.x << 16); v[1] = __builtin_bit_cast(float, w.x & 0xffff0000u);
    v[2] = __builtin_bit_cast(float, w.y << 16); v[3] = __builtin_bit_cast(float, w.y & 0xffff0000u);
    v[4] = __builtin_bit_cast(float, w.z << 16); v[5] = __builtin_bit_cast(float, w.z & 0xffff0000u);
    v[6] = __builtin_bit_cast(float, w.w << 16); v[7] = __builtin_bit_cast(float, w.w & 0xffff0000u);
#endif
}
__device__ __forceinline__ void store4(act_t* p, const float* v) {
#if defined(EMU)
    for (int i = 0; i < 4; ++i) p[i] = f2a(v[i]);
#else
    typedef unsigned u32x2 __attribute__((ext_vector_type(2)));
    u32x2 w; w.x = (unsigned)f2a(v[0]) | ((unsigned)f2a(v[1]) << 16); w.y = (unsigned)f2a(v[2]) | ((unsigned)f2a(v[3]) << 16);
    *(u32x2*)p = w;
#endif
}
struct Params {
    const float* in[N_IN];
    float* out;
    unsigned* ctl;
    float* mod;
    act_t* proj;
    act_t* hz;
    act_t* wmoe13;
    act_t* wmoe2;
    act_t* hch;
    act_t* u;
    float* retD;
    float* glaD;
    float* glaE;
    act_t* mix;
    float* osum;
    act_t* gbuf;
    act_t* wglu_t;
    float* loga;
    act_t* ys;
    act_t* win_t;
    act_t* wout_t;
    act_t* w13_t;
    act_t* w2_t;
    float* hctx;
    float* filt;
    float* fnorm;
    float* hdn2;
    float* fft_tw;
    float* hspec;
    float* rot;
    float* s5tab;
    float* s5pw;
    act_t* s5Tc;
    act_t* s5Win;
    act_t* s5Wend;
    float* s5S;
    int* tok_e;
    float* tok_g;
    int* slot_asg;
};
#define CTL_MOE 4096
#define CTL_WORDS 4224
#define FILT_LAYER_FLOATS (2 * CTXL * 256)
#define FN (2 * SEQ)
#if SEQ == 4096
#define FLOG 13
#elif SEQ == 512
#define FLOG 10
#elif SEQ == 256
#define FLOG 9
#endif

#define LDS_RING 131072
#define LDS_BYTES 147456
#define LDS_MISC (LDS_BYTES - 256)
#ifdef EMU
#define GRID_BAR()
#else
#define LAS __attribute__((address_space(3)))
#define XB_TMO      128
#define XB_XCNT(j)  (256  + 64 * (j))
#define XB_XSUB(j)  (1280 + 64 * (j))
#define XB_XGEN(j)  (2304 + 64 * (j))
#define XB_TOP      3328
#define XB_TOPGEN   3392
#define XCD_BAR_WORDS 3456
#define XB_SPIN_CAP (1u << 26)
__device__ __forceinline__ unsigned xb_ld(unsigned* p)              { return __hip_atomic_load(p, __ATOMIC_RELAXED, __HIP_MEMORY_SCOPE_AGENT); }
__device__ __forceinline__ unsigned xb_add(unsigned* p, unsigned v) { return __hip_atomic_fetch_add(p, v, __ATOMIC_RELAXED, __HIP_MEMORY_SCOPE_AGENT); }
__device__ __forceinline__ unsigned xb_xcc_id() { return (unsigned)__builtin_amdgcn_s_getreg((3 << 11) | 20) & 0xFu; }
#define XB_SPIN(cond, bar) do { unsigned _sp = 0; while (cond) { __builtin_amdgcn_s_sleep(1); \
    if ((++_sp & 255u) == 0u) { if (xb_ld(&(bar)[XB_TMO])) break; if (_sp > XB_SPIN_CAP) { atomicAdd(&(bar)[XB_TMO], 1u); break; } } } } while (0)
struct XcdBarrier { unsigned* bar; unsigned x; volatile LAS unsigned* st; };
__device__ __forceinline__ XcdBarrier xcd_barrier_post(unsigned* bar, volatile LAS unsigned* st) {
    XcdBarrier b; b.bar = bar; b.x = xb_xcc_id(); b.st = st;
    if (threadIdx.x == 0) (void)xb_add(&bar[XB_XCNT(b.x)], 1u);
    return b;
}
__device__ __forceinline__ void xcd_barrier_complete(unsigned* bar, unsigned x, unsigned& nloc, unsigned& nx) {
    const unsigned G = gridDim.x * gridDim.y * gridDim.z;
    unsigned sum, cnt, mine, sp = 0u;
    for (;;) {
        sum = 0u; cnt = 0u; mine = 0u;
#pragma unroll
        for (unsigned j = 0; j < 16; ++j) { const unsigned c = xb_ld(&bar[XB_XCNT(j)]); sum += c; cnt += (c > 0u) ? 1u : 0u; mine = (j == x) ? c : mine; }
        if (sum == G) break;
        __builtin_amdgcn_s_sleep(1);
        if ((++sp & 255u) == 0u) { if (xb_ld(&bar[XB_TMO])) break; if (sp > XB_SPIN_CAP) { atomicAdd(&bar[XB_TMO], 1u); break; } }
    }
    nloc = mine > 0u ? mine : 1u; nx = cnt > 0u ? cnt : 1u;
}
__device__ __forceinline__ void xcd_barrier(const XcdBarrier& b) {
    asm volatile("s_waitcnt vmcnt(0)" ::: "memory");
    __syncthreads();
    if (threadIdx.x == 0) {
        unsigned* bar = b.bar;
        __builtin_amdgcn_s_waitcnt(0);
        unsigned nloc = b.st[0], nx = b.st[1];
        if (nloc == 0u) { xcd_barrier_complete(bar, b.x, nloc, nx); b.st[0] = nloc; b.st[1] = nx; }
        const unsigned old = xb_add(&bar[XB_XSUB(b.x)], 1u);
        const unsigned gen = old / nloc;
        if (old + 1u == (gen + 1u) * nloc) {
            __builtin_amdgcn_fence(__ATOMIC_RELEASE, "agent");
            asm volatile("s_waitcnt vmcnt(0)" ::: "memory");
            const unsigned og = xb_add(&bar[XB_TOP], 1u);
            const unsigned tg = og / nx;
            if (og + 1u == (tg + 1u) * nx) xb_add(&bar[XB_TOPGEN], 1u);
            else XB_SPIN(xb_ld(&bar[XB_TOPGEN]) == tg, bar);
            __builtin_amdgcn_fence(__ATOMIC_ACQUIRE, "agent");
            xb_add(&bar[XB_XGEN(b.x)], 1u);
            asm volatile("s_waitcnt vmcnt(0)" ::: "memory");
        } else {
            XB_SPIN(xb_ld(&bar[XB_XGEN(b.x)]) == gen, bar);
            __builtin_amdgcn_fence(__ATOMIC_ACQUIRE, "agent");
            asm volatile("s_waitcnt vmcnt(0)" ::: "memory");
        }
    }
    __syncthreads();
}
#define GRID_BAR() do { XcdBarrier _b; _b.bar = p.ctl; _b.x = xb_xcc_id(); _b.st = (volatile LAS unsigned*)((LAS unsigned char*)lds + LDS_MISC) + 8; xcd_barrier(_b); } while (0)
#endif

#ifdef EMU
#define TIDX() ((int)threadIdx.x)
#define BIDX() ((int)blockIdx.x)
#define NBLK() ((int)gridDim.x)
#else
#define BIDX() bid_opaque()
#define NBLK() nblk_opaque()
__device__ __forceinline__ int tid_opaque(int wv) { int t; asm volatile("v_mbcnt_lo_u32_b32 %0, -1, 0\n\tv_mbcnt_hi_u32_b32 %0, -1, %0\n\tv_lshl_add_u32 %0, %1, 6, %0" : "=&v"(t) : "s"(wv)); return t; }
#define TIDX() tid_opaque(wv)
__device__ __forceinline__ int bid_opaque() { int t = blockIdx.x; asm volatile("" : "+s"(t)); return t; }
__device__ __forceinline__ int nblk_opaque() { int t = gridDim.x; asm volatile("" : "+s"(t)); return t; }
#endif
#ifdef EMU
__device__ __forceinline__ float wave_sum(float v) {
    for (int o = 32; o > 0; o >>= 1) v += __shfl_xor(v, o);
    return v;
}
#else
__device__ __forceinline__ float wave_sum(float v) {
#define WS_STEP(m) v += __builtin_bit_cast(float, __builtin_amdgcn_ds_swizzle(__builtin_bit_cast(int, v), ((m) << 10) | 0x1f))
    WS_STEP(1); WS_STEP(2); WS_STEP(4); WS_STEP(8); WS_STEP(16);
#undef WS_STEP
    float a = v, b = v;
    asm volatile("s_nop 1\n\tv_permlane32_swap_b32 %0, %1" : "+v"(a), "+v"(b));
    return a + b;
}
#endif
__device__ __forceinline__ float silu_f(float x) { return x / (1.0f + expf(-x)); }
__device__ __forceinline__ float sigmoid_f(float x) { return 1.0f / (1.0f + expf(-x)); }
__device__ __forceinline__ float log_sigmoid_f(float x) { return fminf(x, 0.0f) - log1pf(expf(-fabsf(x))); }
#ifdef EMU
#define EPI_FENCE()
__device__ __forceinline__ float log_sigmoid_fast(float x) { return log_sigmoid_f(x); }
#else
#define EPI_FENCE() asm volatile("" ::: "memory")
__device__ __forceinline__ float log_sigmoid_fast(float x) { return fminf(x, 0.0f) - __logf(1.0f + __expf(-fabsf(x))); }
#endif
__device__ __forceinline__ float gelu_tanh_f(float x) {
    return 0.5f * x * (1.0f + tanhf(0.7978845608028654f * (x + 0.044715f * x * x * x)));
}
__device__ __forceinline__ void ln_stats16(const float* v, float& mu, float& rstd) {
    float s = 0.f;
    for (int i = 0; i < 16; ++i) s += v[i];
    s = wave_sum(s);
    mu = s * (1.0f / DM);
    float q = 0.f;
    for (int i = 0; i < 16; ++i) { float d = v[i] - mu; q += d * d; }
    q = wave_sum(q);
    rstd = 1.0f / sqrtf(q * (1.0f / DM) + LN_EPS);
}
__device__ __forceinline__ int row_modidx(int row) { return row < NLAT ? row / SEQ : BATCH; }

struct Unit { int pm, pn; };
struct Gemm { const act_t* A; const act_t* Bt; int M, N, K; const int* rowmap; };
#define GBM 256
#define GNXCD 8
#define GWGM 8
struct StaticOrder {
    int nM, nN, nwg, G, c;
    __device__ void init(int M, int N, int G_, int c_) { nM = M / GBM; nN = N / GBM; nwg = nM * nN; G = G_; c = c_; }
    __device__ bool next(int i, Unit& u) const {
        const long L = (long)i * G + c; if (L >= nwg) return false;
        int wgid = (int)L; { const int q = nwg / GNXCD, r = nwg % GNXCD, xcd = wgid % GNXCD, off = wgid / GNXCD; wgid = (xcd < r ? xcd * (q + 1) : r * (q + 1) + (xcd - r) * q) + off; }
        const int nig = GWGM * nN, gid = wgid / nig, fm = gid * GWGM, gsz = (nM - fm) < GWGM ? (nM - fm) : GWGM;
        u.pm = fm + ((wgid % nig) % gsz); u.pn = (wgid % nig) / gsz; return true;
    }
    __device__ __forceinline__ const act_t* b_base(const Unit& u, const Gemm& g) const { return g.Bt + (size_t)u.pn * GBM * g.K; }
};
struct MoeOrder {
    StaticOrder so; int t0; int pend[NEXP]; size_t estride;
    __device__ bool next(int i, Unit& u) const { if (!so.next(i, u)) return false; u.pm += t0; return true; }
    __device__ __forceinline__ const act_t* b_base(const Unit& u, const Gemm& g) const {
        int e = 0;
#pragma unroll
        for (int q = 0; q < NEXP - 1; ++q) e += (u.pm * 256 >= pend[q]) ? 1 : 0;
        return g.Bt + (size_t)e * estride + (size_t)u.pn * GBM * g.K;
    }
};

template <class Epi, class Sched, bool GATHER>
__device__ __forceinline__ void gemm_phase_ref(int wv, const Gemm g, const Sched& S, const Epi& E) {
    const int tid = TIDX(), wid = tid >> 6, lane = tid & 63, wr = wid >> 2, wc = wid & 3, fr = lane & 15, fq = lane >> 4;
    Unit cur;
    for (int ui = 0; S.next(ui, cur); ++ui) {
        f32x4 acc[2][2][4][2];
        const act_t* Bt = S.b_base(cur, g);
        _Pragma("unroll") for (int ai = 0; ai < 2; ++ai) _Pragma("unroll") for (int bj = 0; bj < 2; ++bj) _Pragma("unroll") for (int m = 0; m < 4; ++m) _Pragma("unroll") for (int n = 0; n < 2; ++n) _Pragma("unroll") for (int j = 0; j < 4; ++j) {
            int r = cur.pm * 256 + ai * 128 + wr * 64 + m * 16 + fr;
            int cl = Epi::PERM ? (bj * 128 + wc * 32 + 8 * fq + 4 * n + j) : (bj * 128 + wc * 32 + 16 * n + 4 * fq + j);
            long ar = r;
            if (GATHER) { int a = g.rowmap[r]; ar = a >= 0 ? (a >> 1) : 0; }
            const act_t* ap = g.A + ar * g.K; const act_t* bp = Bt + (long)cl * g.K;
            float s = 0.f;
            _Pragma("unroll 4") for (int k = 0; k < g.K; ++k) s += a2f(ap[k]) * a2f(bp[k]);
            acc[ai][bj][m][n][j] = s;
        }
        E(acc, cur, wr, wc, fr, fq);
    }
}
#ifdef EMU
template <class Epi, class Sched, bool GATHER>
void gemm_phase(unsigned char*, int wv, const Gemm g, const Sched& S, const Epi& E) { gemm_phase_ref<Epi, Sched, GATHER>(wv, g, S, E); }
#else
namespace pg8 {
#define PG8_LAS __attribute__((address_space(3)))
typedef short bf16x8 __attribute__((ext_vector_type(8)));
constexpr int BM = 256, BK = 64, HALF = 128, HTB = HALF * BK * 2, STAGE_BYTES = 8 * HTB;
__device__ __forceinline__ int lds_byte(int r, int c) { const int st = (r >> 4) * 2 + (c >> 5), rr = r & 15, cc = c & 31, ob = rr * 64 + cc * 2; return st * 1024 + (ob ^ (((ob >> 9) & 1) << 5)); }
__device__ __forceinline__ void stage_rc(int b, int& R, int& C) { const int st = b / 1024, sb = b % 1024, swz = sb ^ (((sb >> 9) & 1) << 5); R = (st >> 1) * 16 + swz / 64; C = (st & 1) * 32 + (swz % 64) / 2; }
__device__ __forceinline__ int perm32(int rho) { const int n = rho >> 4, i = rho & 15; return 8 * (i >> 2) + 4 * n + (i & 3); }
template <class Epi, class Sched, bool GATHER>
__device__ __forceinline__ void gemm_phase(PG8_LAS unsigned char* lds, int wv, const Gemm g, const Sched& S, const Epi& E) {
    const int tid = TIDX(), wid = __builtin_amdgcn_readfirstlane(tid >> 6), lane = tid & 63, wr = wid >> 2, wc = wid & 3, fr = lane & 15, fq = lane >> 4;
    const int K = g.K, nt = K / BK;
    unsigned voffA[2], voffB[2];
    unsigned gc0[2], gc1[2], gn0[2], gn1[2];
    int sR[2], sC[2];
#pragma unroll
    for (int i = 0; i < 2; ++i) { int R, C; stage_rc(tid * 16 + i * 8192, R, C); sR[i] = R; sC[i] = C; const int Rb = Epi::PERM ? ((R & ~31) + perm32(R & 31)) : R;
        voffA[i] = (unsigned)(R * K + C) * 2u; voffB[i] = (unsigned)(Rb * K + C) * 2u; }
    const size_t kstep = (size_t)(BK * 2);
    const size_t hstep = (size_t)HALF * K * 2;
    const size_t tstep = 2 * hstep;
    const unsigned ldsw = (unsigned)wid * 1024u;
    const int aoff = lds_byte(wr * 64 + fr, fq * 8), boff = lds_byte(wc * 32 + fr, fq * 8);
    auto g_offs = [&](const Unit& u, unsigned (&o0)[2], unsigned (&o1)[2]) {
#pragma unroll
        for (int i = 0; i < 2; ++i) {
            const int a0 = g.rowmap[u.pm * BM + sR[i]], a1 = g.rowmap[u.pm * BM + HALF + sR[i]];
            const int r0 = a0 >= 0 ? (a0 >> 1) : 0, r1 = a1 >= 0 ? (a1 >> 1) : 0;
            o0[i] = (unsigned)(r0 * K + sC[i]) * 2u; o1[i] = (unsigned)(r1 * K + sC[i]) * 2u;
        }
    };
#define PG8_SA(b, h) (((b) * 2 + (h)) * HTB)
#define PG8_SB(b, h) ((4 + (b) * 2 + (h)) * HTB)
#define PG8_STAGE(bufoff, gbase, voff) do { _Pragma("unroll") for (int _i = 0; _i < 2; ++_i) { unsigned _o = (voff)[_i]; if (GATHER) asm volatile("" : "+v"(_o)); \
        __builtin_amdgcn_global_load_lds((const unsigned*)((const char*)(gbase) + _o), (PG8_LAS unsigned*)(lds + (bufoff) + ldsw + _i * 8192), 16, 0, 0); } } while (0)
#define PG8_STAGE_A(bufoff, h, tile, koff, o0, o1) do { if constexpr (GATHER) { if (h) PG8_STAGE(bufoff, gA + (koff), o1); else PG8_STAGE(bufoff, gA + (koff), o0); } \
        else PG8_STAGE(bufoff, (tile) + (koff) + (h) * hstep, voffA); } while (0)
#define PG8_LDA(dst, b, h) do { _Pragma("unroll") for (int m = 0; m < 4; ++m) _Pragma("unroll") for (int k = 0; k < 2; ++k) dst[m][k] = *(const PG8_LAS bf16x8*)(lds + PG8_SA(b, h) + aoff + m * 2048 + k * 1024); } while (0)
#define PG8_LDB(dst, b, h) do { _Pragma("unroll") for (int n = 0; n < 2; ++n) _Pragma("unroll") for (int k = 0; k < 2; ++k) dst[n][k] = *(const PG8_LAS bf16x8*)(lds + PG8_SB(b, h) + boff + n * 2048 + k * 1024); } while (0)
#define PG8_MMA(ai, bj, At, Bt) do { __builtin_amdgcn_s_setprio(1); _Pragma("unroll") for (int m = 0; m < 4; ++m) _Pragma("unroll") for (int n = 0; n < 2; ++n) _Pragma("unroll") for (int k = 0; k < 2; ++k) \
        acc[ai][bj][m][n] = __builtin_amdgcn_mfma_f32_16x16x32_bf16(Bt[n][k], At[m][k], acc[ai][bj][m][n], 0, 0, 0); __builtin_amdgcn_s_setprio(0); } while (0)
#define PG8_WAIT_V(n) asm volatile("s_waitcnt vmcnt(" #n ")" ::: "memory")
#define PG8_WAIT_L(n) asm volatile("s_waitcnt lgkmcnt(" #n ")" ::: "memory")
#define PG8_BAR __builtin_amdgcn_s_barrier()
#define PG8_SCHED __builtin_amdgcn_sched_barrier(0)
    Unit cur, nxt; int ui = 0;
    if (!S.next(0, cur)) return;
    float zf = 0.f; asm volatile("" : "+v"(zf));
    f32x4 acc[2][2][4][2];
#pragma unroll
    for (int a = 0; a < 2; ++a)
#pragma unroll
        for (int b = 0; b < 2; ++b)
#pragma unroll
            for (int m = 0; m < 4; ++m)
#pragma unroll
                for (int n = 0; n < 2; ++n) acc[a][b][m][n] = (f32x4){zf, zf, zf, zf};
    bf16x8 At[4][2], B0[2][2], B1[2][2];
    const char* gA = (const char*)g.A;
    const char* cA = gA + (size_t)cur.pm * tstep;
    const char* cB = (const char*)S.b_base(cur, g);
    if constexpr (GATHER) g_offs(cur, gc0, gc1);
    {
        PG8_STAGE(PG8_SB(0, 0), cB, voffB); PG8_STAGE(PG8_SB(0, 1), cB + hstep, voffB); PG8_STAGE_A(PG8_SA(0, 0), 0, cA, 0, gc0, gc1); PG8_STAGE_A(PG8_SA(0, 1), 1, cA, 0, gc0, gc1);
        if (wr == 1) PG8_BAR;
        PG8_WAIT_V(2); PG8_BAR;
        PG8_STAGE(PG8_SB(1, 0), cB + kstep, voffB); PG8_STAGE_A(PG8_SA(1, 0), 0, cA, kstep, gc0, gc1); PG8_STAGE(PG8_SB(1, 1), cB + hstep + kstep, voffB);
        PG8_WAIT_V(6); PG8_BAR;
    }
    for (;;) {
        const bool has_next = S.next(ui + 1, nxt);
        const char* nA = has_next ? gA + (size_t)nxt.pm * tstep : cA;
        const char* nB = has_next ? (const char*)S.b_base(nxt, g) : cB;
        if constexpr (GATHER) { if (has_next) g_offs(nxt, gn0, gn1); else { gn0[0] = gc0[0]; gn0[1] = gc0[1]; gn1[0] = gc1[0]; gn1[1] = gc1[1]; } }
        for (int t = 0; t < nt; t += 2) {
            const bool last = (t == nt - 2);
            const size_t k1 = (size_t)(t + 1) * kstep;
            const char* tA = last ? nA : cA;
            const size_t k2 = last ? 0 : (size_t)(t + 2) * kstep, k3 = k2 + kstep;
            const char* b2 = last ? nB : cB + (size_t)(t + 2) * kstep; const char* b3 = b2 + kstep;
            unsigned w0[2], w1[2];
            if constexpr (GATHER) { w0[0] = last ? gn0[0] : gc0[0]; w0[1] = last ? gn0[1] : gc0[1]; w1[0] = last ? gn1[0] : gc1[0]; w1[1] = last ? gn1[1] : gc1[1]; }
            PG8_LDB(B0, 0, 0); PG8_LDB(B1, 0, 1); PG8_SCHED; PG8_LDA(At, 0, 0); PG8_STAGE_A(PG8_SA(1, 1), 1, cA, k1, gc0, gc1);
            PG8_WAIT_V(8); PG8_WAIT_L(0); PG8_BAR; PG8_MMA(0, 0, At, B0); PG8_MMA(0, 1, At, B1); PG8_BAR; PG8_SCHED;
            PG8_LDA(At, 0, 1); PG8_STAGE(PG8_SB(0, 0), b2, voffB); PG8_STAGE(PG8_SB(0, 1), b2 + hstep, voffB); PG8_STAGE_A(PG8_SA(0, 0), 0, tA, k2, w0, w1);
            PG8_WAIT_V(8); PG8_WAIT_L(0); PG8_BAR; PG8_MMA(1, 0, At, B0); PG8_MMA(1, 1, At, B1); PG8_BAR; PG8_SCHED;
            PG8_LDB(B0, 1, 0); PG8_LDB(B1, 1, 1); PG8_SCHED; PG8_LDA(At, 1, 0); PG8_STAGE_A(PG8_SA(0, 1), 1, tA, k2, w0, w1);
            PG8_WAIT_V(8); PG8_WAIT_L(0); PG8_BAR; PG8_MMA(0, 0, At, B0); PG8_MMA(0, 1, At, B1); PG8_BAR; PG8_SCHED;
            PG8_LDA(At, 1, 1); PG8_STAGE(PG8_SB(1, 0), b3, voffB); PG8_STAGE(PG8_SB(1, 1), b3 + hstep, voffB); PG8_STAGE_A(PG8_SA(1, 0), 0, tA, k3, w0, w1);
            PG8_WAIT_V(8); PG8_WAIT_L(0); PG8_BAR; PG8_MMA(1, 0, At, B0); PG8_MMA(1, 1, At, B1); PG8_BAR; PG8_SCHED;
        }
        if (wr == 0) PG8_BAR;
        { const int t2 = TIDX(); E(acc, cur, wr, wc, t2 & 15, (t2 >> 4) & 3); }
        if (!has_next) break;
#pragma unroll
        for (int a = 0; a < 2; ++a)
#pragma unroll
            for (int b = 0; b < 2; ++b)
#pragma unroll
                for (int m = 0; m < 4; ++m)
#pragma unroll
                    for (int n = 0; n < 2; ++n) acc[a][b][m][n] = (f32x4){zf, zf, zf, zf};
        cur = nxt; cA = nA; cB = nB; ++ui;
        if constexpr (GATHER) { gc0[0] = gn0[0]; gc0[1] = gn0[1]; gc1[0] = gn1[0]; gc1[1] = gn1[1]; }
        if (wr == 1) PG8_BAR;
    }
    PG8_WAIT_V(0);
    PG8_BAR;
#undef PG8_SA
#undef PG8_SB
#undef PG8_STAGE
#undef PG8_STAGE_A
#undef PG8_LDA
#undef PG8_LDB
#undef PG8_MMA
#undef PG8_WAIT_V
#undef PG8_WAIT_L
#undef PG8_BAR
#undef PG8_SCHED
}
}
template <class Epi, class Sched, bool GATHER>
__device__ __forceinline__ void gemm_phase(unsigned char* lds, int wv, const Gemm g, const Sched& S, const Epi& E) {
    pg8::gemm_phase<Epi, Sched, GATHER>((PG8_LAS unsigned char*)lds, wv, g, S, E);
}
#endif

struct EpiPlain {
    static constexpr bool PERM = true;
    act_t* O; int ldc;
    __device__ __forceinline__ void operator()(const f32x4 (&acc)[2][2][4][2], const Unit& u, int wr, int wc, int fr, int fq) const {
        const int row0 = u.pm * 256 + wr * 64 + fr, col0 = u.pn * 256 + wc * 32 + 8 * fq;
        for (int ai = 0; ai < 2; ++ai) for (int m = 0; m < 4; ++m) {
            act_t* rowp = O + (size_t)(row0 + ai * 128 + m * 16) * ldc + col0;
            for (int bj = 0; bj < 2; ++bj) {
                float v[8];
                for (int j = 0; j < 4; ++j) { v[j] = acc[ai][bj][m][0][j]; v[4 + j] = acc[ai][bj][m][1][j]; }
                store8(rowp + bj * 128, v);
            }
            EPI_FENCE();
        }
    }
};
struct EpiProj {
    static constexpr bool PERM = true;
    act_t* O; float* loga; const float* rot; const float* ba;
    __device__ __forceinline__ void operator()(const f32x4 (&acc)[2][2][4][2], const Unit& u, int wr, int wc, int fr, int fq) const {
        const int row0 = u.pm * 256 + wr * 64 + fr;
        if (u.pn == 11) {
            const int col0 = wc * 32 + 8 * fq;
            for (int ai = 0; ai < 2; ++ai) for (int m = 0; m < 4; ++m) {
                float* rowp = loga + (size_t)(row0 + ai * 128 + m * 16) * 256 + col0;
                for (int bj = 0; bj < 2; ++bj) for (int n = 0; n < 2; ++n) {
                    float o4[4];
                    for (int j = 0; j < 4; ++j) o4[j] = log_sigmoid_fast(acc[ai][bj][m][n][j] + ba[col0 + bj * 128 + 4 * n + j]) * (1.0f / 16.0f);
                    *(f32x4*)(rowp + bj * 128 + 4 * n) = (f32x4){o4[0], o4[1], o4[2], o4[3]};
                    EPI_FENCE();
                }
            }
        } else if (u.pn <= 1) {
            const bool lat = u.pm * 256 < NLAT;
            for (int ai = 0; ai < 2; ++ai) for (int m = 0; m < 4; ++m) {
                const int row = row0 + ai * 128 + m * 16;
                act_t* rowp = O + (size_t)row * PROJ_W + u.pn * 256 + wc * 64 + 8 * fq;
                float o1[8], o2[8];
                const float* rt = rot + ((size_t)(row % SEQ) * 32 + 8 * fq) * 2;
                for (int n = 0; n < 2; ++n) for (int j = 0; j < 4; ++j) {
                    float t1 = acc[ai][0][m][n][j], t2 = acc[ai][1][m][n][j];
                    float cs = 1.f, sn = 0.f;
                    if (lat) { cs = rt[(4 * n + j) * 2]; sn = rt[(4 * n + j) * 2 + 1]; }
                    o1[4 * n + j] = t1 * cs - t2 * sn;
                    o2[4 * n + j] = t1 * sn + t2 * cs;
                }
                store8(rowp, o1);
                store8(rowp + 32, o2);
                EPI_FENCE();
            }
        } else {
            const int col0 = u.pn * 256 + wc * 32 + 8 * fq;
            for (int ai = 0; ai < 2; ++ai) for (int m = 0; m < 4; ++m) {
                act_t* rowp = O + (size_t)(row0 + ai * 128 + m * 16) * PROJ_W + col0;
                for (int bj = 0; bj < 2; ++bj) {
                    float v[8];
                    for (int j = 0; j < 4; ++j) { v[j] = acc[ai][bj][m][0][j]; v[4 + j] = acc[ai][bj][m][1][j]; }
                    store8(rowp + bj * 128, v);
                }
                EPI_FENCE();
            }
        }
    }
};
struct EpiSwiglu {
    static constexpr bool PERM = true;
    act_t* H; int row_off;
    __device__ __forceinline__ void operator()(const f32x4 (&acc)[2][2][4][2], const Unit& u, int wr, int wc, int fr, int fq) const {
        const int row0 = u.pm * 256 + wr * 64 + fr - row_off, col0 = u.pn * 128 + wc * 32 + 8 * fq;
        for (int ai = 0; ai < 2; ++ai) for (int m = 0; m < 4; ++m) {
            float v[8];
            for (int n = 0; n < 2; ++n) for (int j = 0; j < 4; ++j) v[4 * n + j] = silu_f(acc[ai][0][m][n][j]) * acc[ai][1][m][n][j];
            store8(H + (size_t)(row0 + ai * 128 + m * 16) * DFF + col0, v);
            EPI_FENCE();
        }
    }
};
struct EpiMoeOut {
    static constexpr bool PERM = true;
    act_t* ys; const int* slot_asg; const float* tok_g;
    __device__ __forceinline__ void operator()(const f32x4 (&acc)[2][2][4][2], const Unit& u, int wr, int wc, int fr, int fq) const {
        const int row0 = u.pm * 256 + wr * 64 + fr, col0 = u.pn * 256 + wc * 32 + 8 * fq;
        for (int ai = 0; ai < 2; ++ai) for (int m = 0; m < 4; ++m) {
            const int as = slot_asg[row0 + ai * 128 + m * 16];
            if (as < 0) continue;
            const float gt = tok_g[as];
            act_t* rowp = ys + (size_t)as * DM + col0;
            for (int bj = 0; bj < 2; ++bj) {
                float v[8];
                for (int j = 0; j < 4; ++j) { v[j] = gt * acc[ai][bj][m][0][j]; v[4 + j] = gt * acc[ai][bj][m][1][j]; }
                store8(rowp + bj * 128, v);
            }
            EPI_FENCE();
        }
    }
};

struct EpiGlu {
    static constexpr bool PERM = true;
    act_t* mix; const act_t* g; const float* bias;
    __device__ __forceinline__ void operator()(const f32x4 (&acc)[2][2][4][2], const Unit& u, int wr, int wc, int fr, int fq) const {
        const int row0 = u.pm * 256 + wr * 64 + fr, col0 = wc * 32 + 8 * fq;
        _Pragma("unroll") for (int ai = 0; ai < 2; ++ai) _Pragma("unroll") for (int m = 0; m < 4; ++m) {
            const size_t row = (size_t)(row0 + ai * 128 + m * 16);
            _Pragma("unroll") for (int bj = 0; bj < 2; ++bj) {
                float gv[8], v[8];
                load8f(gv, g + row * 256 + col0 + bj * 128);
                _Pragma("unroll") for (int j = 0; j < 4; ++j) {
                    v[j] = gv[j] * sigmoid_f(acc[ai][bj][m][0][j] + bias[col0 + bj * 128 + j]);
                    v[4 + j] = gv[4 + j] * sigmoid_f(acc[ai][bj][m][1][j] + bias[col0 + bj * 128 + 4 + j]);
                }
                store8(mix + row * DM + 512 + col0 + bj * 128, v);
            }
            EPI_FENCE();
        }
    }
};
#ifdef EMU
#define WAVE_SYNC() __syncthreads()
#else
#define WAVE_SYNC() asm volatile("s_waitcnt lgkmcnt(0)" ::: "memory")
#endif
__device__ __forceinline__ void transpose_item(const float* W, int Nsrc, int K, int k0, int n0, act_t* WT, int drow0, float scale, float* scr, int lane) {
    for (int i = 0; i < 32; ++i) { const int kk = 2 * i + (lane >> 5); scr[kk * 33 + (lane & 31)] = W[(size_t)(k0 + kk) * Nsrc + n0 + (lane & 31)]; }
    WAVE_SYNC();
    const int c = lane & 7;
    for (int j = 0; j < 4; ++j) {
        const int n = (lane >> 3) + 8 * j; const float* s = scr + (8 * c) * 33 + n;
        float v[8];
        for (int q = 0; q < 8; ++q) v[q] = s[q * 33] * scale;
        store8(WT + (size_t)(drow0 + n) * K + k0 + 8 * c, v);
    }
    WAVE_SYNC();
}
__device__ __forceinline__ int win_dest(int n0, float& scale) {
    scale = 1.0f;
    if (n0 < 512) {
        const int base = n0 & ~255, s = n0 & 255, h = s >> 6, hi = (s >> 5) & 1;
        if (n0 >= 256) scale = 0.125f;
        return base + hi * 128 + h * 32;
    }
    if (n0 >= O_GQ && n0 < O_GK) scale = 0.17677669529663687f;
    if (n0 < 1792) return n0;
    if (n0 == 1792) return -1;
    return n0 - 32;
}
__device__ __forceinline__ void st_convert_items(const Params& p, int wv, unsigned char* lds, int which  ) {
    const int tid = TIDX(), wave = tid >> 6, lane = tid & 63;
    float* scr = (float*)lds + wave * (64 * 33 + 16);
    const int gw = BIDX() * NW + wave, NGW = NBLK() * NW;
    const int I_IN = (DM / 64) * (DPROJ_IN / 32), I_OUT = (DM / 64) * (DM / 32), I_F1 = (DM / 64) * (DFF / 32), I_F2 = (DFF / 64) * (DM / 32);
    const int I_GL = (256 / 64) * (256 / 32);
    const int total = which == 0 ? (DEPTH * (I_IN + I_OUT) + 2 * I_F1 + I_F2 + DEPTH * I_GL) : NEXP * (2 * I_F1 + I_F2);
    const int trips = (total + NGW - 1) / NGW;
    for (int tr = 0; tr < trips; ++tr) {
        int it = tr * NGW + gw;
        const bool valid = it < total;
        if (!valid) it = 0;
        const float* W; int Nsrc, K, k0, n0, drow0; act_t* WT; float scale = 1.0f;
        if (which == 0) {
            if (it < DEPTH * I_IN) {
                const int l = it / I_IN, r = it % I_IN; const int nblk = DPROJ_IN / 32;
                W = p.in[I_W_IN] + (size_t)l * DM * DPROJ_IN; Nsrc = DPROJ_IN; K = DM; k0 = 64 * (r / nblk); n0 = 32 * (r % nblk);
                WT = p.win_t + (size_t)l * NPROJ_T * DM; drow0 = win_dest(n0, scale);
            } else if (it < DEPTH * (I_IN + I_OUT)) {
                const int q = it - DEPTH * I_IN; const int l = q / I_OUT, r = q % I_OUT; const int nblk = DM / 32;
                W = p.in[I_W_OUT] + (size_t)l * DM * DM; Nsrc = DM; K = DM; k0 = 64 * (r / nblk); n0 = 32 * (r % nblk);
                WT = p.wout_t + (size_t)l * DM * DM; drow0 = n0;
            } else {
                int q = it - DEPTH * (I_IN + I_OUT);
                if (q < 2 * I_F1) {
                    const int w3 = q / I_F1, r = q % I_F1; const int nblk = DFF / 32;
                    W = p.in[w3 ? I_FFN_W3 : I_FFN_W1]; Nsrc = DFF; K = DM; k0 = 64 * (r / nblk); n0 = 32 * (r % nblk);
                    WT = p.w13_t; drow0 = (n0 / 128) * 256 + w3 * 128 + (n0 % 128);
                } else if (q < 2 * I_F1 + I_F2) {
                    const int r = q - 2 * I_F1; const int nblk = DM / 32;
                    W = p.in[I_FFN_W2]; Nsrc = DM; K = DFF; k0 = 64 * (r / nblk); n0 = 32 * (r % nblk);
                    WT = p.w2_t; drow0 = n0;
                } else {
                    const int r2 = q - 2 * I_F1 - I_F2; const int ll = r2 / I_GL, r = r2 % I_GL; const int nblk = 256 / 32;
                    W = p.in[I_S5_GLU_W] + (size_t)ll * 256 * 256; Nsrc = 256; K = 256; k0 = 64 * (r / nblk); n0 = 32 * (r % nblk);
                    WT = p.wglu_t + (size_t)ll * 256 * 256; drow0 = n0;
                }
            }
        } else {
            const int per = 2 * I_F1 + I_F2; const int e = it / per; int q = it % per;
            if (q < 2 * I_F1) {
                const int w3 = q / I_F1, r = q % I_F1; const int nblk = DFF / 32;
                W = p.in[w3 ? I_MOE_W3 : I_MOE_W1] + (size_t)e * DM * DFF; Nsrc = DFF; K = DM; k0 = 64 * (r / nblk); n0 = 32 * (r % nblk);
                WT = p.wmoe13 + (size_t)e * 2 * DFF * DM; drow0 = (n0 / 128) * 256 + w3 * 128 + (n0 % 128);
            } else {
                const int r = q - 2 * I_F1; const int nblk = DM / 32;
                W = p.in[I_MOE_W2] + (size_t)e * DFF * DM; Nsrc = DM; K = DFF; k0 = 64 * (r / nblk); n0 = 32 * (r % nblk);
                WT = p.wmoe2 + (size_t)e * DM * DFF; drow0 = n0;
            }
        }
        if (!valid || drow0 < 0) { WAVE_SYNC(); WAVE_SYNC(); continue; }
        transpose_item(W, Nsrc, K, k0, n0, WT, drow0, scale, scr, lane);
    }
}

__device__ __forceinline__ void st_prep(const Params& p, int wv, unsigned char* lds) {
    const int tid = TIDX(), nb = NBLK(), bid = BIDX();
    {
        float* sc = (float*)lds;
        const int ncols = DEPTH * 6 * DM;
        if (bid * NT < ncols) {
            for (int e = tid; e < (BATCH + 1) * DM; e += NT) { const int bb = e / DM, k = e % DM; sc[e] = silu_f(bb < BATCH ? p.in[I_C][bb * DM + k] : p.in[I_CCTX][k]); }
        }
        __syncthreads();
        for (int it = bid * NT + tid; it < ncols; it += nb * NT) {
            const int col = it % (6 * DM), l = it / (6 * DM);
            const float* w = p.in[I_ADA_W] + (long)l * DM * 6 * DM + col;
            float acc[BATCH + 1];
            _Pragma("unroll") for (int bb = 0; bb <= BATCH; ++bb) acc[bb] = p.in[I_ADA_B][l * 6 * DM + col];
#pragma unroll 4
            for (int k = 0; k < DM; ++k) { const float wv2 = w[(long)k * 6 * DM]; _Pragma("unroll") for (int bb = 0; bb <= BATCH; ++bb) acc[bb] += sc[bb * DM + k] * wv2; }
            _Pragma("unroll") for (int bb = 0; bb <= BATCH; ++bb) p.mod[((long)l * (BATCH + 1) + bb) * 6 * DM + col] = acc[bb];
        }
        __syncthreads();
    }
    for (int it = bid * NT + tid; it < SEQ * 32; it += nb * NT) {
        int t = it / 32, f = it % 32;
        float pos = f < 16 ? (float)(t / GRID_W) : (float)(t % GRID_W);
        float inv = exp2f(-(float)(f & 15) * (13.287712379549449f / 16.0f));
        float ang = pos * inv;
        p.rot[it * 2] = cosf(ang);
        p.rot[it * 2 + 1] = sinf(ang);
    }
    for (int it = bid * NT + tid; it < FN / 2; it += nb * NT) {
        double ang = -2.0 * M_PI * (double)it / (double)FN;
        p.fft_tw[it * 2] = (float)cos(ang); p.fft_tw[it * 2 + 1] = (float)sin(ang);
    }
    for (long it = (long)bid * NT + tid; it < (long)DEPTH * 256 * DM; it += (long)nb * NT) {
        int k = it % DM; int c = (it / DM) % 256; int l = it / (DM * 256);
        int dir = c >> 7, j = c & 127;
        const float* wi = p.in[I_W_IN] + ((size_t)l * DM + k) * DPROJ_IN + 1792 + 16 * dir;
        const float* wa = p.in[I_GLA_WA] + ((size_t)(l * 2 + dir) * 16) * 128 + j;
        float s = 0.f;
        for (int i = 0; i < 16; ++i) s += wi[i] * wa[i * 128];
        p.win_t[((size_t)l * NPROJ_T + 2816 + c) * DM + k] = f2a(s);
    }
    {
        const int wave = tid >> 6, lane = tid & 63;
        float* h1 = (float*)lds + wave * 128;
        float* h2 = h1 + 64;
        const int per_layer = SEQ + CTXL;
        for (int base = bid * NW; base < DEPTH * per_layer; base += nb * NW) {
            int it = base + wave;
            int l = it / per_layer;
            int r = it % per_layer;
            int which = r < SEQ ? 0 : 1;
            int n = which ? CTXL : SEQ;
            int t = which ? r - SEQ : r;
            float* circ = p.filt + (long)l * FILT_LAYER_FLOATS;
            const float tn = (float)((double)t / (double)(n - 1));
            const float* fw1 = p.in[I_HY_FW1] + l * 33 * 64;
            const float* fw2 = p.in[I_HY_FW2] + l * 64 * 64;
            const float* fw3 = p.in[I_HY_FW3] + l * 64 * 512;
            const float fr = p.in[I_HY_FREQ][l * 64 + lane];
            float a = p.in[I_HY_FB1][l * 64 + lane] + tn * fw1[lane];
#pragma unroll 2
            for (int k = 0; k < 16; ++k) {
                double band = 1e-4 + (double)k * ((15.0 - 1e-4) / 15.0);
                double turns = band * (double)t / (double)n;
                float ang = (float)((turns - floor(turns)) * (2.0 * M_PI));
                a += cosf(ang) * fw1[(1 + k) * 64 + lane];
                a += -sinf(ang) * fw1[(17 + k) * 64 + lane];
            }
            h1[lane] = sinf(fr * a);
            __syncthreads();
            float a2 = p.in[I_HY_FB2][l * 64 + lane];
#pragma unroll 8
            for (int i = 0; i < 64; ++i) a2 += h1[i] * fw2[i * 64 + lane];
            h2[lane] = sinf(fr * a2);
            if (!which) p.hdn2[((size_t)l * SEQ + t) * 64 + lane] = h2[lane];
            __syncthreads();
#pragma unroll 1
            for (int cc = 0; cc < (which ? 8 : 0); ++cc) {
                int c = cc * 64 + lane;
                float f = 0.0f;
#pragma unroll 8
                for (int i = 0; i < 64; ++i) f += h2[i] * fw3[i * 512 + c];
                int w = c >> 8, ch = c & 255;
                float dec = fabsf(p.in[I_HY_DECAY][(l * 2 + w) * 256 + ch]);
                f *= expf(-tn * dec);
                if (w == 0) circ[(long)t * 256 + ch] = f;
                else if (t >= 1) circ[(long)(2 * n - t) * 256 + ch] = f;
                if (t == 0 && w == 1) circ[(long)n * 256 + ch] = 0.0f;
            }
            __syncthreads();
        }
    }
    for (int it = bid * NT + tid; it < DEPTH * 2 * 16 * 64; it += nb * NT) {
        const int n = it & 63, pg = it >> 6;
        double lre = p.in[I_S5_LAM_RE][it], lim = p.in[I_S5_LAM_IM][it];
        double dt = exp((double)p.in[I_S5_LOG_DT][pg]);
        double mag = exp(lre * dt);
        double lbr = mag * cos(lim * dt), lbi = mag * sin(lim * dt);
        double den = lre * lre + lim * lim;
        double cr = ((lbr - 1.0) * lre + lbi * lim) / den;
        double ci = (lbi * lre - (lbr - 1.0) * lim) / den;
        float* tb = p.s5tab + (size_t)it * 34;
        tb[0] = (float)lbr; tb[1] = (float)lbi;
#pragma unroll 1
        for (int q = 0; q < 16; ++q) {
            double br = p.in[I_S5_B_RE][((long)pg * 64 + n) * 16 + q], bi = p.in[I_S5_B_IM][((long)pg * 64 + n) * 16 + q];
            tb[2 + q] = (float)(cr * br - ci * bi);
            tb[18 + q] = (float)(cr * bi + ci * br);
        }
    }
    for (int it = bid * NT + tid; it < DEPTH * 2 * 16 * 65 * 64; it += nb * NT) {
        const int n = it & 63, tau = (it >> 6) % 65, pg = it / (65 * 64);
        const double lre = p.in[I_S5_LAM_RE][pg * 64 + n], lim = p.in[I_S5_LAM_IM][pg * 64 + n];
        const double dt = exp((double)p.in[I_S5_LOG_DT][pg]);
        const double mag = exp(lre * dt * (double)tau), ph = lim * dt * (double)tau;
        p.s5pw[(size_t)it * 2] = (float)(mag * cos(ph)); p.s5pw[(size_t)it * 2 + 1] = (float)(mag * sin(ph));
    }
    st_convert_items(p, wv, lds, 0);
}

__device__ __forceinline__ void st_prep2(const Params& p, int wv) {
    const int tid = TIDX(), wave = tid >> 6, lane = tid & 63;
    for (int base = BIDX() * NW; base < DEPTH * 256; base += NBLK() * NW) {
        int it = base + wave;
        int ch = it & 255, l = it >> 8;
        int n = CTXL;
        const float* circ = p.filt + (long)l * FILT_LAYER_FLOATS;
        double s = 0.0;
        for (int i = lane; i < 2 * n; i += 64) s += fabs((double)circ[(long)i * 256 + ch]);
        float hi = (float)s, lo = (float)(s - (double)hi);
        hi = wave_sum(hi); lo = wave_sum(lo);
        if (lane == 0) p.fnorm[it] = (float)(1.0 / ((double)hi + (double)lo));
    }
}

__device__ __forceinline__ void ld8(float* v, const float* src) {
#if defined(EMU)
    for (int i = 0; i < 8; ++i) v[i] = src[i];
#else
    const f32x4 a = *(const f32x4*)src, b = *(const f32x4*)(src + 4);
    v[0] = a[0]; v[1] = a[1]; v[2] = a[2]; v[3] = a[3]; v[4] = b[0]; v[5] = b[1]; v[6] = b[2]; v[7] = b[3];
#endif
}
__device__ __forceinline__ void st8f(float* dst, const float* v) {
#if defined(EMU)
    for (int i = 0; i < 8; ++i) dst[i] = v[i];
#else
    *(f32x4*)dst = (f32x4){v[0], v[1], v[2], v[3]}; *(f32x4*)(dst + 4) = (f32x4){v[4], v[5], v[6], v[7]};
#endif
}
__device__ __forceinline__ void st_ln(const Params& p, int wv, unsigned char* lds, int l, int mode) {
    const int tid = TIDX(), wave = tid >> 6, lane = tid & 63;
    const bool last = (l == DEPTH - 1);
    const int nrows = (mode == 0) ? NTOK : (last ? NLAT : NTOK);
    const bool moe = (l & 1);
    const bool route = (mode == 1) && moe;
    int* lc = (int*)lds;
    if (route) {
        if (tid < NW * NEXP) lc[tid] = 0;
        __syncthreads();
        for (int i = BIDX() * NT + tid; i < MOE_CAP; i += NBLK() * NT) p.slot_asg[i] = -1;
    }
    const float* rw = p.in[I_ROUTER_W] + (long)(l / 2) * DM * NEXP;
    const float* rb = p.in[I_ROUTER_B] + (l / 2) * NEXP;
    for (int base = BIDX() * NW; base < nrows; base += NBLK() * NW) {
        const int row = base + wave;
        const bool lat = row < NLAT;
        const float* modp = p.mod + ((long)l * (BATCH + 1) + row_modidx(row)) * 6 * DM;
        act_t* urow = p.u + (long)row * DM;
        float v[16], t8[8], m1[8], m2[8], o[8];
        float mu, rstd;
        if (mode == 0) {
            const float* src = lat ? p.in[I_X] + (long)row * DM : p.in[I_CTX] + (long)(row - NLAT) * DM;
            for (int g = 0; g < 2; ++g) ld8(v + 8 * g, src + g * 512 + lane * 8);
            ln_stats16(v, mu, rstd);
            for (int g = 0; g < 2; ++g) {
                const int c0 = g * 512 + lane * 8;
                ld8(m1, modp + DM + c0); ld8(m2, modp + c0);
                for (int j = 0; j < 8; ++j) o[j] = (v[8 * g + j] - mu) * rstd * (1.0f + m1[j]) + m2[j];
                store8(urow + c0, o);
            }
        } else if (mode == 1) {
            const float* src = lat ? ((l == 0 ? p.in[I_X] : p.out) + (long)row * DM)
                                   : ((l == 0 ? p.in[I_CTX] : p.hctx) + (long)(row - NLAT) * DM);
            float* dst = lat ? p.out + (long)row * DM : p.hctx + (long)(row - NLAT) * DM;
            for (int g = 0; g < 2; ++g) {
                const int c0 = g * 512 + lane * 8;
                ld8(t8, src + c0); ld8(m1, modp + 2 * DM + c0); load8f(m2, urow + c0);
                for (int j = 0; j < 8; ++j) v[8 * g + j] = ALPHA * t8[j] + m1[j] * m2[j];
            }
            ln_stats16(v, mu, rstd);
            for (int g = 0; g < 2; ++g) {
                const int c0 = g * 512 + lane * 8;
                ld8(m1, p.in[I_LN_MIX_G] + l * DM + c0); ld8(m2, p.in[I_LN_MIX_B] + l * DM + c0);
                for (int j = 0; j < 8; ++j) v[8 * g + j] = (v[8 * g + j] - mu) * rstd * m1[j] + m2[j];
                st8f(dst + c0, v + 8 * g);
            }
            ln_stats16(v, mu, rstd);
            float lg[NEXP];
            for (int e = 0; e < NEXP; ++e) lg[e] = 0.f;
            for (int g = 0; g < 2; ++g) {
                const int c0 = g * 512 + lane * 8;
                ld8(m1, modp + 4 * DM + c0); ld8(m2, modp + 3 * DM + c0);
                for (int j = 0; j < 8; ++j) o[j] = (v[8 * g + j] - mu) * rstd * (1.0f + m1[j]) + m2[j];
                store8(urow + c0, o);
                if (route) for (int j = 0; j < 8; ++j) { ld8(t8, rw + (long)(c0 + j) * NEXP); for (int e = 0; e < NEXP; ++e) lg[e] += o[j] * t8[e]; }
            }
            if (route) {
                for (int e = 0; e < NEXP; ++e) lg[e] = wave_sum(lg[e]) + rb[e];
                if (lane == 0) {
                    int e1 = 0;
                    for (int e = 1; e < NEXP; ++e) if (lg[e] > lg[e1]) e1 = e;
                    int e2 = (e1 == 0) ? 1 : 0;
                    for (int e = 0; e < NEXP; ++e) if (e != e1 && lg[e] > lg[e2]) e2 = e;
                    float ex = expf(lg[e2] - lg[e1]);
                    float g1 = 1.0f / (1.0f + ex);
                    p.tok_e[row * 2] = e1; p.tok_e[row * 2 + 1] = e2;
                    p.tok_g[row * 2] = g1; p.tok_g[row * 2 + 1] = ex * g1;
                    lc[wave * NEXP + e1] += 1;
                    lc[wave * NEXP + e2] += 1;
                }
            }
        } else {
            float* dst = lat ? p.out + (long)row * DM : p.hctx + (long)(row - NLAT) * DM;
            for (int g = 0; g < 2; ++g) {
                const int c0 = g * 512 + lane * 8;
                ld8(t8, dst + c0); ld8(m1, modp + 5 * DM + c0);
                if (moe) { load8f(m2, p.ys + (long)(row * 2) * DM + c0); load8f(o, p.ys + (long)(row * 2 + 1) * DM + c0); for (int j = 0; j < 8; ++j) m2[j] += o[j]; }
                else load8f(m2, urow + c0);
                for (int j = 0; j < 8; ++j) v[8 * g + j] = ALPHA * t8[j] + m1[j] * m2[j];
            }
            ln_stats16(v, mu, rstd);
            for (int g = 0; g < 2; ++g) {
                const int c0 = g * 512 + lane * 8;
                ld8(m1, p.in[I_LN_FFN_G] + l * DM + c0); ld8(m2, p.in[I_LN_FFN_B] + l * DM + c0);
                for (int j = 0; j < 8; ++j) v[8 * g + j] = (v[8 * g + j] - mu) * rstd * m1[j] + m2[j];
                st8f(dst + c0, v + 8 * g);
            }
            if (l + 1 < DEPTH) {
                const float* modn = p.mod + ((long)(l + 1) * (BATCH + 1) + row_modidx(row)) * 6 * DM;
                ln_stats16(v, mu, rstd);
                for (int g = 0; g < 2; ++g) {
                    const int c0 = g * 512 + lane * 8;
                    ld8(m1, modn + DM + c0); ld8(m2, modn + c0);
                    for (int j = 0; j < 8; ++j) o[j] = (v[8 * g + j] - mu) * rstd * (1.0f + m1[j]) + m2[j];
                    store8(urow + c0, o);
                }
            }
        }
    }
    if (route) {
        int* cnt = (int*)(p.ctl + CTL_MOE);
        __syncthreads();
        if (tid < NEXP) {
            int tot = 0;
            for (int w = 0; w < NW; ++w) tot += lc[w * NEXP + tid];
            if (tot) atomicAdd(&cnt[tid], tot);
        }
        __syncthreads();
    }
}

__device__ __forceinline__ void st_router(const Params& p, int wv, unsigned char* lds, int l) {
    const int tid = TIDX(), wave = tid >> 6, lane = tid & 63;
    const int j = l / 2;
    const float* rw = p.in[I_ROUTER_W] + (long)j * DM * NEXP;
    const float* rb = p.in[I_ROUTER_B] + j * NEXP;
    int* cnt = (int*)(p.ctl + CTL_MOE);
    int* lc = (int*)lds;
    if (tid < NW * NEXP) lc[tid] = 0;
    __syncthreads();
    for (int i = BIDX() * NT + tid; i < MOE_CAP; i += NBLK() * NT) p.slot_asg[i] = -1;
    for (int base = BIDX() * NW; base < NLAT; base += NBLK() * NW) {
        const int row = base + wave;
        const float* modp = p.mod + ((long)l * (BATCH + 1) + row_modidx(row)) * 6 * DM;
        float v[16], mu, rstd;
        for (int i = 0; i < 16; ++i) v[i] = p.out[(long)row * DM + i * 64 + lane];
        ln_stats16(v, mu, rstd);
        float lg[NEXP];
        for (int e = 0; e < NEXP; ++e) lg[e] = 0.f;
        for (int i = 0; i < 16; ++i) {
            int c = i * 64 + lane;
            float vv = (v[i] - mu) * rstd * (1.0f + modp[4 * DM + c]) + modp[3 * DM + c];
            for (int e = 0; e < NEXP; ++e) lg[e] += vv * rw[c * NEXP + e];
        }
        for (int e = 0; e < NEXP; ++e) lg[e] = wave_sum(lg[e]) + rb[e];
        if (lane == 0) {
            int e1 = 0;
            for (int e = 1; e < NEXP; ++e) if (lg[e] > lg[e1]) e1 = e;
            int e2 = (e1 == 0) ? 1 : 0;
            for (int e = 0; e < NEXP; ++e) if (e != e1 && lg[e] > lg[e2]) e2 = e;
            float ex = expf(lg[e2] - lg[e1]);
            float g1 = 1.0f / (1.0f + ex);
            p.tok_e[row * 2] = e1; p.tok_e[row * 2 + 1] = e2;
            p.tok_g[row * 2] = g1; p.tok_g[row * 2 + 1] = ex * g1;
            lc[wave * NEXP + e1] += 1;
            lc[wave * NEXP + e2] += 1;
        }
    }
    __syncthreads();
    if (tid < NEXP) {
        int tot = 0;
        for (int w = 0; w < NW; ++w) tot += lc[w * NEXP + tid];
        if (tot) atomicAdd(&cnt[tid], tot);
    }
    __syncthreads();
}
__device__ __forceinline__ void moe_offsets(const Params& p, int* pstart, int* pend) {
    const int* cnt = (const int*)(p.ctl + CTL_MOE);
    int acc = 0;
    for (int e = 0; e < NEXP; ++e) {
        int c = cnt[e];
        pstart[e] = acc;
        acc += (c + 255) / 256 * 256;
        pend[e] = acc;
    }
}
__device__ __forceinline__ void st_place(const Params& p, int wv, unsigned char* lds) {
    const int tid = TIDX();
    int pstart[NEXP], pend[NEXP];
    moe_offsets(p, pstart, pend);
    int* fill = (int*)(p.ctl + CTL_MOE) + 8;
    int* lcnt = (int*)lds;
    int* lpos = lcnt + 16;
    const int per = (2 * NLAT + NBLK() - 1) / NBLK();
    const int a0 = BIDX() * per, a1 = (a0 + per < 2 * NLAT) ? a0 + per : 2 * NLAT;
    if (tid < 32) lcnt[tid] = 0;
    __syncthreads();
    for (int a = a0 + tid; a < a1; a += NT) atomicAdd(&lcnt[p.tok_e[a]], 1);
    __syncthreads();
    if (tid < NEXP) { const int c = lcnt[tid]; lcnt[tid] = c ? atomicAdd(&fill[tid], c) : 0; }
    __syncthreads();
    for (int a = a0 + tid; a < a1; a += NT) {
        const int e = p.tok_e[a];
        const int pos = lcnt[e] + atomicAdd(&lpos[e], 1);
        int ps = 0;
        for (int q = 0; q < NEXP; ++q) ps = (q == e) ? pstart[q] : ps;
        p.slot_asg[ps + pos] = a;
    }
    __syncthreads();
}

enum { G_PROJ, G_OUT, G_FFN1, G_FFN2, G_MFFN1, G_MFFN2, G_GLU };
#ifndef REFMASK
#define REFMASK 0
#endif
#if defined(EMU)
#define GEMM_CALL(mode, EPI, SCH, GA) gemm_phase<EPI, SCH, GA>(lds, wv, g, S, E)
#else
#define GEMM_CALL(mode, EPI, SCH, GA) do { if ((REFMASK >> (mode)) & 1) gemm_phase_ref<EPI, SCH, GA>(wv, g, S, E); else gemm_phase<EPI, SCH, GA>(lds, wv, g, S, E); } while (0)
#endif
template <int MODE>
__device__ __forceinline__ void st_gemm(const Params& p, int wv, unsigned char* lds, int l, int pass) {
    const bool last = (l == DEPTH - 1);
    const int G = NBLK(), c = BIDX();
    if (MODE == G_PROJ) {
        Gemm g{p.u, p.win_t + (size_t)l * NPROJ_T * DM, NTOK, NPROJ_T, DM, nullptr};
        StaticOrder S; S.init(NTOK, NPROJ_T, G, c);
        EpiProj E{p.proj, p.loga, p.rot, p.in[I_GLA_BA] + l * 256};
        GEMM_CALL(G_PROJ, EpiProj, StaticOrder, false);
    } else if (MODE == G_OUT) {
        const int M = last ? NLAT : NTOK;
        Gemm g{p.mix, p.wout_t + (size_t)l * DM * DM, M, DM, DM, nullptr};
        StaticOrder S; S.init(M, DM, G, c);
        EpiPlain E{p.u, DM};
        GEMM_CALL(G_OUT, EpiPlain, StaticOrder, false);
    } else if (MODE == G_GLU && false) {
        const int M = last ? NLAT : NTOK;
        Gemm g{p.gbuf, p.wglu_t + (size_t)l * 256 * 256, M, 256, 256, nullptr};
        StaticOrder S; S.init(M, 256, G, c);
        EpiGlu E{p.mix, p.gbuf, p.in[I_S5_GLU_B] + l * 256};
        GEMM_CALL(G_GLU, EpiGlu, StaticOrder, false);
    } else if (MODE == G_FFN1) {
        Gemm g{p.u, p.w13_t, NTOK, 2 * DFF, DM, nullptr};
        StaticOrder S; S.init(NTOK, 2 * DFF, G, c);
        EpiSwiglu E{p.proj, 0};
        GEMM_CALL(G_FFN1, EpiSwiglu, StaticOrder, false);
    } else if (MODE == G_FFN2) {
        Gemm g{p.proj, p.w2_t, NTOK, DM, DFF, nullptr};
        StaticOrder S; S.init(NTOK, DM, G, c);
        EpiPlain E{p.u, DM};
        GEMM_CALL(G_FFN2, EpiPlain, StaticOrder, false);
    } else {
        int pstart[NEXP], pend[NEXP];
        moe_offsets(p, pstart, pend);
        const int used = pend[NEXP - 1] / 256;
        const int t0 = pass * MOE_PT;
        int nt = used - t0; if (nt > MOE_PT) nt = MOE_PT;
        if (nt <= 0) return;
        MoeOrder S; S.t0 = t0;
        for (int e = 0; e < NEXP; ++e) S.pend[e] = pend[e];
        if (MODE == G_MFFN1) {
            S.so.init(nt * 256, 2 * DFF, G, c); S.estride = (size_t)2 * DFF * DM;
            Gemm g{p.u, p.wmoe13, nt * 256, 2 * DFF, DM, p.slot_asg};
            EpiSwiglu E{p.hch, t0 * 256};
            GEMM_CALL(G_MFFN1, EpiSwiglu, MoeOrder, true);
        } else {
            S.so.init(nt * 256, DM, G, c); S.estride = (size_t)DM * DFF;
            Gemm g{p.hch - (size_t)t0 * 256 * DFF, p.wmoe2, nt * 256, DM, DFF, nullptr};
            EpiMoeOut E{p.ys, p.slot_asg, p.tok_g};
            GEMM_CALL(G_MFFN2, EpiMoeOut, MoeOrder, false);
        }
    }
}

__device__ __forceinline__ void st_glu(const Params& p, int wv, unsigned char* lds, int l) {
    const int M = (l == DEPTH - 1) ? NLAT : NTOK;
    float(*As)[132] = (float(*)[132])lds;
    float(*Bs)[68] = (float(*)[68])(lds + 16 * 132 * 4);
    const float* W = p.in[I_S5_GLU_W] + (long)l * 256 * 256;
    const float* g = p.osum;
    const int tid = TIDX(), ty = tid >> 4, tx = tid & 15;
    const int ar = tid >> 2, ak = (tid & 3) * 4;
    const int bk = (tid >> 4) & 15, bc = (tid & 15) * 4;
    const int ntm = M / 128, ntn = 4;
    for (int tile = BIDX(); tile < ntm * ntn; tile += NBLK()) {
        const int m0 = (tile / ntn) * 128, n0 = (tile % ntn) * 64;
        float acc[4][4];
        for (int i = 0; i < 4; ++i) for (int j = 0; j < 4; ++j) acc[i][j] = 0.f;
        for (int k0 = 0; k0 < 256; k0 += 16) {
            for (int q = 0; q < 4; ++q) As[ak + q][ar] = g[(long)(m0 + ar) * 256 + k0 + ak + q];
            if (tid < 256) for (int q = 0; q < 4; ++q) Bs[bk][bc + q] = W[(k0 + bk) * 256 + n0 + bc + q];
            __syncthreads();
            for (int k = 0; k < 16; ++k) {
                float a[4], b[4];
                for (int i = 0; i < 4; ++i) a[i] = As[k][ty * 4 + i];
                for (int j = 0; j < 4; ++j) b[j] = Bs[k][tx * 4 + j];
                for (int i = 0; i < 4; ++i) for (int j = 0; j < 4; ++j) acc[i][j] += a[i] * b[j];
            }
            __syncthreads();
        }
        for (int i = 0; i < 4; ++i) for (int j = 0; j < 4; ++j) {
            int r = m0 + ty * 4 + i, c = n0 + tx * 4 + j;
            float gv = g[(long)r * 256 + c];
            p.mix[(long)r * DM + 512 + c] = f2a(gv * sigmoid_f(acc[i][j] + p.in[I_S5_GLU_B][l * 256 + c]));
        }
    }
}

#define GLP 264
__device__ __forceinline__ f32x4 mm16(f32x4 acc, const act_t* A, int pa, const act_t* Bt, int pb, int K, int lane);
__device__ __forceinline__ void st_glu2(const Params& p, int wv, unsigned char* lds, int l, int bid, int nb) {
    const int tid = TIDX(), wave = tid >> 6, lane = tid & 63;
    const int M = (l == DEPTH - 1) ? NLAT : NTOK;
    act_t* gt = (act_t*)lds; act_t* ot = gt + 64 * GLP;
    const act_t* Wt = p.wglu_t + (size_t)l * 256 * 256;
    for (int u = bid; u < M / 64; u += nb) {
        const int row0 = u * 64;
        for (int e = tid; e < 64 * 32; e += NT) { const int r = e >> 5, c8 = (e & 31) * 8; copy8(gt + r * GLP + c8, p.gbuf + (size_t)(row0 + r) * 256 + c8); }
        __syncthreads();
        for (int q = 0; q < 2; ++q) {
            const int n = 2 * wave + q;
            for (int rb = 0; rb < 4; ++rb) {
                f32x4 acc = (f32x4){0.f, 0.f, 0.f, 0.f};
                acc = mm16(acc, gt + 16 * rb * GLP, GLP, Wt + (size_t)16 * n * 256, 256, 256, lane);
                for (int r = 0; r < 4; ++r) {
                    const int t = 16 * rb + 4 * (lane >> 4) + r, c = 16 * n + (lane & 15);
                    ot[t * GLP + c] = f2a(a2f(gt[t * GLP + c]) * sigmoid_f(acc[r] + p.in[I_S5_GLU_B][l * 256 + c]));
                }
            }
        }
        __syncthreads();
        for (int e = tid; e < 64 * 32; e += NT) { const int r = e >> 5, c8 = (e & 31) * 8; copy8(p.mix + (size_t)(row0 + r) * DM + 512 + c8, ot + r * GLP + c8); }
        __syncthreads();
    }
}
__device__ __forceinline__ float hy_short(const Params& p, int l, int row, int c) {
    const bool lat = row < NLAT;
    const int n = lat ? SEQ : CTXL;
    const int t = lat ? row % SEQ : (row - NLAT) % CTXL;
    const float* cw = p.in[I_HY_CONV_W] + (long)l * 3 * 768;
    float s = p.in[I_HY_CONV_B][l * 768 + c];
    for (int jj = 0; jj < 3; ++jj) {
        int tt = t + jj - 1;
        if (tt >= 0 && tt < n) s += a2f(p.proj[(long)(row + jj - 1) * PROJ_W + O_HP + c]) * cw[jj * 768 + c];
    }
    return s;
}
__device__ __forceinline__ void st_hy_ctx_pre(const Params& p, int wv, int l, int bid, int nb) {
    const int tid = TIDX();
    for (long it = (long)bid * NT + tid; it < (long)NCTX * 256; it += (long)nb * NT) {
        int row = NLAT + (int)(it >> 8), ch = it & 255;
        p.hz[(long)row * 256 + ch] = f2a(hy_short(p, l, row, 256 + ch) * hy_short(p, l, row, 512 + ch));
    }
}
__device__ __forceinline__ void st_hy_ctx_conv(const Params& p, int wv, int l, int bid, int nb) {
    const int tid = TIDX();
    for (long it = (long)bid * NT + tid; it < (long)NCTX * 256; it += (long)nb * NT) {
        int row = NLAT + (int)(it >> 8), ch = it & 255;
        const int n = CTXL;
        const int t = (row - NLAT) % CTXL;
        const int rbase = row - t;
        const float* circ = p.filt + (long)l * FILT_LAYER_FLOATS;
        float acc = 0.f;
        for (int s2 = 0; s2 < n; ++s2) {
            int idx = t - s2; if (idx < 0) idx += 2 * n;
            acc += circ[(long)idx * 256 + ch] * a2f(p.hz[(long)(rbase + s2) * 256 + ch]);
        }
        float yv = acc * p.fnorm[l * 256 + ch];
        float z = a2f(p.hz[(long)row * 256 + ch]);
        float x0 = hy_short(p, l, row, ch);
        p.mix[(long)row * DM + 768 + ch] = f2a(x0 * (yv + z * p.in[I_HY_BIAS][l * 256 + ch]));
    }
}
struct cpx { float x, y; };
__device__ __forceinline__ cpx cmul(cpx a, cpx b) { cpx r; r.x = a.x * b.x - a.y * b.y; r.y = a.x * b.y + a.y * b.x; return r; }
__device__ __forceinline__ cpx cmulc(cpx a, cpx b) { cpx r; r.x = a.x * b.x + a.y * b.y; r.y = a.y * b.x - a.x * b.y; return r; }
__device__ __forceinline__ int fslot(int i) { return i + (i >> 5); }
#define FSLOTS (FN + (FN >> 5))
template <int NB, bool INV>
__device__ __forceinline__ void fft_pass(cpx* x, const cpx* tw, int shift, int tid) {
    for (int g = tid; g < (FN >> NB); g += NT) {
        const int low = g & ((1 << shift) - 1), high = g >> shift;
        const int base = (high << (shift + NB)) | low;
        cpx v[1 << NB];
#pragma unroll
        for (int j = 0; j < (1 << NB); ++j) v[j] = x[fslot(base | (j << shift))];
#pragma unroll
        for (int q = 0; q < NB; ++q) {
            const int lb = INV ? q : NB - 1 - q, ml = 1 << lb, gb = shift + lb;
#pragma unroll
            for (int j = 0; j < (1 << NB); ++j) {
                if (j & ml) continue;
                const int e = ((base | (j << shift)) & ((1 << gb) - 1)) << (FLOG - 1 - gb);
                const cpx w = tw[e];
                if (!INV) { cpx a = v[j], b2 = v[j + ml], d; v[j].x = a.x + b2.x; v[j].y = a.y + b2.y; d.x = a.x - b2.x; d.y = a.y - b2.y; v[j + ml] = cmul(d, w); }
                else { cpx a = v[j], b2 = cmulc(v[j + ml], w); v[j].x = a.x + b2.x; v[j].y = a.y + b2.y; v[j + ml].x = a.x - b2.x; v[j + ml].y = a.y - b2.y; }
            }
        }
#pragma unroll
        for (int j = 0; j < (1 << NB); ++j) x[fslot(base | (j << shift))] = v[j];
    }
    __syncthreads();
}
__device__ __forceinline__ void fft_fwd(cpx* x, const cpx* tw, int tid) {
#if FLOG == 13
    fft_pass<3, false>(x, tw, 10, tid); fft_pass<3, false>(x, tw, 7, tid); fft_pass<3, false>(x, tw, 4, tid); fft_pass<4, false>(x, tw, 0, tid);
#elif FLOG == 10
    fft_pass<3, false>(x, tw, 7, tid); fft_pass<3, false>(x, tw, 4, tid); fft_pass<4, false>(x, tw, 0, tid);
#else
    fft_pass<3, false>(x, tw, 6, tid); fft_pass<3, false>(x, tw, 3, tid); fft_pass<3, false>(x, tw, 0, tid);
#endif
}
__device__ __forceinline__ void fft_inv(cpx* x, const cpx* tw, int tid) {
#if FLOG == 13
    fft_pass<4, true>(x, tw, 0, tid); fft_pass<3, true>(x, tw, 4, tid); fft_pass<3, true>(x, tw, 7, tid); fft_pass<3, true>(x, tw, 10, tid);
#elif FLOG == 10
    fft_pass<4, true>(x, tw, 0, tid); fft_pass<3, true>(x, tw, 4, tid); fft_pass<3, true>(x, tw, 7, tid);
#else
    fft_pass<3, true>(x, tw, 0, tid); fft_pass<3, true>(x, tw, 3, tid); fft_pass<3, true>(x, tw, 6, tid);
#endif
}
__device__ __forceinline__ void fft_load_tw(const Params& p, cpx* tw, int tid) {
    for (int i = tid; i < FN / 2; i += NT) { tw[i].x = p.fft_tw[2 * i]; tw[i].y = p.fft_tw[2 * i + 1]; }
}
__device__ __forceinline__ void st_hy_spec(const Params& p, int wv, unsigned char* lds, int l, int bid, int nb) {
    const int tid = TIDX();
    cpx* x = (cpx*)lds; cpx* tw = x + FSLOTS; float* red = (float*)(tw + FN / 2);
    float* fwc = red; float* part = red + 128;
    if (bid < 256) fft_load_tw(p, tw, tid);
    for (int c = bid; c < 256; c += nb) {
        if (tid < 128) fwc[tid] = p.in[I_HY_FW3][(long)l * 64 * 512 + (tid & 63) * 512 + (tid >> 6) * 256 + c];
        __syncthreads();
        const float d0 = fabsf(p.in[I_HY_DECAY][(l * 2 + 0) * 256 + c]), d1 = fabsf(p.in[I_HY_DECAY][(l * 2 + 1) * 256 + c]);
        float asum = 0.f;
        for (int i = tid; i < FN; i += NT) {
            float val = 0.f;
            if (i != SEQ) {
                const int w = i > SEQ, t = w ? FN - i : i;
                const float* hd = p.hdn2 + ((size_t)l * SEQ + t) * 64;
                const float* fc = fwc + w * 64;
                float f = 0.f;
#pragma unroll 8
                for (int j = 0; j < 64; ++j) f += hd[j] * fc[j];
                const float tn = (float)((double)t / (double)(SEQ - 1));
                val = f * expf(-tn * (w ? d1 : d0));
            }
            x[fslot(i)].x = val; x[fslot(i)].y = 0.f;
            asum += fabsf(val);
        }
        asum = wave_sum(asum);
        if ((tid & 63) == 0) part[tid >> 6] = asum;
        __syncthreads();
        float tot = 0.f;
        for (int q = 0; q < NW; ++q) tot += part[q];
        const float sc = 1.0f / (tot * (float)FN);
        fft_fwd(x, tw, tid);
        float* H = p.hspec + (size_t)c * FN * 2;
        for (int i = tid; i < FN; i += NT) { cpx v = x[fslot(i)]; H[2 * i] = v.x * sc; H[2 * i + 1] = v.y * sc; }
        __syncthreads();
    }
}
#define HT 32
__device__ __forceinline__ void hy_stage(const Params& p, act_t* tl, int pitch, int b, int t0, int c0, int ncg, int tid) {
    for (int e = tid; e < (HT + 2) * ncg; e += NT) {
        const int r = e / ncg, cg = e % ncg, t = t0 - 1 + r;
        act_t* dst = tl + r * pitch + cg * 8;
        if (t >= 0 && t < SEQ) copy8(dst, p.proj + (long)(b * SEQ + t) * PROJ_W + O_HP + c0 + cg * 8);
        else {
#if defined(EMU)
            for (int i = 0; i < 8; ++i) dst[i] = f2a(0.f);
#else
            unsigned zz = 0u; asm volatile("" : "+v"(zz));
            *(u32x4*)dst = (u32x4){zz, zz, zz, zz};
#endif
        }
    }
}
__device__ __forceinline__ float hy_short_lds(const act_t* tl, int pitch, int r, int cc, const float* w3, float bias) {
    return bias + a2f(tl[r * pitch + cc]) * w3[0] + a2f(tl[(r + 1) * pitch + cc]) * w3[1] + a2f(tl[(r + 2) * pitch + cc]) * w3[2];
}
__device__ __forceinline__ void st_hy_pre(const Params& p, int wv, unsigned char* lds, int l, int bid, int nb) {
    const int tid = TIDX(), wave = tid >> 6, lane = tid & 63;
    float* tile = (float*)lds;
    act_t* tl = (act_t*)(tile + HT * 257);
    const int ch = tid & 255;
    const float* cw = p.in[I_HY_CONV_W] + (long)l * 3 * 768;
    const float w1[3] = {cw[256 + ch], cw[768 + 256 + ch], cw[1536 + 256 + ch]}, w2[3] = {cw[512 + ch], cw[768 + 512 + ch], cw[1536 + 512 + ch]};
    const float b1 = p.in[I_HY_CONV_B][l * 768 + 256 + ch], b2 = p.in[I_HY_CONV_B][l * 768 + 512 + ch];
    for (int u = bid; u < BATCH * (SEQ / HT); u += nb) {
        const int b = u / (SEQ / HT), t0 = (u % (SEQ / HT)) * HT;
        hy_stage(p, tl, 520, b, t0, 256, 64, tid);
        __syncthreads();
        for (int r = tid >> 8; r < HT; r += 2) tile[r * 257 + ch] = hy_short_lds(tl, 520, r, ch, w1, b1) * hy_short_lds(tl, 520, r, 256 + ch, w2, b2);
        __syncthreads();
        for (int c = wave * 2 + (lane >> 5); c < 256; c += 2 * NW) p.hz[((size_t)(b * 256 + c)) * SEQ + t0 + (lane & 31)] = f2a(tile[(lane & 31) * 257 + c]);
        __syncthreads();
    }
}
__device__ __forceinline__ void st_hy_fft(const Params& p, int wv, unsigned char* lds, int l, int bid, int nb) {
    const int tid = TIDX();
    cpx* x = (cpx*)lds; cpx* tw = x + FSLOTS;
    const int NPAIR = (BATCH + 1) / 2;
    if (bid < 256 * NPAIR) fft_load_tw(p, tw, tid);
    for (int u = bid; u < 256 * NPAIR; u += nb) {
        const int c = u / NPAIR, q = u % NPAIR, b1 = 2 * q, b2 = 2 * q + 1;
        act_t* z1 = p.hz + ((size_t)(b1 * 256 + c)) * SEQ;
        act_t* z2 = p.hz + ((size_t)((b2 < BATCH ? b2 : b1) * 256 + c)) * SEQ;
        for (int i8 = tid; i8 < FN / 8; i8 += NT) {
            float a[8] = {0.f, 0.f, 0.f, 0.f, 0.f, 0.f, 0.f, 0.f}, c2[8] = {0.f, 0.f, 0.f, 0.f, 0.f, 0.f, 0.f, 0.f};
            if (i8 * 8 < SEQ) { load8f(a, z1 + i8 * 8); if (b2 < BATCH) load8f(c2, z2 + i8 * 8); }
            for (int j = 0; j < 8; ++j) { cpx v; v.x = a[j]; v.y = c2[j]; x[fslot(i8 * 8 + j)] = v; }
        }
        __syncthreads();
        fft_fwd(x, tw, tid);
        const float* H = p.hspec + (size_t)c * FN * 2;
        for (int i = tid; i < FN; i += NT) { cpx h; h.x = H[2 * i]; h.y = H[2 * i + 1]; x[fslot(i)] = cmul(x[fslot(i)], h); }
        __syncthreads();
        fft_inv(x, tw, tid);
        for (int i8 = tid; i8 < SEQ / 8; i8 += NT) {
            float a[8], c2[8];
            for (int j = 0; j < 8; ++j) { cpx v = x[fslot(i8 * 8 + j)]; a[j] = v.x; c2[j] = v.y; }
            store8(z1 + i8 * 8, a); if (b2 < BATCH) store8(z2 + i8 * 8, c2);
        }
        __syncthreads();
    }
}
__device__ __forceinline__ void st_hy_post(const Params& p, int wv, unsigned char* lds, int l, int bid, int nb) {
    const int tid = TIDX(), wave = tid >> 6, lane = tid & 63;
    float* tile = (float*)lds;
    act_t* tl = (act_t*)(tile + HT * 257);
    const int ch = tid & 255;
    const float* cw = p.in[I_HY_CONV_W] + (long)l * 3 * 768;
    const float w0[3] = {cw[ch], cw[768 + ch], cw[1536 + ch]}, w1[3] = {cw[256 + ch], cw[768 + 256 + ch], cw[1536 + 256 + ch]}, w2[3] = {cw[512 + ch], cw[768 + 512 + ch], cw[1536 + 512 + ch]};
    const float b0 = p.in[I_HY_CONV_B][l * 768 + ch], b1 = p.in[I_HY_CONV_B][l * 768 + 256 + ch], b2 = p.in[I_HY_CONV_B][l * 768 + 512 + ch];
    const float hb = p.in[I_HY_BIAS][l * 256 + ch];
    for (int u = bid; u < BATCH * (SEQ / HT); u += nb) {
        const int b = u / (SEQ / HT), t0 = (u % (SEQ / HT)) * HT;
        hy_stage(p, tl, 776, b, t0, 0, 96, tid);
        for (int c = wave * 2 + (lane >> 5); c < 256; c += 2 * NW) tile[(lane & 31) * 257 + c] = a2f(p.hz[((size_t)(b * 256 + c)) * SEQ + t0 + (lane & 31)]);
        __syncthreads();
        for (int r = tid >> 8; r < HT; r += 2) {
            const float z = hy_short_lds(tl, 776, r, 256 + ch, w1, b1) * hy_short_lds(tl, 776, r, 512 + ch, w2, b2);
            const float x0 = hy_short_lds(tl, 776, r, ch, w0, b0);
            p.mix[(long)(b * SEQ + t0 + r) * DM + 768 + ch] = f2a(x0 * (tile[r * 257 + ch] + z * hb));
        }
        __syncthreads();
    }
}
#define RC 128
#define NCH_CTX (CTXL / RC)
#define NCH_LAT (SEQ / RC)
#define NCHK (NCH_CTX + NCH_LAT)
__device__ __forceinline__ int chunk_row0(int b, int cidx) { return cidx < NCH_CTX ? NLAT + b * CTXL + cidx * RC : b * SEQ + (cidx - NCH_CTX) * RC; }
__device__ __forceinline__ int chunk_at(int dir, int k) { if (!dir) return k; return k < NCH_CTX ? NCH_CTX - 1 - k : NCH_CTX + (NCH_LAT - 1 - (k - NCH_CTX)); }
typedef short bf16x8v __attribute__((ext_vector_type(8)));
__device__ __forceinline__ f32x4 mm16(f32x4 acc, const act_t* A, int pa, const act_t* Bt, int pb, int K, int lane) {
#if defined(EMU)
    for (int r = 0; r < 4; ++r) {
        const act_t* ap = A + (4 * (lane >> 4) + r) * pa; const act_t* bp = Bt + (lane & 15) * pb;
        float sacc = 0.f;
        for (int k = 0; k < K; ++k) sacc += a2f(ap[k]) * a2f(bp[k]);
        acc[r] += sacc;
    }
    return acc;
#else
    const act_t* ap = A + (lane & 15) * pa + 8 * (lane >> 4); const act_t* bp = Bt + (lane & 15) * pb + 8 * (lane >> 4);
    for (int k0 = 0; k0 < K; k0 += 32) {
        const bf16x8v a = *(const bf16x8v*)(ap + k0), b = *(const bf16x8v*)(bp + k0);
        acc = __builtin_amdgcn_mfma_f32_16x16x32_bf16(a, b, acc, 0, 0, 0);
    }
    return acc;
#endif
}
#define RPK (RC + 8)
#define RPQ 72
__device__ __forceinline__ void st_ret_a(const Params& p, int wv, unsigned char* lds, int l, int bid, int nb) {
    const int tid = TIDX(), wave = tid >> 6, lane = tid & 63;
    act_t* kTf = (act_t*)lds; act_t* kTb = kTf + 64 * RPK; act_t* vT = kTb + 64 * RPK;
    for (int u = bid; u < BATCH * 4 * NCHK; u += nb) {
        const int cidx = u % NCHK, h = (u / NCHK) & 3, b = u / (NCHK * 4);
        const int row0 = chunk_row0(b, cidx);
        const float lgf = log_sigmoid_f(p.in[I_RET_DECAY][(l * 2 + 0) * 4 + h]), lgb = log_sigmoid_f(p.in[I_RET_DECAY][(l * 2 + 1) * 4 + h]);
        for (int e = tid; e < RC * 8; e += NT) {
            const int sx = e >> 3, d8 = (e & 7) * 8;
            const act_t* pr = p.proj + (long)(row0 + sx) * PROJ_W;
            float kv[8], vv[8];
            load8f(kv, pr + O_RK + h * 64 + d8); load8f(vv, pr + O_RV + h * 64 + d8);
            const float df = expf(lgf * (float)(RC - 1 - sx)), db = expf(lgb * (float)sx);
            for (int j = 0; j < 8; ++j) {
                kTf[(d8 + j) * RPK + sx] = f2a(kv[j] * df);
                kTb[(d8 + j) * RPK + sx] = f2a(kv[j] * db);
                vT[(d8 + j) * RPK + sx] = f2a(vv[j]);
            }
        }
        __syncthreads();
        {
            const int dir = wave >> 2, db = wave & 3;
            const act_t* Ak = (dir ? kTb : kTf) + 16 * db * RPK;
            float* D = p.retD + ((size_t)(((b * 4 + h) * 2 + dir) * NCHK + cidx)) * 4096;
            for (int n = 0; n < 4; ++n) {
                f32x4 acc = (f32x4){0.f, 0.f, 0.f, 0.f};
                acc = mm16(acc, Ak, RPK, vT + 16 * n * RPK, RPK, RC, lane);
                for (int r = 0; r < 4; ++r) D[(16 * db + 4 * (lane >> 4) + r) * 64 + 16 * n + (lane & 15)] = acc[r];
            }
        }
        __syncthreads();
    }
}
__device__ __forceinline__ void st_ret_b(const Params& p, int wv, int l, int bid, int nb) {
    const int tid = TIDX();
    for (int it = bid * NT + tid; it < BATCH * 4 * 2 * 4096; it += nb * NT) {
        const int el = it & 4095, seq = it >> 12, dir = seq & 1, h = (seq >> 1) & 3;
        const float gC = expf((float)RC * log_sigmoid_f(p.in[I_RET_DECAY][(l * 2 + dir) * 4 + h]));
        float* base = p.retD + (size_t)seq * NCHK * 4096 + el;
        float S = 0.f;
#pragma unroll 1
        for (int kb = 0; kb < NCHK; kb += 17) {
            float Dv[17];
#pragma unroll
            for (int j = 0; j < 17; ++j) Dv[j] = (kb + j < NCHK) ? base[(size_t)chunk_at(dir, kb + j) * 4096] : 0.f;
#pragma unroll
            for (int j = 0; j < 17; ++j) if (kb + j < NCHK) { base[(size_t)chunk_at(dir, kb + j) * 4096] = S; S = gC * S + Dv[j]; }
        }
    }
}
__device__ __forceinline__ void st_ret_c(const Params& p, int wv, unsigned char* lds, int l, int bid, int nb) {
    const int tid = TIDX(), wave = tid >> 6, lane = tid & 63;
    const bool need_ctx = (l != DEPTH - 1);
    act_t* qs = (act_t*)lds; act_t* ks = qs + RC * RPQ; act_t* P = qs;
    act_t* vT = ks + RC * RPQ; act_t* qt = vT + 64 * RPK; act_t* ST = qt + RC * RPK; float* mt = (float*)(ST + 64 * RPK);
    float* of = (float*)qt;
    for (int u = bid; u < BATCH * 4 * NCHK; u += nb) {
        const int cidx = u % NCHK, h = (u / NCHK) & 3, b = u / (NCHK * 4);
        if (cidx < NCH_CTX && !need_ctx) continue;
        const int row0 = chunk_row0(b, cidx);
        const float lgf = log_sigmoid_f(p.in[I_RET_DECAY][(l * 2 + 0) * 4 + h]), lgb = log_sigmoid_f(p.in[I_RET_DECAY][(l * 2 + 1) * 4 + h]);
        for (int e = tid; e < RC * 8; e += NT) {
            const int sx = e >> 3, d8 = (e & 7) * 8;
            const act_t* pr = p.proj + (long)(row0 + sx) * PROJ_W;
            float qv[8], vv[8], q1[8], q2[8];
            load8f(qv, pr + O_RQ + h * 64 + d8); load8f(vv, pr + O_RV + h * 64 + d8);
            copy8(qs + sx * RPQ + d8, pr + O_RQ + h * 64 + d8);
            copy8(ks + sx * RPQ + d8, pr + O_RK + h * 64 + d8);
            const float e1 = expf(lgf * (float)(sx + 1)), e2 = expf(lgb * (float)(RC - sx));
            for (int j = 0; j < 8; ++j) { vT[(d8 + j) * RPK + sx] = f2a(vv[j]); q1[j] = qv[j] * e1; q2[j] = qv[j] * e2; }
            store8(qt + sx * RPK + d8, q1); store8(qt + sx * RPK + 64 + d8, q2);
        }
        for (int e = tid; e < 2 * 64 * 16; e += NT) {
            const int dir = e >> 10, d = (e >> 4) & 63, e4 = (e & 15) * 4;
            const f32x4 sv = *(const f32x4*)(p.retD + ((size_t)(((b * 4 + h) * 2 + dir) * NCHK + cidx)) * 4096 + d * 64 + e4);
            for (int j = 0; j < 4; ++j) ST[(e4 + j) * RPK + dir * 64 + d] = f2a(sv[j]);
        }
        if (tid < 2 * RC - 1) { const int dl = tid - (RC - 1); mt[tid] = dl > 0 ? expf(lgf * (float)dl) : (dl < 0 ? expf(lgb * (float)(-dl)) : 2.0f); }
        __syncthreads();
        f32x4 racc[8];
        for (int n = 0; n < 8; ++n) { racc[n] = (f32x4){0.f, 0.f, 0.f, 0.f}; racc[n] = mm16(racc[n], qs + 16 * wave * RPQ, RPQ, ks + 16 * n * RPQ, RPQ, 64, lane); }
        __syncthreads();
        for (int n = 0; n < 8; ++n) for (int r = 0; r < 4; ++r) {
            const int t = 16 * wave + 4 * (lane >> 4) + r, sx = 16 * n + (lane & 15);
            P[t * RPK + sx] = f2a(racc[n][r] * mt[t - sx + RC - 1]);
        }
        __syncthreads();
        f32x4 oacc[4];
        for (int n = 0; n < 4; ++n) {
            oacc[n] = (f32x4){0.f, 0.f, 0.f, 0.f};
            oacc[n] = mm16(oacc[n], P + 16 * wave * RPK, RPK, vT + 16 * n * RPK, RPK, RC, lane);
            oacc[n] = mm16(oacc[n], qt + 16 * wave * RPK, RPK, ST + 16 * n * RPK, RPK, 128, lane);
        }
        __syncthreads();
        for (int n = 0; n < 4; ++n) for (int r = 0; r < 4; ++r) of[(16 * wave + 4 * (lane >> 4) + r) * 68 + 16 * n + (lane & 15)] = oacc[n][r];
        __syncthreads();
        for (int rr = 0; rr < 16; ++rr) {
            const int t = 16 * wave + rr, row = row0 + t, c = h * 64 + lane;
            const float o = of[t * 68 + lane];
            const float mu = wave_sum(o) * (1.0f / 64.0f);
            const float dd = o - mu;
            const float var = wave_sum(dd * dd) * (1.0f / 64.0f);
            const float yv = dd * (1.0f / sqrtf(var + LN_EPS)) * p.in[I_RET_GN_G][l * 256 + c] + p.in[I_RET_GN_B][l * 256 + c];
            p.mix[(long)row * DM + c] = f2a(yv * silu_f(a2f(p.proj[(long)row * PROJ_W + O_RG + c])));
        }
        __syncthreads();
    }
}
#define GC 64
#define GNCH_CTX (CTXL / GC)
#define GNCH_LAT (SEQ / GC)
#define GNCHK (GNCH_CTX + GNCH_LAT)
__device__ __forceinline__ int gchunk_row0(int b, int cidx) { return cidx < GNCH_CTX ? NLAT + b * CTXL + cidx * GC : b * SEQ + (cidx - GNCH_CTX) * GC; }
__device__ __forceinline__ int gchunk_at(int dir, int k) { if (!dir) return k; return k < GNCH_CTX ? GNCH_CTX - 1 - k : GNCH_CTX + (GNCH_LAT - 1 - (k - GNCH_CTX)); }
#define GP 72
__device__ __forceinline__ void gla_cumsum(const Params& p, float* cs, int row0, int h, int tid) {
    for (int e = tid; e < 2 * GC * 8; e += NT) {
        const int dir = e >> 9, t = (e >> 3) & 63, d4 = (e & 7) * 4;
        *(f32x4*)(cs + dir * GC * 32 + t * 32 + d4) = *(const f32x4*)(p.loga + (long)(row0 + t) * 256 + dir * 128 + h * 32 + d4);
    }
    __syncthreads();
    {
        float* seg = cs + 2 * GC * 32;
        const int col = tid & 63, sg = tid >> 6, dir = col >> 5, d = col & 31;
        float* c = cs + dir * GC * 32 + d;
        float run = 0.f;
        for (int q = 0; q < 8; ++q) { const int t = dir ? GC - 1 - (sg * 8 + q) : sg * 8 + q; run += c[t * 32]; c[t * 32] = run; }
        seg[sg * 64 + col] = run;
        __syncthreads();
        float off = 0.f;
        for (int q = 0; q < sg; ++q) off += seg[q * 64 + col];
        if (sg) for (int q = 0; q < 8; ++q) { const int t = dir ? GC - 1 - (sg * 8 + q) : sg * 8 + q; c[t * 32] += off; }
    }
    __syncthreads();
}
__device__ __forceinline__ void st_gla_a(const Params& p, int wv, unsigned char* lds, int l, int bid, int nb) {
    const int tid = TIDX(), wave = tid >> 6, lane = tid & 63;
    float* cs = (float*)lds; act_t* kTf = (act_t*)(cs + 2 * GC * 32 + 512); act_t* kTb = kTf + 32 * GP; act_t* vT = kTb + 32 * GP;
    for (int u = bid; u < BATCH * 4 * GNCHK; u += nb) {
        const int cidx = u % GNCHK, h = (u / GNCHK) & 3, b = u / (GNCHK * 4);
        const int row0 = gchunk_row0(b, cidx);
        gla_cumsum(p, cs, row0, h, tid);
        for (int e = tid; e < GC * 4; e += NT) {
            const int sx = e >> 2, d8 = (e & 3) * 8;
            float kv[8];
            load8f(kv, p.proj + (long)(row0 + sx) * PROJ_W + O_GK + h * 32 + d8);
            for (int j = 0; j < 8; ++j) {
                const int d = d8 + j;
                kTf[d * GP + sx] = f2a(kv[j] * expf(cs[(GC - 1) * 32 + d] - cs[sx * 32 + d]));
                kTb[d * GP + sx] = f2a(kv[j] * expf(cs[GC * 32 + d] - cs[GC * 32 + sx * 32 + d]));
            }
        }
        for (int e = tid; e < GC * 8; e += NT) {
            const int sx = e >> 3, e8 = (e & 7) * 8;
            float vv[8];
            load8f(vv, p.proj + (long)(row0 + sx) * PROJ_W + O_GV + h * 64 + e8);
            for (int j = 0; j < 8; ++j) vT[(e8 + j) * GP + sx] = f2a(vv[j]);
        }
        const size_t ub = (size_t)(b * 4 + h) * 2;
        if (tid < 64) { const int dir = tid >> 5, d = tid & 31; p.glaE[((ub + dir) * GNCHK + cidx) * 32 + d] = expf(dir ? cs[GC * 32 + d] : cs[(GC - 1) * 32 + d]); }
        __syncthreads();
        {
            const int dir = wave >> 2, db = (wave >> 1) & 1, nh = wave & 1;
            float* D = p.glaD + ((ub + dir) * GNCHK + cidx) * 2048;
            for (int q = 0; q < 2; ++q) {
                const int n = nh * 2 + q;
                f32x4 acc = (f32x4){0.f, 0.f, 0.f, 0.f};
                acc = mm16(acc, (dir ? kTb : kTf) + 16 * db * GP, GP, vT + 16 * n * GP, GP, GC, lane);
                for (int r = 0; r < 4; ++r) D[(16 * db + 4 * (lane >> 4) + r) * 64 + 16 * n + (lane & 15)] = acc[r];
            }
        }
        __syncthreads();
    }
}
__device__ __forceinline__ void st_gla_b(const Params& p, int wv, int l, int bid, int nb) {
    const int tid = TIDX();
    for (int it = bid * NT + tid; it < BATCH * 4 * 2 * 2048; it += nb * NT) {
        const int el = it & 2047, seq = it >> 11, dir = seq & 1, d = el >> 6;
        float* base = p.glaD + (size_t)seq * GNCHK * 2048 + el;
        const float* eb = p.glaE + (size_t)seq * GNCHK * 32 + d;
        float S = 0.f;
#pragma unroll 1
        for (int kb = 0; kb < GNCHK; kb += 17) {
            float Dv[17], Ev[17];
#pragma unroll
            for (int j = 0; j < 17; ++j) { const int c = gchunk_at(dir, kb + j < GNCHK ? kb + j : 0); Dv[j] = base[(size_t)c * 2048]; Ev[j] = eb[c * 32]; }
#pragma unroll
            for (int j = 0; j < 17; ++j) if (kb + j < GNCHK) { base[(size_t)gchunk_at(dir, kb + j) * 2048] = S; S = Ev[j] * S + Dv[j]; }
        }
    }
}
__device__ __forceinline__ void st_gla_c(const Params& p, int wv, unsigned char* lds, int l, int bid, int nb) {
    const int tid = TIDX(), wave = tid >> 6, lane = tid & 63;
    const bool need_ctx = (l != DEPTH - 1);
    float* cs = (float*)lds; act_t* qt = (act_t*)(cs + 2 * GC * 32 + 512); act_t* kt = qt + GC * GP; act_t* vT = kt + GC * GP; act_t* P = vT + 64 * GP; act_t* ST = P + GC * GP;
    float* of = (float*)(ST + 64 * GP);
    for (int u = bid; u < BATCH * 4 * GNCHK; u += nb) {
        const int cidx = u % GNCHK, h = (u / GNCHK) & 3, b = u / (GNCHK * 4);
        if (cidx < GNCH_CTX && !need_ctx) continue;
        const int row0 = gchunk_row0(b, cidx);
        gla_cumsum(p, cs, row0, h, tid);
        for (int e = tid; e < GC * 8; e += NT) {
            const int sx = e >> 3, c8 = (e & 7) * 8, dir = c8 >> 5, d8 = c8 & 31;
            const act_t* pr = p.proj + (long)(row0 + sx) * PROJ_W;
            float qv[8], kv[8], vv[8], qo[8], ko[8];
            load8f(qv, pr + O_GQ + h * 32 + d8); load8f(kv, pr + O_GK + h * 32 + d8); load8f(vv, pr + O_GV + h * 64 + c8);
            for (int j = 0; j < 8; ++j) {
                const float cv = cs[dir * GC * 32 + sx * 32 + d8 + j];
                qo[j] = qv[j] * expf(cv); ko[j] = kv[j] * expf(-cv);
                vT[(c8 + j) * GP + sx] = f2a(vv[j]);
            }
            store8(qt + sx * GP + c8, qo); store8(kt + sx * GP + c8, ko);
        }
        const size_t ub = (size_t)(b * 4 + h) * 2;
        for (int e = tid; e < 2 * 32 * 16; e += NT) {
            const int dir = e >> 9, d = (e >> 4) & 31, e4 = (e & 15) * 4;
            const f32x4 sv = *(const f32x4*)(p.glaD + ((ub + dir) * GNCHK + cidx) * 2048 + d * 64 + e4);
            for (int j = 0; j < 4; ++j) ST[(e4 + j) * GP + dir * 32 + d] = f2a(sv[j]);
        }
        __syncthreads();
        {
            const int rb = wave & 3, nh = wave >> 2;
            for (int q = 0; q < 2; ++q) {
                const int n = nh * 2 + q;
                f32x4 rf = (f32x4){0.f, 0.f, 0.f, 0.f}, rbk = (f32x4){0.f, 0.f, 0.f, 0.f};
                rf = mm16(rf, qt + 16 * rb * GP, GP, kt + 16 * n * GP, GP, 32, lane);
                rbk = mm16(rbk, qt + 16 * rb * GP + 32, GP, kt + 16 * n * GP + 32, GP, 32, lane);
                for (int r = 0; r < 4; ++r) {
                    const int t = 16 * rb + 4 * (lane >> 4) + r, sx = 16 * n + (lane & 15);
                    P[t * GP + sx] = f2a((sx <= t ? rf[r] : 0.f) + (sx >= t ? rbk[r] : 0.f));
                }
            }
        }
        __syncthreads();
        {
            const int rb = wave & 3, nh = wave >> 2;
            for (int q = 0; q < 2; ++q) {
                const int n = nh * 2 + q;
                f32x4 acc = (f32x4){0.f, 0.f, 0.f, 0.f};
                acc = mm16(acc, P + 16 * rb * GP, GP, vT + 16 * n * GP, GP, GC, lane);
                acc = mm16(acc, qt + 16 * rb * GP, GP, ST + 16 * n * GP, GP, 64, lane);
                for (int r = 0; r < 4; ++r) of[(16 * rb + 4 * (lane >> 4) + r) * 68 + 16 * n + (lane & 15)] = acc[r];
            }
        }
        __syncthreads();
        for (int rr = 0; rr < 8; ++rr) {
            const int t = 8 * wave + rr, row = row0 + t, c = h * 64 + lane;
            const float o = of[t * 68 + lane];
            const float ms = wave_sum(o * o) * (1.0f / 64.0f);
            const float yv = o * (1.0f / sqrtf(ms + LN_EPS)) * p.in[I_GLA_NORM_G][l * 256 + c];
            p.mix[(long)row * DM + 256 + c] = f2a(yv * silu_f(a2f(p.proj[(long)row * PROJ_W + O_GR + c])));
        }
        __syncthreads();
    }
}
#define SC 64
#define SNCHK ((CTXL + SEQ) / SC)
#define SNCOL (BATCH * SNCHK)
#define SNCT ((SNCOL + 15) / 16)
#define SPU (SC * 16 + 8)
#define SPH 264
__device__ __forceinline__ void st_s5_tables(const Params& p, int wv, int l, int bid, int nb) {
    const int tid = TIDX();
    for (int it = bid * NT + tid; it < 16 * 127 * 256; it += nb * NT) {
        const int pp = it & 15, pq = (it >> 4) & 15, dl = (it >> 8) % 127, g = it / (127 * 256);
        const int delta = dl - 63;
        float val = 0.f;
        for (int d = 0; d < 2; ++d) {
            if (d == 0 ? delta < 0 : delta > 0) continue;
            const int tau = delta < 0 ? -delta : delta, pg = (l * 2 + d) * 16 + g;
            const float* cre = p.in[I_S5_C_RE] + ((size_t)pg * 16 + pq) * 64; const float* cim = p.in[I_S5_C_IM] + ((size_t)pg * 16 + pq) * 64;
            const float* pw = p.s5pw + ((size_t)pg * 65 + tau) * 128;
            float acc = 0.f;
            for (int n = 0; n < 64; ++n) {
                const float* tb = p.s5tab + ((size_t)pg * 64 + n) * 34;
                const float wr = pw[2 * n], wi = pw[2 * n + 1], br = tb[2 + pp], bi = tb[18 + pp];
                const float vr = wr * br - wi * bi, vi = wr * bi + wi * br;
                acc += cre[n] * vr - cim[n] * vi;
            }
            val += acc;
        }
        p.s5Tc[it] = f2a(val);
    }
    for (int it = bid * NT + tid; it < 16 * 1024 * 256; it += nb * NT) {
        const int k = it & 255, row = (it >> 8) & 1023, g = it >> 18;
        const int d = k >> 7, ri = (k >> 6) & 1, n = k & 63, i = row >> 4, pq = row & 15, pg = (l * 2 + d) * 16 + g;
        const int ex = d ? SC - i : i + 1;
        const float cr = p.in[I_S5_C_RE][((size_t)pg * 16 + pq) * 64 + n], ci = p.in[I_S5_C_IM][((size_t)pg * 16 + pq) * 64 + n];
        const float wr = p.s5pw[(((size_t)pg * 65 + ex) * 64 + n) * 2], wi = p.s5pw[(((size_t)pg * 65 + ex) * 64 + n) * 2 + 1];
        p.s5Win[it] = f2a(ri ? -(cr * wi + ci * wr) : (cr * wr - ci * wi));
    }
    for (int it = bid * NT + tid; it < 16 * 2 * 128 * 1024; it += nb * NT) {
        const int k = it & 1023, nri = (it >> 10) & 127, d = (it >> 17) & 1, g = it >> 18;
        const int j = k >> 4, pp = k & 15, ri = nri >> 6, n = nri & 63, pg = (l * 2 + d) * 16 + g;
        const int ex = d ? j : SC - 1 - j;
        const float* tb = p.s5tab + ((size_t)pg * 64 + n) * 34;
        const float wr = p.s5pw[(((size_t)pg * 65 + ex) * 64 + n) * 2], wi = p.s5pw[(((size_t)pg * 65 + ex) * 64 + n) * 2 + 1];
        const float br = tb[2 + pp], bi = tb[18 + pp];
        p.s5Wend[it] = f2a(ri ? (wr * bi + wi * br) : (wr * br - wi * bi));
    }
}
__device__ __forceinline__ void s5_load_cols(const Params& p, act_t* U, int g, int ct, int tid) {
    for (int e = tid; e < 16 * SC * 2; e += NT) {
        const int hf = e & 1, j = (e >> 1) & 63, cl = e >> 7, col = ct * 16 + cl;
        act_t* dst = U + cl * SPU + j * 16 + hf * 8;
        if (SNCOL % 16 == 0 || col < SNCOL) copy8(dst, p.proj + (long)(gchunk_row0(col / SNCHK, col % SNCHK) + j) * PROJ_W + O_SU + g * 16 + hf * 8);
        else { float z8[8] = {0.f, 0.f, 0.f, 0.f, 0.f, 0.f, 0.f, 0.f}; store8(dst, z8); }
    }
}
__device__ __forceinline__ void st_s5_a(const Params& p, int wv, unsigned char* lds, int l, int bid, int nb) {
    const int tid = TIDX(), wave = tid >> 6, lane = tid & 63;
    act_t* U = (act_t*)lds;
    for (int u = bid; u < 16 * SNCT; u += nb) {
        const int ct = u % SNCT, g = u / SNCT;
        s5_load_cols(p, U, g, ct, tid);
        __syncthreads();
        for (int dir = 0; dir < 2; ++dir) {
            f32x4 acc = (f32x4){0.f, 0.f, 0.f, 0.f};
            acc = mm16(acc, p.s5Wend + ((size_t)(g * 2 + dir) * 128 + 16 * wave) * 1024, 1024, U, SPU, 1024, lane);
            const int col = ct * 16 + (lane & 15);
            if (col < SNCOL) {
                const int b = col / SNCHK, cidx = col % SNCHK;
                float* S = p.s5S + ((size_t)((b * 16 + g) * 2 + dir) * SNCHK + cidx) * 128;
                for (int r = 0; r < 4; ++r) S[16 * wave + 4 * (lane >> 4) + r] = acc[r];
            }
        }
        __syncthreads();
    }
}
__device__ __forceinline__ void st_s5_b(const Params& p, int wv, int l, int bid, int nb) {
    const int tid = TIDX();
    for (int it = bid * NT + tid; it < BATCH * 16 * 2 * 64; it += nb * NT) {
        const int n = it & 63, seq = it >> 6, dir = seq & 1, g = (seq >> 1) & 15, pg = (l * 2 + dir) * 16 + g;
        const float lr = p.s5pw[(((size_t)pg * 65 + SC) * 64 + n) * 2], li = p.s5pw[(((size_t)pg * 65 + SC) * 64 + n) * 2 + 1];
        float* base = p.s5S + (size_t)seq * SNCHK * 128 + n;
        float hr = 0.f, hi = 0.f;
#pragma unroll 1
        for (int kb = 0; kb < SNCHK; kb += 17) {
            float sr[17], si[17];
#pragma unroll
            for (int j = 0; j < 17; ++j) { const int c = gchunk_at(dir, kb + j < SNCHK ? kb + j : 0); sr[j] = base[c * 128]; si[j] = base[c * 128 + 64]; }
#pragma unroll
            for (int j = 0; j < 17; ++j) if (kb + j < SNCHK) {
                const int c = gchunk_at(dir, kb + j);
                base[c * 128] = hr; base[c * 128 + 64] = hi;
                const float nr = lr * hr - li * hi + sr[j], ni = lr * hi + li * hr + si[j];
                hr = nr; hi = ni;
            }
        }
    }
}
__device__ __forceinline__ f32x4 mm16_toep(f32x4 acc, const act_t* Tc, int i, const act_t* U, int lane) {
#if defined(EMU)
    for (int r = 0; r < 4; ++r) {
        const int pq = 4 * (lane >> 4) + r, cl = lane & 15;
        float sacc = 0.f;
        for (int j = 0; j < SC; ++j) for (int pp = 0; pp < 16; ++pp) sacc += a2f(Tc[((i - j + 63) * 16 + pq) * 16 + pp]) * a2f(U[cl * SPU + j * 16 + pp]);
        acc[r] += sacc;
    }
    return acc;
#else
    const int pq = lane & 15, kq = lane >> 4;
    const act_t* bp = U + (lane & 15) * SPU + 8 * kq;
    for (int ks = 0; ks < SC / 2; ++ks) {
        const int j = 2 * ks + (kq >> 1);
        const bf16x8v a = *(const bf16x8v*)(Tc + ((i - j + 63) * 16 + pq) * 16 + 8 * (kq & 1)), b = *(const bf16x8v*)(bp + ks * 32);
        acc = __builtin_amdgcn_mfma_f32_16x16x32_bf16(a, b, acc, 0, 0, 0);
    }
    return acc;
#endif
}
__device__ __forceinline__ void st_s5_c(const Params& p, int wv, unsigned char* lds, int l, int bid, int nb) {
    const int tid = TIDX(), wave = tid >> 6, lane = tid & 63;
    const bool need_ctx = (l != DEPTH - 1);
    act_t* U = (act_t*)lds; act_t* Hc = U + 16 * SPU; act_t* Tc = Hc + 16 * SPH;
    for (int u = bid; u < 16 * SNCT; u += nb) {
        const int ct = u % SNCT, g = u / SNCT;
        s5_load_cols(p, U, g, ct, tid);
        for (int e = tid; e < 16 * 64; e += NT) {
            const int k4 = (e & 63) * 4, cl = e >> 6, col = ct * 16 + cl;
            float v[4] = {0.f, 0.f, 0.f, 0.f};
            if (col < SNCOL) { const f32x4 sv = *(const f32x4*)(p.s5S + ((size_t)(((col / SNCHK) * 16 + g) * 2 + (k4 >> 7)) * SNCHK + col % SNCHK) * 128 + (k4 & 127)); v[0] = sv[0]; v[1] = sv[1]; v[2] = sv[2]; v[3] = sv[3]; }
            store4(Hc + cl * SPH + k4, v);
        }
        for (int e = tid; e < 127 * 32; e += NT) copy8(Tc + e * 8, p.s5Tc + (size_t)g * 127 * 256 + e * 8);
        __syncthreads();
        const int col = ct * 16 + (lane & 15);
        const bool valid = col < SNCOL && (need_ctx || (col % SNCHK) >= GNCH_CTX);
        const int row0 = valid ? gchunk_row0(col / SNCHK, col % SNCHK) : 0;
        for (int i = wave; i < SC; i += NW) {
            f32x4 acc = (f32x4){0.f, 0.f, 0.f, 0.f};
            acc = mm16_toep(acc, Tc, i, U, lane);
            acc = mm16(acc, p.s5Win + ((size_t)g * 1024 + i * 16) * 256, 256, Hc, SPH, 256, lane);
            if (valid) {
                float o[4];
                for (int r = 0; r < 4; ++r) {
                    const int pq = 4 * (lane >> 4) + r;
                    const float yv = acc[r] + p.in[I_S5_D][l * 256 + g * 16 + pq] * a2f(U[(lane & 15) * SPU + i * 16 + pq]);
                    o[r] = gelu_tanh_f(yv);
                }
                store4(p.gbuf + (size_t)(row0 + i) * 256 + g * 16 + 4 * (lane >> 4), o);
            }
        }
        __syncthreads();
    }
}
__device__ __forceinline__ int scan_row(int b, int dir, int step, bool& isctx) {
    isctx = step < CTXL;
    if (isctx) { int t = dir ? CTXL - 1 - step : step; return NLAT + b * CTXL + t; }
    int s2 = step - CTXL; int t = dir ? SEQ - 1 - s2 : s2; return b * SEQ + t;
}
__device__ __forceinline__ void st_scan_ret(const Params& p, int wv, int l, int bid, int nb) {
    const int tid = TIDX();
    const bool need_ctx = (l != DEPTH - 1);
    for (int it = bid * NT + tid; it < BATCH * 256; it += nb * NT) {
        const int b = it >> 8, h = (it >> 6) & 3, e = it & 63;
        for (int dir = 0; dir < 2; ++dir) {
            float dec = p.in[I_RET_DECAY][(l * 2 + dir) * 4 + h];
            float g = expf(log_sigmoid_f(dec));
            float S[64];
            for (int d = 0; d < 64; ++d) S[d] = 0.f;
            for (int step = 0; step < CTXL + SEQ; ++step) {
                bool isctx; const int row = scan_row(b, dir, step, isctx);
                const act_t* pr = p.proj + (long)row * PROJ_W;
                float v = a2f(pr[O_RV + h * 64 + e]);
                float o = 0.f;
                for (int d = 0; d < 64; ++d) {
                    float k = a2f(pr[O_RK + h * 64 + d]);
                    float q = a2f(pr[O_RQ + h * 64 + d]);
                    S[d] = g * S[d] + k * v;
                    o += q * S[d];
                }
                if (!isctx || need_ctx) {
                    float* dst = p.osum + (long)row * 256 + h * 64 + e;
                    if (dir == 0) *dst = o; else *dst += o;
                }
            }
        }
    }
}
__device__ __forceinline__ void st_scan_gla(const Params& p, int wv, int l, int bid, int nb) {
    const int tid = TIDX();
    const bool need_ctx = (l != DEPTH - 1);
    for (int it = bid * NT + tid; it < BATCH * 256; it += nb * NT) {
        const int b = it >> 8, h = (it >> 6) & 3, e = it & 63;
        for (int dir = 0; dir < 2; ++dir) {
            float S[32];
            for (int d = 0; d < 32; ++d) S[d] = 0.f;
            for (int step = 0; step < CTXL + SEQ; ++step) {
                bool isctx; const int row = scan_row(b, dir, step, isctx);
                const act_t* pr = p.proj + (long)row * PROJ_W;
                const float* la = p.loga + (long)row * 256 + dir * 128 + h * 32;
                float v = a2f(pr[O_GV + h * 64 + e]);
                float o = 0.f;
                for (int d = 0; d < 32; ++d) {
                    float k = a2f(pr[O_GK + h * 32 + d]);
                    float q = a2f(pr[O_GQ + h * 32 + d]);
                    S[d] = expf(la[d]) * S[d] + k * v;
                    o += q * S[d];
                }
                if (!isctx || need_ctx) {
                    float* dst = p.osum + (long)row * 256 + h * 64 + e;
                    if (dir == 0) *dst = o; else *dst += o;
                }
            }
        }
    }
}
__device__ __forceinline__ void st_scan_s5(const Params& p, int wv, unsigned char* lds, int l, int bid, int nb) {
    const bool need_ctx = (l != DEPTH - 1);
    float* sh = (float*)lds;
    const int tid = TIDX(), gl = tid >> 6, n = tid & 63;
    float* hsh = sh + gl * 128;
    for (int blk = bid; blk < BATCH * 2; blk += nb) {
        const int b = blk >> 1, g = (blk & 1) * 8 + gl;
        for (int dir = 0; dir < 2; ++dir) {
            const int pg = (l * 2 + dir) * 16 + g;
            const float* tb = p.s5tab + ((size_t)pg * 64 + n) * 34;
            float bbr[16], bbi[16];
            for (int q = 0; q < 16; ++q) { bbr[q] = tb[2 + q]; bbi[q] = tb[18 + q]; }
            const float flr = tb[0], fli = tb[1];
            const float* cre = p.in[I_S5_C_RE] + ((long)pg * 16 + (n & 15)) * 64;
            const float* cim = p.in[I_S5_C_IM] + ((long)pg * 16 + (n & 15)) * 64;
            float hr = 0.f, hi = 0.f;
            for (int step = 0; step < CTXL + SEQ; ++step) {
                bool isctx; const int row = scan_row(b, dir, step, isctx);
                const act_t* uu = p.proj + (long)row * PROJ_W + O_SU + g * 16;
                float br = 0.f, bi = 0.f;
                for (int q = 0; q < 16; ++q) { float uv = a2f(uu[q]); br += bbr[q] * uv; bi += bbi[q] * uv; }
                float nr = flr * hr - fli * hi + br;
                float ni = flr * hi + fli * hr + bi;
                hr = nr; hi = ni;
                hsh[n] = hr; hsh[64 + n] = hi;
                __syncthreads();
                if (n < 16 && (!isctx || need_ctx)) {
                    float yv = 0.f;
                    for (int m = 0; m < 64; ++m) yv += cre[m] * hsh[m] - cim[m] * hsh[64 + m];
                    float* dst = p.osum + (long)row * 256 + g * 16 + n;
                    if (dir == 0) *dst = yv; else *dst += yv;
                }
                __syncthreads();
            }
        }
    }
}
__device__ __forceinline__ void st_finish(const Params& p, int wv, int l, int which) {
    const int tid = TIDX(), wave = tid >> 6, lane = tid & 63;
    const int nrows = (l == DEPTH - 1) ? NLAT : NTOK;
    for (int base = BIDX() * NW; base < nrows; base += NBLK() * NW) {
        const int row = base + wave;
        const act_t* pr = p.proj + (long)row * PROJ_W;
        for (int h = 0; h < 4; ++h) {
            int c = h * 64 + lane;
            float* op = p.osum + (long)row * 256 + c;
            float o = *op;
            if (which == 0) {
                float mu = wave_sum(o) * (1.0f / 64.0f);
                float d = o - mu;
                float var = wave_sum(d * d) * (1.0f / 64.0f);
                float yv = d * (1.0f / sqrtf(var + LN_EPS)) * p.in[I_RET_GN_G][l * 256 + c] + p.in[I_RET_GN_B][l * 256 + c];
                p.mix[(long)row * DM + c] = f2a(yv * silu_f(a2f(pr[O_RG + c])));
            } else if (which == 1) {
                float ms = wave_sum(o * o) * (1.0f / 64.0f);
                float yv = o * (1.0f / sqrtf(ms + LN_EPS)) * p.in[I_GLA_NORM_G][l * 256 + c];
                p.mix[(long)row * DM + 256 + c] = f2a(yv * silu_f(a2f(pr[O_GR + c])));
            } else {
                float yv = o + p.in[I_S5_D][l * 256 + c] * a2f(pr[O_SU + c]);
                *op = gelu_tanh_f(yv);
            }
        }
    }
}

#ifdef EMU
#define PHASE(call) emu_launch(EMU_GRID, NT, [&]() { unsigned char* lds = emu_lds(); (void)lds; call; })
#else
#define PHASE(call) do { call; GRID_BAR(); } while (0)
#endif

#ifndef PHMASK
#define PHMASK 0xffffffffu
#endif
#ifndef PREFIX_K
#define PREFIX_K 0
#endif
#define PHASEN(i, call) do { if (((PHMASK >> (i)) & 1u) && (KSTOP == 0 || ((i) < 3 ? (i) : 3 + 20 * lcur_ + ((i) - 3)) <= KSTOP)) PHASE(call); } while (0)
#ifndef DUPSEL
#define DUPSEL 0
#endif
#ifndef DUPN
#define DUPN 3
#endif
#define REP(k, call) do { call; if (DUPSEL == (k)) for (int _r = 0; _r < DUPN; ++_r) { call; } } while (0)
#ifdef EMU
static const int KSTOP = 0;
static void forward(const Params& p)
#else
template <int KSTOP> __global__ void __launch_bounds__(NT, 2) fwd_megakernel(Params p)
#endif
{
#ifndef EMU
    extern __shared__ __attribute__((aligned(16))) unsigned char lds[];
    {
        volatile LAS unsigned* misc = (volatile LAS unsigned*)((LAS unsigned char*)lds + LDS_MISC);
        if (threadIdx.x < 64) misc[threadIdx.x] = 0u;
        __syncthreads();
    }
    (void)xcd_barrier_post(p.ctl, (volatile LAS unsigned*)((LAS unsigned char*)lds + LDS_MISC) + 8);
    const int wv = __builtin_amdgcn_readfirstlane(threadIdx.x >> 6);
#define nbk NBLK()
#define bidx BIDX()
#else
    const int nbk = EMU_GRID; const int wv = 0; (void)wv;
#define bidx ((int)blockIdx.x)
#endif
    int lcur_ = 0;
    PHASEN(1, REP(1, st_prep(p, wv, lds)));
    PHASEN(2, REP(2, (st_prep2(p, wv), st_ln(p, wv, lds, 0, 0), st_s5_tables(p, wv, 0, bidx, nbk))));
#pragma unroll 1
    for (int l = 0; l < DEPTH; ++l) {
        lcur_ = l;
        PHASEN(3, REP(3, st_gemm<G_PROJ>(p, wv, lds, l, 0)));
        PHASEN(4, { REP(4, st_ret_a(p, wv, lds, l, bidx, nbk)); REP(5, st_gla_a(p, wv, lds, l, bidx, nbk)); REP(6, st_s5_a(p, wv, lds, l, bidx, nbk)); REP(7, st_hy_spec(p, wv, lds, l, bidx, nbk)); REP(8, st_hy_pre(p, wv, lds, l, bidx, nbk)); if (l == 0) st_hy_ctx_pre(p, wv, l, bidx, nbk); });
        PHASEN(5, (st_ret_b(p, wv, l, bidx, nbk), st_gla_b(p, wv, l, bidx, nbk), st_s5_b(p, wv, l, bidx, nbk)));
        PHASEN(6, { REP(9, st_ret_c(p, wv, lds, l, bidx, nbk)); REP(10, st_gla_c(p, wv, lds, l, bidx, nbk)); REP(11, st_s5_c(p, wv, lds, l, bidx, nbk)); st_hy_fft(p, wv, lds, l, bidx, nbk); if (l == 0) st_hy_ctx_conv(p, wv, l, bidx, nbk); });
        PHASEN(10, { REP(12, st_hy_post(p, wv, lds, l, bidx, nbk)); REP(13, st_glu2(p, wv, lds, l, bidx, nbk)); });
        PHASEN(11, REP(14, st_gemm<G_OUT>(p, wv, lds, l, 0)));
        if ((l & 1) == 0) {
            PHASEN(12, st_ln(p, wv, lds, l, 1));
            PHASEN(13, REP(15, st_gemm<G_FFN1>(p, wv, lds, l, 0)));
            PHASEN(14, REP(16, st_gemm<G_FFN2>(p, wv, lds, l, 0)));
        } else {
            PHASEN(15, { st_ln(p, wv, lds, l, 1); REP(19, st_convert_items(p, wv, lds, 1)); });
            PHASEN(17, st_place(p, wv, lds));
#pragma unroll 1
            for (int ps = 0; ps < MOE_NPASS; ++ps) {
                PHASEN(18, REP(17, st_gemm<G_MFFN1>(p, wv, lds, l, ps)));
                PHASEN(19, REP(18, st_gemm<G_MFFN2>(p, wv, lds, l, ps)));
            }
        }
        PHASEN(20, (st_ln(p, wv, lds, l, 2), (l + 1 < DEPTH ? st_s5_tables(p, wv, l + 1, bidx, nbk) : (void)0)));
        if (DUPSEL == 20) for (int _r = 0; _r < 10; ++_r) { PHASE((void)0); }
    }
}

static inline size_t align_up(size_t v, size_t a) { return (v + a - 1) / a * a; }
#ifdef EMU
Params g_dbg_params;
#endif

extern "C" void kernel_launch(void* const* d_in, const int* in_sizes, int n_in, void* d_out, int out_size, void* d_ws,
                              size_t ws_size, hipStream_t stream) {
    Params p{};
    for (int i = 0; i < N_IN; ++i) p.in[i] = (const float*)d_in[i];
    p.out = (float*)d_out;
    char* ws = (char*)d_ws;
    size_t off = 0;
    auto take = [&](size_t bytes) { char* r = ws + off; off = align_up(off + bytes, 256); return r; };
    const size_t A = sizeof(act_t);
    p.ctl = (unsigned*)take(CTL_WORDS * 4);
    const size_t big_a = (size_t)NTOK * PROJ_W * A + (size_t)NTOK * 256 * A;
    const size_t big_b = (size_t)NEXP * 3 * DM * DFF * A + (size_t)MOE_PT * 256 * DFF * A;
    const size_t big_c = big_a + (size_t)2 * 16 * 1024 * 256 * A;
    char* big = take(big_c > big_b ? big_c : big_b);
    p.proj = (act_t*)big;
    p.hz = (act_t*)(big + (size_t)NTOK * PROJ_W * A);
    p.wmoe13 = (act_t*)big;
    p.wmoe2 = p.wmoe13 + (size_t)NEXP * 2 * DFF * DM;
    p.hch = p.wmoe2 + (size_t)NEXP * DM * DFF;
    p.u = (act_t*)take((size_t)NTOK * DM * A > (size_t)NTOK * DM * 2 ? (size_t)NTOK * DM * A : (size_t)NTOK * DM * 2);
    p.retD = (float*)p.u;
    p.glaD = p.retD + (size_t)NTOK * 256;
    p.glaE = (float*)take((size_t)BATCH * 4 * 2 * ((CTXL + SEQ) / 64) * 32 * 4);
    char* mixr = take((size_t)NTOK * DM * A + (size_t)2 * NTOK * 256 * 4);
    p.mix = (act_t*)mixr;
    p.osum = (float*)(mixr + (size_t)NTOK * DM * A);
    p.gbuf = (act_t*)p.osum;
    p.loga = p.osum + (size_t)NTOK * 256;
    p.ys = (act_t*)mixr;
    p.win_t = (act_t*)take((size_t)DEPTH * NPROJ_T * DM * A);
    p.wout_t = (act_t*)take((size_t)DEPTH * DM * DM * A);
    p.w13_t = (act_t*)take((size_t)2 * DFF * DM * A);
    p.w2_t = (act_t*)take((size_t)DM * DFF * A);
    p.wglu_t = (act_t*)take((size_t)DEPTH * 256 * 256 * A);
    p.mod = (float*)take((size_t)DEPTH * (BATCH + 1) * 6 * DM * 4);
    p.hctx = (float*)take((size_t)NCTX * DM * 4);
    p.filt = (float*)take((size_t)DEPTH * FILT_LAYER_FLOATS * 4);
    p.fnorm = (float*)take((size_t)DEPTH * 256 * 4);
    p.hdn2 = (float*)take((size_t)DEPTH * SEQ * 64 * 4);
    p.fft_tw = (float*)take((size_t)FN * 4);
    p.hspec = (float*)take((size_t)256 * FN * 2 * 4);
    p.rot = (float*)take((size_t)SEQ * 32 * 2 * 4);
    p.s5tab = (float*)take((size_t)DEPTH * 2 * 16 * 64 * 34 * 4);
    p.s5pw = (float*)take((size_t)DEPTH * 2 * 16 * 65 * 64 * 2 * 4);
    p.s5Tc = (act_t*)take((size_t)16 * 127 * 256 * A);
    p.s5S = (float*)take((size_t)BATCH * 16 * 2 * ((CTXL + SEQ) / 64) * 128 * 4);
    p.s5Win = (act_t*)(big + big_a);
    p.s5Wend = p.s5Win + (size_t)16 * 1024 * 256;
    p.tok_e = (int*)take((size_t)NLAT * 2 * 4);
    p.tok_g = (float*)take((size_t)NLAT * 2 * 4);
    p.slot_asg = (int*)take((size_t)MOE_CAP * 4);
#ifdef EMU
    g_dbg_params = p;
    memset(p.ctl, 0, CTL_WORDS * 4);
    forward(p);
#else
    if (off > ws_size) return;
    static int grid_blocks = 0;
    if (!grid_blocks) {
        int dev = 0, cus = 0;
        (void)hipGetDevice(&dev);
        (void)hipDeviceGetAttribute(&cus, hipDeviceAttributeMultiprocessorCount, dev);
        (void)hipFuncSetAttribute((const void*)fwd_megakernel<0>, hipFuncAttributeMaxDynamicSharedMemorySize, LDS_BYTES);
#if PREFIX_K > 0
        (void)hipFuncSetAttribute((const void*)fwd_megakernel<PREFIX_K>, hipFuncAttributeMaxDynamicSharedMemorySize, LDS_BYTES);
#endif
        grid_blocks = cus;
    }
#if PREFIX_K > 0
    (void)hipMemsetAsync(p.ctl, 0, CTL_WORDS * 4, stream);
    hipLaunchKernelGGL(fwd_megakernel<PREFIX_K>, dim3(grid_blocks), dim3(NT), LDS_BYTES, stream, p);
#endif
    (void)hipMemsetAsync(p.ctl, 0, CTL_WORDS * 4, stream);
    hipLaunchKernelGGL(fwd_megakernel<0>, dim3(grid_blocks), dim3(NT), LDS_BYTES, stream, p);
#endif
}
```

```cpp
#ifndef EMU
#include <hip/hip_runtime.h>
#endif
#include <stdint.h>
#include <math.h>

#ifndef BATCH
#define BATCH 8
#endif
#ifndef SEQ
#define SEQ 4096
#endif
#ifndef CTXL
#define CTXL 256
#endif
#define NT 512
#define NW 8
#define DM 1024
#define DEPTH 2
#define GRID_W 64
#define DPROJ_IN 2848
#define PROJ_W 2816
#define NPROJ_T 3072
#define DFF 2816
#define NEXP 8
#define NLAT (BATCH * SEQ)
#define NCTX (BATCH * CTXL)
#define NTOK (NLAT + NCTX)
#define MOE_CAP (2 * NLAT + NEXP * 256)
#define MOE_TILES (MOE_CAP / 256)
#ifndef MOE_PT
#define MOE_PT 64
#endif
#define MOE_NPASS ((MOE_TILES + MOE_PT - 1) / MOE_PT)
#define LN_EPS 1e-5f
#define ALPHA 1.4142135623730951f
#define O_RQ 0
#define O_RK 256
#define O_RV 512
#define O_RG 768
#define O_GQ 1024
#define O_GK 1152
#define O_GV 1280
#define O_GR 1536
#define O_SU 1792
#define O_HP 2048

enum { I_X, I_C, I_CTX, I_CCTX, I_ADA_W, I_ADA_B, I_W_IN, I_RET_DECAY, I_RET_GN_G, I_RET_GN_B, I_GLA_WA, I_GLA_BA,
       I_GLA_NORM_G, I_S5_LAM_RE, I_S5_LAM_IM, I_S5_LOG_DT, I_S5_B_RE, I_S5_B_IM, I_S5_C_RE, I_S5_C_IM, I_S5_D,
       I_S5_GLU_W, I_S5_GLU_B, I_HY_CONV_W, I_HY_CONV_B, I_HY_FW1, I_HY_FB1, I_HY_FREQ, I_HY_FW2, I_HY_FB2, I_HY_FW3,
       I_HY_DECAY, I_HY_BIAS, I_W_OUT, I_LN_MIX_G, I_LN_MIX_B, I_LN_FFN_G, I_LN_FFN_B, I_FFN_W1, I_FFN_W3, I_FFN_W2,
       I_ROUTER_W, I_ROUTER_B, I_MOE_W1, I_MOE_W3, I_MOE_W2, N_IN };

typedef float f32x4 __attribute__((ext_vector_type(4)));
typedef unsigned u32x4 __attribute__((ext_vector_type(4)));

#ifdef EMU_F32ACT
typedef float act_t;
__device__ __forceinline__ float a2f(act_t v) { return v; }
__device__ __forceinline__ act_t f2a(float f) { return f; }
#else
typedef unsigned short act_t;
__device__ __forceinline__ float a2f(act_t v) { union { unsigned u; float f; } c; c.u = ((unsigned)v) << 16; return c.f; }
__device__ __forceinline__ act_t f2a(float f) { union { unsigned u; float f; } c; c.f = f; unsigned u = c.u; u += 0x7fffu + ((u >> 16) & 1u); return (act_t)(u >> 16); }
#endif
__device__ __forceinline__ void store8(act_t* p, const float* v) {
#if defined(EMU)
    for (int i = 0; i < 8; ++i) p[i] = f2a(v[i]);
#else
    u32x4 w;
    w.x = (unsigned)f2a(v[0]) | ((unsigned)f2a(v[1]) << 16); w.y = (unsigned)f2a(v[2]) | ((unsigned)f2a(v[3]) << 16);
    w.z = (unsigned)f2a(v[4]) | ((unsigned)f2a(v[5]) << 16); w.w = (unsigned)f2a(v[6]) | ((unsigned)f2a(v[7]) << 16);
    *(u32x4*)p = w;
#endif
}

__device__ __forceinline__ void copy8(act_t* dst, const act_t* src) {
#if defined(EMU)
    for (int i = 0; i < 8; ++i) dst[i] = src[i];
#else
    *(u32x4*)dst = *(const u32x4*)src;
#endif
}
__device__ __forceinline__ void load8f(float* v, const act_t* src) {
#if defined(EMU)
    for (int i = 0; i < 8; ++i) v[i] = a2f(src[i]);
#else
    const u32x4 w = *(const u32x4*)src;
    v[0] = __builtin_bit_cast(float, w.x << 16); v[1] = __builtin_bit_cast(float, w.x & 0xffff0000u);
    v[2] = __builtin_bit_cast(float, w.y << 16); v[3] = __builtin_bit_cast(float, w.y & 0xffff0000u);
    v[4] = __builtin_bit_cast(float, w.z << 16); v[5] = __builtin_bit_cast(float, w.z & 0xffff0000u);
    v[6] = __builtin_bit_cast(float, w.w << 16); v[7] = __builtin_bit_cast(float, w.w & 0xffff0000u);
#endif
}
__device__ __forceinline__ void store4(act_t* p, const float* v) {
#if defined(EMU)
    for (int i = 0; i < 4; ++i) p[i] = f2a(v[i]);
#else
    typedef unsigned u32x2 __attribute__((ext_vector_type(2)));
    u32x2 w; w.x = (unsigned)f2a(v[0]) | ((unsigned)f2a(v[1]) << 16); w.y = (unsigned)f2a(v[2]) | ((unsigned)f2a(v[3]) << 16);
    *(u32x2*)p = w;
#endif
}
struct Params {
    const float* in[N_IN];
    float* out;
    unsigned* ctl;
    float* mod;
    act_t* proj;
    act_t* hz;
    act_t* wmoe13;
    act_t* wmoe2;
    act_t* hch;
    act_t* u;
    float* retD;
    float* glaD;
    float* glaE;
    act_t* mix;
    float* osum;
    act_t* gbuf;
    act_t* wglu_t;
    float* loga;
    act_t* ys;
    act_t* win_t;
    act_t* wout_t;
    act_t* w13_t;
    act_t* w2_t;
    float* hctx;
    float* filt;
    float* fnorm;
    float* hdn2;
    float* fft_tw;
    float* hspec;
    float* rot;
    float* s5tab;
    float* s5pw;
    act_t* s5Tc;
    act_t* s5Win;
    act_t* s5Wend;
    float* s5S;
    int* tok_e;
    float* tok_g;
    int* slot_asg;
};
#define CTL_MOE 4096
#define CTL_WORDS 4224
#define FILT_LAYER_FLOATS (2 * CTXL * 256)
#define FN (2 * SEQ)
#if SEQ == 4096
#define FLOG 13
#elif SEQ == 512
#define FLOG 10
#elif SEQ == 256
#define FLOG 9
#endif

#define LDS_RING 131072
#define LDS_BYTES 147456
#define LDS_MISC (LDS_BYTES - 256)
#ifdef EMU
#define GRID_BAR()
#else
#define LAS __attribute__((address_space(3)))
#define XB_TMO      128
#define XB_XCNT(j)  (256  + 64 * (j))
#define XB_XSUB(j)  (1280 + 64 * (j))
#define XB_XGEN(j)  (2304 + 64 * (j))
#define XB_TOP      3328
#define XB_TOPGEN   3392
#define XCD_BAR_WORDS 3456
#define XB_SPIN_CAP (1u << 26)
__device__ __forceinline__ unsigned xb_ld(unsigned* p)              { return __hip_atomic_load(p, __ATOMIC_RELAXED, __HIP_MEMORY_SCOPE_AGENT); }
__device__ __forceinline__ unsigned xb_add(unsigned* p, unsigned v) { return __hip_atomic_fetch_add(p, v, __ATOMIC_RELAXED, __HIP_MEMORY_SCOPE_AGENT); }
__device__ __forceinline__ unsigned xb_xcc_id() { return (unsigned)__builtin_amdgcn_s_getreg((3 << 11) | 20) & 0xFu; }
#define XB_SPIN(cond, bar) do { unsigned _sp = 0; while (cond) { __builtin_amdgcn_s_sleep(1); \
    if ((++_sp & 255u) == 0u) { if (xb_ld(&(bar)[XB_TMO])) break; if (_sp > XB_SPIN_CAP) { atomicAdd(&(bar)[XB_TMO], 1u); break; } } } } while (0)
struct XcdBarrier { unsigned* bar; unsigned x; volatile LAS unsigned* st; };
__device__ __forceinline__ XcdBarrier xcd_barrier_post(unsigned* bar, volatile LAS unsigned* st) {
    XcdBarrier b; b.bar = bar; b.x = xb_xcc_id(); b.st = st;
    if (threadIdx.x == 0) (void)xb_add(&bar[XB_XCNT(b.x)], 1u);
    return b;
}
__device__ __forceinline__ void xcd_barrier_complete(unsigned* bar, unsigned x, unsigned& nloc, unsigned& nx) {
    const unsigned G = gridDim.x * gridDim.y * gridDim.z;
    unsigned sum, cnt, mine, sp = 0u;
    for (;;) {
        sum = 0u; cnt = 0u; mine = 0u;
#pragma unroll
        for (unsigned j = 0; j < 16; ++j) { const unsigned c = xb_ld(&bar[XB_XCNT(j)]); sum += c; cnt += (c > 0u) ? 1u : 0u; mine = (j == x) ? c : mine; }
        if (sum == G) break;
        __builtin_amdgcn_s_sleep(1);
        if ((++sp & 255u) == 0u) { if (xb_ld(&bar[XB_TMO])) break; if (sp > XB_SPIN_CAP) { atomicAdd(&bar[XB_TMO], 1u); break; } }
    }
    nloc = mine > 0u ? mine : 1u; nx = cnt > 0u ? cnt : 1u;
}
__device__ __forceinline__ void xcd_barrier(const XcdBarrier& b) {
    asm volatile("s_waitcnt vmcnt(0)" ::: "memory");
    __syncthreads();
    if (threadIdx.x == 0) {
        unsigned* bar = b.bar;
        __builtin_amdgcn_s_waitcnt(0);
        unsigned nloc = b.st[0], nx = b.st[1];
        if (nloc == 0u) { xcd_barrier_complete(bar, b.x, nloc, nx); b.st[0] = nloc; b.st[1] = nx; }
        const unsigned old = xb_add(&bar[XB_XSUB(b.x)], 1u);
        const unsigned gen = old / nloc;
        if (old + 1u == (gen + 1u) * nloc) {
            __builtin_amdgcn_fence(__ATOMIC_RELEASE, "agent");
            asm volatile("s_waitcnt vmcnt(0)" ::: "memory");
            const unsigned og = xb_add(&bar[XB_TOP], 1u);
            const unsigned tg = og / nx;
            if (og + 1u == (tg + 1u) * nx) xb_add(&bar[XB_TOPGEN], 1u);
            else XB_SPIN(xb_ld(&bar[XB_TOPGEN]) == tg, bar);
            __builtin_amdgcn_fence(__ATOMIC_ACQUIRE, "agent");
            xb_add(&bar[XB_XGEN(b.x)], 1u);
            asm volatile("s_waitcnt vmcnt(0)" ::: "memory");
        } else {
            XB_SPIN(xb_ld(&bar[XB_XGEN(b.x)]) == gen, bar);
            __builtin_amdgcn_fence(__ATOMIC_ACQUIRE, "agent");
            asm volatile("s_waitcnt vmcnt(0)" ::: "memory");
        }
    }
    __syncthreads();
}
#define GRID_BAR() do { XcdBarrier _b; _b.bar = p.ctl; _b.x = xb_xcc_id(); _b.st = (volatile LAS unsigned*)((LAS unsigned char*)lds + LDS_MISC) + 8; xcd_barrier(_b); } while (0)
#endif

#ifdef EMU
#define TIDX() ((int)threadIdx.x)
#define BIDX() ((int)blockIdx.x)
#define NBLK() ((int)gridDim.x)
#else
#define BIDX() bid_opaque()
#define NBLK() nblk_opaque()
__device__ __forceinline__ int tid_opaque(int wv) { int t; asm volatile("v_mbcnt_lo_u32_b32 %0, -1, 0\n\tv_mbcnt_hi_u32_b32 %0, -1, %0\n\tv_lshl_add_u32 %0, %1, 6, %0" : "=&v"(t) : "s"(wv)); return t; }
#define TIDX() tid_opaque(wv)
__device__ __forceinline__ int bid_opaque() { int t = blockIdx.x; asm volatile("" : "+s"(t)); return t; }
__device__ __forceinline__ int nblk_opaque() { int t = gridDim.x; asm volatile("" : "+s"(t)); return t; }
#endif
#ifdef EMU
__device__ __forceinline__ float wave_sum(float v) {
    for (int o = 32; o > 0; o >>= 1) v += __shfl_xor(v, o);
    return v;
}
#else
__device__ __forceinline__ float wave_sum(float v) {
#define WS_STEP(m) v += __builtin_bit_cast(float, __builtin_amdgcn_ds_swizzle(__builtin_bit_cast(int, v), ((m) << 10) | 0x1f))
    WS_STEP(1); WS_STEP(2); WS_STEP(4); WS_STEP(8); WS_STEP(16);
#undef WS_STEP
    float a = v, b = v;
    asm volatile("s_nop 1\n\tv_permlane32_swap_b32 %0, %1" : "+v"(a), "+v"(b));
    return a + b;
}
#endif
__device__ __forceinline__ float silu_f(float x) { return x / (1.0f + expf(-x)); }
__device__ __forceinline__ float sigmoid_f(float x) { return 1.0f / (1.0f + expf(-x)); }
__device__ __forceinline__ float log_sigmoid_f(float x) { return fminf(x, 0.0f) - log1pf(expf(-fabsf(x))); }
#ifdef EMU
#define EPI_FENCE()
__device__ __forceinline__ float log_sigmoid_fast(float x) { return log_sigmoid_f(x); }
#else
#define EPI_FENCE() asm volatile("" ::: "memory")
__device__ __forceinline__ float log_sigmoid_fast(float x) { return fminf(x, 0.0f) - __logf(1.0f + __expf(-fabsf(x))); }
#endif
__device__ __forceinline__ float gelu_tanh_f(float x) {
    return 0.5f * x * (1.0f + tanhf(0.7978845608028654f * (x + 0.044715f * x * x * x)));
}
__device__ __forceinline__ void ln_stats16(const float* v, float& mu, float& rstd) {
    float s = 0.f;
    for (int i = 0; i < 16; ++i) s += v[i];
    s = wave_sum(s);
    mu = s * (1.0f / DM);
    float q = 0.f;
    for (int i = 0; i < 16; ++i) { float d = v[i] - mu; q += d * d; }
    q = wave_sum(q);
    rstd = 1.0f / sqrtf(q * (1.0f / DM) + LN_EPS);
}
__device__ __forceinline__ int row_modidx(int row) { return row < NLAT ? row / SEQ : BATCH; }

struct Unit { int pm, pn; };
struct Gemm { const act_t* A; const act_t* Bt; int M, N, K; const int* rowmap; };
#define GBM 256
#define GNXCD 8
#define GWGM 8
struct StaticOrder {
    int nM, nN, nwg, G, c;
    __device__ void init(int M, int N, int G_, int c_) { nM = M / GBM; nN = N / GBM; nwg = nM * nN; G = G_; c = c_; }
    __device__ bool next(int i, Unit& u) const {
        const long L = (long)i * G + c; if (L >= nwg) return false;
        int wgid = (int)L; { const int q = nwg / GNXCD, r = nwg % GNXCD, xcd = wgid % GNXCD, off = wgid / GNXCD; wgid = (xcd < r ? xcd * (q + 1) : r * (q + 1) + (xcd - r) * q) + off; }
        const int nig = GWGM * nN, gid = wgid / nig, fm = gid * GWGM, gsz = (nM - fm) < GWGM ? (nM - fm) : GWGM;
        u.pm = fm + ((wgid % nig) % gsz); u.pn = (wgid % nig) / gsz; return true;
    }
    __device__ __forceinline__ const act_t* b_base(const Unit& u, const Gemm& g) const { return g.Bt + (size_t)u.pn * GBM * g.K; }
};
struct MoeOrder {
    StaticOrder so; int t0; int pend[NEXP]; size_t estride;
    __device__ bool next(int i, Unit& u) const { if (!so.next(i, u)) return false; u.pm += t0; return true; }
    __device__ __forceinline__ const act_t* b_base(const Unit& u, const Gemm& g) const {
        int e = 0;
#pragma unroll
        for (int q = 0; q < NEXP - 1; ++q) e += (u.pm * 256 >= pend[q]) ? 1 : 0;
        return g.Bt + (size_t)e * estride + (size_t)u.pn * GBM * g.K;
    }
};

template <class Epi, class Sched, bool GATHER>
__device__ __forceinline__ void gemm_phase_ref(int wv, const Gemm g, const Sched& S, const Epi& E) {
    const int tid = TIDX(), wid = tid >> 6, lane = tid & 63, wr = wid >> 2, wc = wid & 3, fr = lane & 15, fq = lane >> 4;
    Unit cur;
    for (int ui = 0; S.next(ui, cur); ++ui) {
        f32x4 acc[2][2][4][2];
        const act_t* Bt = S.b_base(cur, g);
        _Pragma("unroll") for (int ai = 0; ai < 2; ++ai) _Pragma("unroll") for (int bj = 0; bj < 2; ++bj) _Pragma("unroll") for (int m = 0; m < 4; ++m) _Pragma("unroll") for (int n = 0; n < 2; ++n) _Pragma("unroll") for (int j = 0; j < 4; ++j) {
            int r = cur.pm * 256 + ai * 128 + wr * 64 + m * 16 + fr;
            int cl = Epi::PERM ? (bj * 128 + wc * 32 + 8 * fq + 4 * n + j) : (bj * 128 + wc * 32 + 16 * n + 4 * fq + j);
            long ar = r;
            if (GATHER) { int a = g.rowmap[r]; ar = a >= 0 ? (a >> 1) : 0; }
            const act_t* ap = g.A + ar * g.K; const act_t* bp = Bt + (long)cl * g.K;
            float s = 0.f;
            _Pragma("unroll 4") for (int k = 0; k < g.K; ++k) s += a2f(ap[k]) * a2f(bp[k]);
            acc[ai][bj][m][n][j] = s;
        }
        E(acc, cur, wr, wc, fr, fq);
    }
}
#ifdef EMU
template <class Epi, class Sched, bool GATHER>
void gemm_phase(unsigned char*, int wv, const Gemm g, const Sched& S, const Epi& E) { gemm_phase_ref<Epi, Sched, GATHER>(wv, g, S, E); }
#else
namespace pg8 {
#define PG8_LAS __attribute__((address_space(3)))
typedef short bf16x8 __attribute__((ext_vector_type(8)));
constexpr int BM = 256, BK = 64, HALF = 128, HTB = HALF * BK * 2, STAGE_BYTES = 8 * HTB;
__device__ __forceinline__ int lds_byte(int r, int c) { const int st = (r >> 4) * 2 + (c >> 5), rr = r & 15, cc = c & 31, ob = rr * 64 + cc * 2; return st * 1024 + (ob ^ (((ob >> 9) & 1) << 5)); }
__device__ __forceinline__ void stage_rc(int b, int& R, int& C) { const int st = b / 1024, sb = b % 1024, swz = sb ^ (((sb >> 9) & 1) << 5); R = (st >> 1) * 16 + swz / 64; C = (st & 1) * 32 + (swz % 64) / 2; }
__device__ __forceinline__ int perm32(int rho) { const int n = rho >> 4, i = rho & 15; return 8 * (i >> 2) + 4 * n + (i & 3); }
template <class Epi, class Sched, bool GATHER>
__device__ __forceinline__ void gemm_phase(PG8_LAS unsigned char* lds, int wv, const Gemm g, const Sched& S, const Epi& E) {
    const int tid = TIDX(), wid = __builtin_amdgcn_readfirstlane(tid >> 6), lane = tid & 63, wr = wid >> 2, wc = wid & 3, fr = lane & 15, fq = lane >> 4;
    const int K = g.K, nt = K / BK;
    unsigned voffA[2], voffB[2];
    unsigned gc0[2], gc1[2], gn0[2], gn1[2];
    int sR[2], sC[2];
#pragma unroll
    for (int i = 0; i < 2; ++i) { int R, C; stage_rc(tid * 16 + i * 8192, R, C); sR[i] = R; sC[i] = C; const int Rb = Epi::PERM ? ((R & ~31) + perm32(R & 31)) : R;
        voffA[i] = (unsigned)(R * K + C) * 2u; voffB[i] = (unsigned)(Rb * K + C) * 2u; }
    const size_t kstep = (size_t)(BK * 2);
    const size_t hstep = (size_t)HALF * K * 2;
    const size_t tstep = 2 * hstep;
    const unsigned ldsw = (unsigned)wid * 1024u;
    const int aoff = lds_byte(wr * 64 + fr, fq * 8), boff = lds_byte(wc * 32 + fr, fq * 8);
    auto g_offs = [&](const Unit& u, unsigned (&o0)[2], unsigned (&o1)[2]) {
#pragma unroll
        for (int i = 0; i < 2; ++i) {
            const int a0 = g.rowmap[u.pm * BM + sR[i]], a1 = g.rowmap[u.pm * BM + HALF + sR[i]];
            const int r0 = a0 >= 0 ? (a0 >> 1) : 0, r1 = a1 >= 0 ? (a1 >> 1) : 0;
            o0[i] = (unsigned)(r0 * K + sC[i]) * 2u; o1[i] = (unsigned)(r1 * K + sC[i]) * 2u;
        }
    };
#define PG8_SA(b, h) (((b) * 2 + (h)) * HTB)
#define PG8_SB(b, h) ((4 + (b) * 2 + (h)) * HTB)
#define PG8_STAGE(bufoff, gbase, voff) do { _Pragma("unroll") for (int _i = 0; _i < 2; ++_i) { unsigned _o = (voff)[_i]; if (GATHER) asm volatile("" : "+v"(_o)); \
        __builtin_amdgcn_global_load_lds((const unsigned*)((const char*)(gbase) + _o), (PG8_LAS unsigned*)(lds + (bufoff) + ldsw + _i * 8192), 16, 0, 0); } } while (0)
#define PG8_STAGE_A(bufoff, h, tile, koff, o0, o1) do { if constexpr (GATHER) { if (h) PG8_STAGE(bufoff, gA + (koff), o1); else PG8_STAGE(bufoff, gA + (koff), o0); } \
        else PG8_STAGE(bufoff, (tile) + (koff) + (h) * hstep, voffA); } while (0)
#define PG8_LDA(dst, b, h) do { _Pragma("unroll") for (int m = 0; m < 4; ++m) _Pragma("unroll") for (int k = 0; k < 2; ++k) dst[m][k] = *(const PG8_LAS bf16x8*)(lds + PG8_SA(b, h) + aoff + m * 2048 + k * 1024); } while (0)
#define PG8_LDB(dst, b, h) do { _Pragma("unroll") for (int n = 0; n < 2; ++n) _Pragma("unroll") for (int k = 0; k < 2; ++k) dst[n][k] = *(const PG8_LAS bf16x8*)(lds + PG8_SB(b, h) + boff + n * 2048 + k * 1024); } while (0)
#define PG8_MMA(ai, bj, At, Bt) do { __builtin_amdgcn_s_setprio(1); _Pragma("unroll") for (int m = 0; m < 4; ++m) _Pragma("unroll") for (int n = 0; n < 2; ++n) _Pragma("unroll") for (int k = 0; k < 2; ++k) \
        acc[ai][bj][m][n] = __builtin_amdgcn_mfma_f32_16x16x32_bf16(Bt[n][k], At[m][k], acc[ai][bj][m][n], 0, 0, 0); __builtin_amdgcn_s_setprio(0); } while (0)
#define PG8_WAIT_V(n) asm volatile("s_waitcnt vmcnt(" #n ")" ::: "memory")
#define PG8_WAIT_L(n) asm volatile("s_waitcnt lgkmcnt(" #n ")" ::: "memory")
#define PG8_BAR __builtin_amdgcn_s_barrier()
#define PG8_SCHED __builtin_amdgcn_sched_barrier(0)
    Unit cur, nxt; int ui = 0;
    if (!S.next(0, cur)) return;
    float zf = 0.f; asm volatile("" : "+v"(zf));
    f32x4 acc[2][2][4][2];
#pragma unroll
    for (int a = 0; a < 2; ++a)
#pragma unroll
        for (int b = 0; b < 2; ++b)
#pragma unroll
            for (int m = 0; m < 4; ++m)
#pragma unroll
                for (int n = 0; n < 2; ++n) acc[a][b][m][n] = (f32x4){zf, zf, zf, zf};
    bf16x8 At[4][2], B0[2][2], B1[2][2];
    const char* gA = (const char*)g.A;
    const char* cA = gA + (size_t)cur.pm * tstep;
    const char* cB = (const char*)S.b_base(cur, g);
    if constexpr (GATHER) g_offs(cur, gc0, gc1);
    {
        PG8_STAGE(PG8_SB(0, 0), cB, voffB); PG8_STAGE(PG8_SB(0, 1), cB + hstep, voffB); PG8_STAGE_A(PG8_SA(0, 0), 0, cA, 0, gc0, gc1); PG8_STAGE_A(PG8_SA(0, 1), 1, cA, 0, gc0, gc1);
        if (wr == 1) PG8_BAR;
        PG8_WAIT_V(2); PG8_BAR;
        PG8_STAGE(PG8_SB(1, 0), cB + kstep, voffB); PG8_STAGE_A(PG8_SA(1, 0), 0, cA, kstep, gc0, gc1); PG8_STAGE(PG8_SB(1, 1), cB + hstep + kstep, voffB);
        PG8_WAIT_V(6); PG8_BAR;
    }
    for (;;) {
        const bool has_next = S.next(ui + 1, nxt);
        const char* nA = has_next ? gA + (size_t)nxt.pm * tstep : cA;
        const char* nB = has_next ? (const char*)S.b_base(nxt, g) : cB;
        if constexpr (GATHER) { if (has_next) g_offs(nxt, gn0, gn1); else { gn0[0] = gc0[0]; gn0[1] = gc0[1]; gn1[0] = gc1[0]; gn1[1] = gc1[1]; } }
        for (int t = 0; t < nt; t += 2) {
            const bool last = (t == nt - 2);
            const size_t k1 = (size_t)(t + 1) * kstep;
            const char* tA = last ? nA : cA;
            const size_t k2 = last ? 0 : (size_t)(t + 2) * kstep, k3 = k2 + kstep;
            const char* b2 = last ? nB : cB + (size_t)(t + 2) * kstep; const char* b3 = b2 + kstep;
            unsigned w0[2], w1[2];
            if constexpr (GATHER) { w0[0] = last ? gn0[0] : gc0[0]; w0[1] = last ? gn0[1] : gc0[1]; w1[0] = last ? gn1[0] : gc1[0]; w1[1] = last ? gn1[1] : gc1[1]; }
            PG8_LDB(B0, 0, 0); PG8_LDB(B1, 0, 1); PG8_SCHED; PG8_LDA(At, 0, 0); PG8_STAGE_A(PG8_SA(1, 1), 1, cA, k1, gc0, gc1);
            PG8_WAIT_V(8); PG8_WAIT_L(0); PG8_BAR; PG8_MMA(0, 0, At, B0); PG8_MMA(0, 1, At, B1); PG8_BAR; PG8_SCHED;
            PG8_LDA(At, 0, 1); PG8_STAGE(PG8_SB(0, 0), b2, voffB); PG8_STAGE(PG8_SB(0, 1), b2 + hstep, voffB); PG8_STAGE_A(PG8_SA(0, 0), 0, tA, k2, w0, w1);
            PG8_WAIT_V(8); PG8_WAIT_L(0); PG8_BAR; PG8_MMA(1, 0, At, B0); PG8_MMA(1, 1, At, B1); PG8_BAR; PG8_SCHED;
            PG8_LDB(B0, 1, 0); PG8_LDB(B1, 1, 1); PG8_SCHED; PG8_LDA(At, 1, 0); PG8_STAGE_A(PG8_SA(0, 1), 1, tA, k2, w0, w1);
            PG8_WAIT_V(8); PG8_WAIT_L(0); PG8_BAR; PG8_MMA(0, 0, At, B0); PG8_MMA(0, 1, At, B1); PG8_BAR; PG8_SCHED;
            PG8_LDA(At, 1, 1); PG8_STAGE(PG8_SB(1, 0), b3, voffB); PG8_STAGE(PG8_SB(1, 1), b3 + hstep, voffB); PG8_STAGE_A(PG8_SA(1, 0), 0, tA, k3, w0, w1);
            PG8_WAIT_V(8); PG8_WAIT_L(0); PG8_BAR; PG8_MMA(1, 0, At, B0); PG8_MMA(1, 1, At, B1); PG8_BAR; PG8_SCHED;
        }
        if (wr == 0) PG8_BAR;
        { const int t2 = TIDX(); E(acc, cur, wr, wc, t2 & 15, (t2 >> 4) & 3); }
        if (!has_next) break;
#pragma unroll
        for (int a = 0; a < 2; ++a)
#pragma unroll
            for (int b = 0; b < 2; ++b)
#pragma unroll
                for (int m = 0; m < 4; ++m)
#pragma unroll
                    for (int n = 0; n < 2; ++n) acc[a][b][m][n] = (f32x4){zf, zf, zf, zf};
        cur = nxt; cA = nA; cB = nB; ++ui;
        if constexpr (GATHER) { gc0[0] = gn0[0]; gc0[1] = gn0[1]; gc1[0] = gn1[0]; gc1[1] = gn1[1]; }
        if (wr == 1) PG8_BAR;
    }
    PG8_WAIT_V(0);
    PG8_BAR;
#undef PG8_SA
#undef PG8_SB
#undef PG8_STAGE
#undef PG8_STAGE_A
#undef PG8_LDA
#undef PG8_LDB
#undef PG8_MMA
#undef PG8_WAIT_V
#undef PG8_WAIT_L
#undef PG8_BAR
#undef PG8_SCHED
}
}
template <class Epi, class Sched, bool GATHER>
__device__ __forceinline__ void gemm_phase(unsigned char* lds, int wv, const Gemm g, const Sched& S, const Epi& E) {
    pg8::gemm_phase<Epi, Sched, GATHER>((PG8_LAS unsigned char*)lds, wv, g, S, E);
}
#endif

struct EpiPlain {
    static constexpr bool PERM = true;
    act_t* O; int ldc;
    __device__ __forceinline__ void operator()(const f32x4 (&acc)[2][2][4][2], const Unit& u, int wr, int wc, int fr, int fq) const {
        const int row0 = u.pm * 256 + wr * 64 + fr, col0 = u.pn * 256 + wc * 32 + 8 * fq;
        for (int ai = 0; ai < 2; ++ai) for (int m = 0; m < 4; ++m) {
            act_t* rowp = O + (size_t)(row0 + ai * 128 + m * 16) * ldc + col0;
            for (int bj = 0; bj < 2; ++bj) {
                float v[8];
                for (int j = 0; j < 4; ++j) { v[j] = acc[ai][bj][m][0][j]; v[4 + j] = acc[ai][bj][m][1][j]; }
                store8(rowp + bj * 128, v);
            }
            EPI_FENCE();
        }
    }
};
struct EpiProj {
    static constexpr bool PERM = true;
    act_t* O; float* loga; const float* rot; const float* ba;
    __device__ __forceinline__ void operator()(const f32x4 (&acc)[2][2][4][2], const Unit& u, int wr, int wc, int fr, int fq) const {
        const int row0 = u.pm * 256 + wr * 64 + fr;
        if (u.pn == 11) {
            const int col0 = wc * 32 + 8 * fq;
            for (int ai = 0; ai < 2; ++ai) for (int m = 0; m < 4; ++m) {
                float* rowp = loga + (size_t)(row0 + ai * 128 + m * 16) * 256 + col0;
                for (int bj = 0; bj < 2; ++bj) for (int n = 0; n < 2; ++n) {
                    float o4[4];
                    for (int j = 0; j < 4; ++j) o4[j] = log_sigmoid_fast(acc[ai][bj][m][n][j] + ba[col0 + bj * 128 + 4 * n + j]) * (1.0f / 16.0f);
                    *(f32x4*)(rowp + bj * 128 + 4 * n) = (f32x4){o4[0], o4[1], o4[2], o4[3]};
                    EPI_FENCE();
                }
            }
        } else if (u.pn <= 1) {
            const bool lat = u.pm * 256 < NLAT;
            for (int ai = 0; ai < 2; ++ai) for (int m = 0; m < 4; ++m) {
                const int row = row0 + ai * 128 + m * 16;
                act_t* rowp = O + (size_t)row * PROJ_W + u.pn * 256 + wc * 64 + 8 * fq;
                float o1[8], o2[8];
                const float* rt = rot + ((size_t)(row % SEQ) * 32 + 8 * fq) * 2;
                for (int n = 0; n < 2; ++n) for (int j = 0; j < 4; ++j) {
                    float t1 = acc[ai][0][m][n][j], t2 = acc[ai][1][m][n][j];
                    float cs = 1.f, sn = 0.f;
                    if (lat) { cs = rt[(4 * n + j) * 2]; sn = rt[(4 * n + j) * 2 + 1]; }
                    o1[4 * n + j] = t1 * cs - t2 * sn;
                    o2[4 * n + j] = t1 * sn + t2 * cs;
                }
                store8(rowp, o1);
                store8(rowp + 32, o2);
                EPI_FENCE();
            }
        } else {
            const int col0 = u.pn * 256 + wc * 32 + 8 * fq;
            for (int ai = 0; ai < 2; ++ai) for (int m = 0; m < 4; ++m) {
                act_t* rowp = O + (size_t)(row0 + ai * 128 + m * 16) * PROJ_W + col0;
                for (int bj = 0; bj < 2; ++bj) {
                    float v[8];
                    for (int j = 0; j < 4; ++j) { v[j] = acc[ai][bj][m][0][j]; v[4 + j] = acc[ai][bj][m][1][j]; }
                    store8(rowp + bj * 128, v);
                }
                EPI_FENCE();
            }
        }
    }
};
struct EpiSwiglu {
    static constexpr bool PERM = true;
    act_t* H; int row_off;
    __device__ __forceinline__ void operator()(const f32x4 (&acc)[2][2][4][2], const Unit& u, int wr, int wc, int fr, int fq) const {
        const int row0 = u.pm * 256 + wr * 64 + fr - row_off, col0 = u.pn * 128 + wc * 32 + 8 * fq;
        for (int ai = 0; ai < 2; ++ai) for (int m = 0; m < 4; ++m) {
            float v[8];
            for (int n = 0; n < 2; ++n) for (int j = 0; j < 4; ++j) v[4 * n + j] = silu_f(acc[ai][0][m][n][j]) * acc[ai][1][m][n][j];
            store8(H + (size_t)(row0 + ai * 128 + m * 16) * DFF + col0, v);
            EPI_FENCE();
        }
    }
};
struct EpiMoeOut {
    static constexpr bool PERM = true;
    act_t* ys; const int* slot_asg; const float* tok_g;
    __device__ __forceinline__ void operator()(const f32x4 (&acc)[2][2][4][2], const Unit& u, int wr, int wc, int fr, int fq) const {
        const int row0 = u.pm * 256 + wr * 64 + fr, col0 = u.pn * 256 + wc * 32 + 8 * fq;
        for (int ai = 0; ai < 2; ++ai) for (int m = 0; m < 4; ++m) {
            const int as = slot_asg[row0 + ai * 128 + m * 16];
            if (as < 0) continue;
            const float gt = tok_g[as];
            act_t* rowp = ys + (size_t)as * DM + col0;
            for (int bj = 0; bj < 2; ++bj) {
                float v[8];
                for (int j = 0; j < 4; ++j) { v[j] = gt * acc[ai][bj][m][0][j]; v[4 + j] = gt * acc[ai][bj][m][1][j]; }
                store8(rowp + bj * 128, v);
            }
            EPI_FENCE();
        }
    }
};

struct EpiGlu {
    static constexpr bool PERM = true;
    act_t* mix; const act_t* g; const float* bias;
    __device__ __forceinline__ void operator()(const f32x4 (&acc)[2][2][4][2], const Unit& u, int wr, int wc, int fr, int fq) const {
        const int row0 = u.pm * 256 + wr * 64 + fr, col0 = wc * 32 + 8 * fq;
        _Pragma("unroll") for (int ai = 0; ai < 2; ++ai) _Pragma("unroll") for (int m = 0; m < 4; ++m) {
            const size_t row = (size_t)(row0 + ai * 128 + m * 16);
            _Pragma("unroll") for (int bj = 0; bj < 2; ++bj) {
                float gv[8], v[8];
                load8f(gv, g + row * 256 + col0 + bj * 128);
                _Pragma("unroll") for (int j = 0; j < 4; ++j) {
                    v[j] = gv[j] * sigmoid_f(acc[ai][bj][m][0][j] + bias[col0 + bj * 128 + j]);
                    v[4 + j] = gv[4 + j] * sigmoid_f(acc[ai][bj][m][1][j] + bias[col0 + bj * 128 + 4 + j]);
                }
                store8(mix + row * DM + 512 + col0 + bj * 128, v);
            }
            EPI_FENCE();
        }
    }
};
#ifdef EMU
#define WAVE_SYNC() __syncthreads()
#else
#define WAVE_SYNC() asm volatile("s_waitcnt lgkmcnt(0)" ::: "memory")
#endif
__device__ __forceinline__ void transpose_item(const float* W, int Nsrc, int K, int k0, int n0, act_t* WT, int drow0, float scale, float* scr, int lane) {
#if defined(EMU)
    for (int i = 0; i < 32; ++i) { const int kk = 2 * i + (lane >> 5); scr[kk * 33 + (lane & 31)] = W[(size_t)(k0 + kk) * Nsrc + n0 + (lane & 31)]; }
#else
    {
        f32x4 wv4[8];
#pragma unroll
        for (int i = 0; i < 8; ++i) wv4[i] = *(const f32x4*)(W + (size_t)(k0 + 8 * i + (lane >> 3)) * Nsrc + n0 + (lane & 7) * 4);
#pragma unroll
        for (int i = 0; i < 8; ++i) { float* d = scr + (8 * i + (lane >> 3)) * 33 + (lane & 7) * 4; d[0] = wv4[i][0]; d[1] = wv4[i][1]; d[2] = wv4[i][2]; d[3] = wv4[i][3]; }
    }
#endif
    WAVE_SYNC();
    const int c = lane & 7;
    for (int j = 0; j < 4; ++j) {
        const int n = (lane >> 3) + 8 * j; const float* s = scr + (8 * c) * 33 + n;
        float v[8];
        for (int q = 0; q < 8; ++q) v[q] = s[q * 33] * scale;
        store8(WT + (size_t)(drow0 + n) * K + k0 + 8 * c, v);
    }
    WAVE_SYNC();
}
__device__ __forceinline__ int win_dest(int n0, float& scale) {
    scale = 1.0f;
    if (n0 < 512) {
        const int base = n0 & ~255, s = n0 & 255, h = s >> 6, hi = (s >> 5) & 1;
        if (n0 >= 256) scale = 0.125f;
        return base + hi * 128 + h * 32;
    }
    if (n0 >= O_GQ && n0 < O_GK) scale = 0.17677669529663687f;
    if (n0 < 1792) return n0;
    if (n0 == 1792) return -1;
    return n0 - 32;
}
__device__ __forceinline__ void st_convert_items(const Params& p, int wv, unsigned char* lds, int which  ) {
    const int tid = TIDX(), wave = tid >> 6, lane = tid & 63;
    float* scr = (float*)lds + wave * (64 * 33 + 16);
    const int gw = BIDX() * NW + wave, NGW = NBLK() * NW;
    const int I_IN = (DM / 64) * (DPROJ_IN / 32), I_OUT = (DM / 64) * (DM / 32), I_F1 = (DM / 64) * (DFF / 32), I_F2 = (DFF / 64) * (DM / 32);
    const int I_GL = (256 / 64) * (256 / 32);
    const int total = which == 0 ? (DEPTH * (I_IN + I_OUT) + 2 * I_F1 + I_F2 + DEPTH * I_GL) : NEXP * (2 * I_F1 + I_F2);
    const int trips = (total + NGW - 1) / NGW;
    for (int tr = 0; tr < trips; ++tr) {
        int it = tr * NGW + gw;
        const bool valid = it < total;
        if (!valid) it = 0;
        const float* W; int Nsrc, K, k0, n0, drow0; act_t* WT; float scale = 1.0f;
        if (which == 0) {
            if (it < DEPTH * I_IN) {
                const int l = it / I_IN, r = it % I_IN; const int nblk = DPROJ_IN / 32;
                W = p.in[I_W_IN] + (size_t)l * DM * DPROJ_IN; Nsrc = DPROJ_IN; K = DM; k0 = 64 * (r / nblk); n0 = 32 * (r % nblk);
                WT = p.win_t + (size_t)l * NPROJ_T * DM; drow0 = win_dest(n0, scale);
            } else if (it < DEPTH * (I_IN + I_OUT)) {
                const int q = it - DEPTH * I_IN; const int l = q / I_OUT, r = q % I_OUT; const int nblk = DM / 32;
                W = p.in[I_W_OUT] + (size_t)l * DM * DM; Nsrc = DM; K = DM; k0 = 64 * (r / nblk); n0 = 32 * (r % nblk);
                WT = p.wout_t + (size_t)l * DM * DM; drow0 = n0;
            } else {
                int q = it - DEPTH * (I_IN + I_OUT);
                if (q < 2 * I_F1) {
                    const int w3 = q / I_F1, r = q % I_F1; const int nblk = DFF / 32;
                    W = p.in[w3 ? I_FFN_W3 : I_FFN_W1]; Nsrc = DFF; K = DM; k0 = 64 * (r / nblk); n0 = 32 * (r % nblk);
                    WT = p.w13_t; drow0 = (n0 / 128) * 256 + w3 * 128 + (n0 % 128);
                } else if (q < 2 * I_F1 + I_F2) {
                    const int r = q - 2 * I_F1; const int nblk = DM / 32;
                    W = p.in[I_FFN_W2]; Nsrc = DM; K = DFF; k0 = 64 * (r / nblk); n0 = 32 * (r % nblk);
                    WT = p.w2_t; drow0 = n0;
                } else {
                    const int r2 = q - 2 * I_F1 - I_F2; const int ll = r2 / I_GL, r = r2 % I_GL; const int nblk = 256 / 32;
                    W = p.in[I_S5_GLU_W] + (size_t)ll * 256 * 256; Nsrc = 256; K = 256; k0 = 64 * (r / nblk); n0 = 32 * (r % nblk);
                    WT = p.wglu_t + (size_t)ll * 256 * 256; drow0 = n0;
                }
            }
        } else {
            const int per = 2 * I_F1 + I_F2; const int e = it / per; int q = it % per;
            if (q < 2 * I_F1) {
                const int w3 = q / I_F1, r = q % I_F1; const int nblk = DFF / 32;
                W = p.in[w3 ? I_MOE_W3 : I_MOE_W1] + (size_t)e * DM * DFF; Nsrc = DFF; K = DM; k0 = 64 * (r / nblk); n0 = 32 * (r % nblk);
                WT = p.wmoe13 + (size_t)e * 2 * DFF * DM; drow0 = (n0 / 128) * 256 + w3 * 128 + (n0 % 128);
            } else {
                const int r = q - 2 * I_F1; const int nblk = DM / 32;
                W = p.in[I_MOE_W2] + (size_t)e * DFF * DM; Nsrc = DM; K = DFF; k0 = 64 * (r / nblk); n0 = 32 * (r % nblk);
                WT = p.wmoe2 + (size_t)e * DM * DFF; drow0 = n0;
            }
        }
        if (!valid || drow0 < 0) { WAVE_SYNC(); WAVE_SYNC(); continue; }
        transpose_item(W, Nsrc, K, k0, n0, WT, drow0, scale, scr, lane);
    }
}

__device__ __forceinline__ void st_prep(const Params& p, int wv, unsigned char* lds) {
    const int tid = TIDX(), nb = NBLK(), bid = BIDX();
    {
        float* sc = (float*)lds;
        const int ncols = DEPTH * 6 * DM;
        if (bid * NT < ncols) {
            for (int e = tid; e < (BATCH + 1) * DM; e += NT) { const int bb = e / DM, k = e % DM; sc[e] = silu_f(bb < BATCH ? p.in[I_C][bb * DM + k] : p.in[I_CCTX][k]); }
        }
        __syncthreads();
        for (int it = bid * NT + tid; it < ncols; it += nb * NT) {
            const int col = it % (6 * DM), l = it / (6 * DM);
            const float* w = p.in[I_ADA_W] + (long)l * DM * 6 * DM + col;
            float acc[BATCH + 1];
            _Pragma("unroll") for (int bb = 0; bb <= BATCH; ++bb) acc[bb] = p.in[I_ADA_B][l * 6 * DM + col];
#pragma unroll 4
            for (int k = 0; k < DM; ++k) { const float wv2 = w[(long)k * 6 * DM]; _Pragma("unroll") for (int bb = 0; bb <= BATCH; ++bb) acc[bb] += sc[bb * DM + k] * wv2; }
            _Pragma("unroll") for (int bb = 0; bb <= BATCH; ++bb) p.mod[((long)l * (BATCH + 1) + bb) * 6 * DM + col] = acc[bb];
        }
        __syncthreads();
    }
    for (int it = bid * NT + tid; it < SEQ * 32; it += nb * NT) {
        int t = it / 32, f = it % 32;
        float pos = f < 16 ? (float)(t / GRID_W) : (float)(t % GRID_W);
        float inv = exp2f(-(float)(f & 15) * (13.287712379549449f / 16.0f));
        float ang = pos * inv;
        p.rot[it * 2] = cosf(ang);
        p.rot[it * 2 + 1] = sinf(ang);
    }
    for (int it = bid * NT + tid; it < FN - 1; it += nb * NT) {
        int gb = 0; while ((2 << gb) - 1 <= it) ++gb;
        const int k = it - ((1 << gb) - 1);
        double ang = -2.0 * M_PI * (double)k / (double)(2 << gb);
        p.fft_tw[it * 2] = (float)cos(ang); p.fft_tw[it * 2 + 1] = (float)sin(ang);
    }
    for (long it = (long)bid * NT + tid; it < (long)DEPTH * 256 * DM; it += (long)nb * NT) {
        int k = it % DM; int c = (it / DM) % 256; int l = it / (DM * 256);
        int dir = c >> 7, j = c & 127;
        const float* wi = p.in[I_W_IN] + ((size_t)l * DM + k) * DPROJ_IN + 1792 + 16 * dir;
        const float* wa = p.in[I_GLA_WA] + ((size_t)(l * 2 + dir) * 16) * 128 + j;
        float s = 0.f;
        for (int i = 0; i < 16; ++i) s += wi[i] * wa[i * 128];
        p.win_t[((size_t)l * NPROJ_T + 2816 + c) * DM + k] = f2a(s);
    }
    {
        const int wave = tid >> 6, lane = tid & 63;
        float* h1 = (float*)lds + wave * 128;
        float* h2 = h1 + 64;
        const int per_layer = SEQ + CTXL;
        for (int base = bid * NW; base < DEPTH * per_layer; base += nb * NW) {
            int it = base + wave;
            int l = it / per_layer;
            int r = it % per_layer;
            int which = r < SEQ ? 0 : 1;
            int n = which ? CTXL : SEQ;
            int t = which ? r - SEQ : r;
            float* circ = p.filt + (long)l * FILT_LAYER_FLOATS;
            const float tn = (float)((double)t / (double)(n - 1));
            const float* fw1 = p.in[I_HY_FW1] + l * 33 * 64;
            const float* fw2 = p.in[I_HY_FW2] + l * 64 * 64;
            const float* fw3 = p.in[I_HY_FW3] + l * 64 * 512;
            const float fr = p.in[I_HY_FREQ][l * 64 + lane];
            float a = p.in[I_HY_FB1][l * 64 + lane] + tn * fw1[lane];
#pragma unroll 2
            for (int k = 0; k < 16; ++k) {
                double band = 1e-4 + (double)k * ((15.0 - 1e-4) / 15.0);
                double turns = band * (double)t / (double)n;
                float ang = (float)((turns - floor(turns)) * (2.0 * M_PI));
                a += cosf(ang) * fw1[(1 + k) * 64 + lane];
                a += -sinf(ang) * fw1[(17 + k) * 64 + lane];
            }
            h1[lane] = sinf(fr * a);
            __syncthreads();
            float a2 = p.in[I_HY_FB2][l * 64 + lane];
#pragma unroll 8
            for (int i = 0; i < 64; ++i) a2 += h1[i] * fw2[i * 64 + lane];
            h2[lane] = sinf(fr * a2);
            if (!which) p.hdn2[((size_t)l * SEQ + t) * 64 + lane] = h2[lane];
            __syncthreads();
#pragma unroll 1
            for (int cc = 0; cc < (which ? 8 : 0); ++cc) {
                int c = cc * 64 + lane;
                float f = 0.0f;
#pragma unroll 8
                for (int i = 0; i < 64; ++i) f += h2[i] * fw3[i * 512 + c];
                int w = c >> 8, ch = c & 255;
                float dec = fabsf(p.in[I_HY_DECAY][(l * 2 + w) * 256 + ch]);
                f *= expf(-tn * dec);
                if (w == 0) circ[(long)t * 256 + ch] = f;
                else if (t >= 1) circ[(long)(2 * n - t) * 256 + ch] = f;
                if (t == 0 && w == 1) circ[(long)n * 256 + ch] = 0.0f;
            }
            __syncthreads();
        }
    }
    for (int it = bid * NT + tid; it < DEPTH * 2 * 16 * 64; it += nb * NT) {
        const int n = it & 63, pg = it >> 6;
        double lre = p.in[I_S5_LAM_RE][it], lim = p.in[I_S5_LAM_IM][it];
        double dt = exp((double)p.in[I_S5_LOG_DT][pg]);
        double mag = exp(lre * dt);
        double lbr = mag * cos(lim * dt), lbi = mag * sin(lim * dt);
        double den = lre * lre + lim * lim;
        double cr = ((lbr - 1.0) * lre + lbi * lim) / den;
        double ci = (lbi * lre - (lbr - 1.0) * lim) / den;
        float* tb = p.s5tab + (size_t)it * 34;
        tb[0] = (float)lbr; tb[1] = (float)lbi;
#pragma unroll 1
        for (int q = 0; q < 16; ++q) {
            double br = p.in[I_S5_B_RE][((long)pg * 64 + n) * 16 + q], bi = p.in[I_S5_B_IM][((long)pg * 64 + n) * 16 + q];
            tb[2 + q] = (float)(cr * br - ci * bi);
            tb[18 + q] = (float)(cr * bi + ci * br);
        }
    }
    for (int it = bid * NT + tid; it < DEPTH * 2 * 16 * 65 * 64; it += nb * NT) {
        const int n = it & 63, tau = (it >> 6) % 65, pg = it / (65 * 64);
        const double lre = p.in[I_S5_LAM_RE][pg * 64 + n], lim = p.in[I_S5_LAM_IM][pg * 64 + n];
        const double dt = exp((double)p.in[I_S5_LOG_DT][pg]);
        const double mag = exp(lre * dt * (double)tau), ph = lim * dt * (double)tau;
        p.s5pw[(size_t)it * 2] = (float)(mag * cos(ph)); p.s5pw[(size_t)it * 2 + 1] = (float)(mag * sin(ph));
    }
    st_convert_items(p, wv, lds, 0);
}

__device__ __forceinline__ void st_prep2(const Params& p, int wv) {
    const int tid = TIDX(), wave = tid >> 6, lane = tid & 63;
    for (int base = BIDX() * NW; base < DEPTH * 256; base += NBLK() * NW) {
        int it = base + wave;
        int ch = it & 255, l = it >> 8;
        int n = CTXL;
        const float* circ = p.filt + (long)l * FILT_LAYER_FLOATS;
        double s = 0.0;
        for (int i = lane; i < 2 * n; i += 64) s += fabs((double)circ[(long)i * 256 + ch]);
        float hi = (float)s, lo = (float)(s - (double)hi);
        hi = wave_sum(hi); lo = wave_sum(lo);
        if (lane == 0) p.fnorm[it] = (float)(1.0 / ((double)hi + (double)lo));
    }
}

__device__ __forceinline__ void ld8(float* v, const float* src) {
#if defined(EMU)
    for (int i = 0; i < 8; ++i) v[i] = src[i];
#else
    const f32x4 a = *(const f32x4*)src, b = *(const f32x4*)(src + 4);
    v[0] = a[0]; v[1] = a[1]; v[2] = a[2]; v[3] = a[3]; v[4] = b[0]; v[5] = b[1]; v[6] = b[2]; v[7] = b[3];
#endif
}
__device__ __forceinline__ void st8f(float* dst, const float* v) {
#if defined(EMU)
    for (int i = 0; i < 8; ++i) dst[i] = v[i];
#else
    *(f32x4*)dst = (f32x4){v[0], v[1], v[2], v[3]}; *(f32x4*)(dst + 4) = (f32x4){v[4], v[5], v[6], v[7]};
#endif
}
__device__ __forceinline__ void st_ln(const Params& p, int wv, unsigned char* lds, int l, int mode) {
    const int tid = TIDX(), wave = tid >> 6, lane = tid & 63;
    const bool last = (l == DEPTH - 1);
    const int nrows = (mode == 0) ? NTOK : (last ? NLAT : NTOK);
    const bool moe = (l & 1);
    const bool route = (mode == 1) && moe;
    int* lc = (int*)lds;
    if (route) {
        if (tid < NW * NEXP) lc[tid] = 0;
        __syncthreads();
        for (int i = BIDX() * NT + tid; i < MOE_CAP; i += NBLK() * NT) p.slot_asg[i] = -1;
    }
    const float* rw = p.in[I_ROUTER_W] + (long)(l / 2) * DM * NEXP;
    const float* rb = p.in[I_ROUTER_B] + (l / 2) * NEXP;
    auto fetch = [&](int row, float* xs, float* ys) {
        const bool lat = row < NLAT;
        const float* src;
        if (mode == 0) src = lat ? p.in[I_X] + (long)row * DM : p.in[I_CTX] + (long)(row - NLAT) * DM;
        else if (mode == 1) src = lat ? ((l == 0 ? p.in[I_X] : p.out) + (long)row * DM) : ((l == 0 ? p.in[I_CTX] : p.hctx) + (long)(row - NLAT) * DM);
        else src = lat ? p.out + (long)row * DM : p.hctx + (long)(row - NLAT) * DM;
        for (int g = 0; g < 2; ++g) {
            const int c0 = g * 512 + lane * 8;
            ld8(xs + 8 * g, src + c0);
            if (mode == 1 || (mode == 2 && !moe)) load8f(ys + 8 * g, p.u + (long)row * DM + c0);
            if (mode == 2 && moe) { float o2[8]; load8f(ys + 8 * g, p.ys + (long)(row * 2) * DM + c0); load8f(o2, p.ys + (long)(row * 2 + 1) * DM + c0); for (int j = 0; j < 8; ++j) ys[8 * g + j] += o2[j]; }
        }
    };
    const int step = NBLK() * NW;
    float xa[16], ya[16], xb[16], yb[16];
    int row = BIDX() * NW + wave;
    if (row < nrows) fetch(row, xa, ya);
    for (; row < nrows; row += step) {
        if (row + step < nrows) fetch(row + step, xb, yb);
        const bool lat = row < NLAT;
        const float* modp = p.mod + ((long)l * (BATCH + 1) + row_modidx(row)) * 6 * DM;
        act_t* urow = p.u + (long)row * DM;
        float v[16], m1[8], m2[8], o[8], t8[8];
        float mu, rstd;
        if (mode == 0) {
            for (int i = 0; i < 16; ++i) v[i] = xa[i];
            ln_stats16(v, mu, rstd);
            for (int g = 0; g < 2; ++g) {
                const int c0 = g * 512 + lane * 8;
                ld8(m1, modp + DM + c0); ld8(m2, modp + c0);
                for (int j = 0; j < 8; ++j) o[j] = (v[8 * g + j] - mu) * rstd * (1.0f + m1[j]) + m2[j];
                store8(urow + c0, o);
            }
        } else if (mode == 1) {
            float* dst = lat ? p.out + (long)row * DM : p.hctx + (long)(row - NLAT) * DM;
            for (int g = 0; g < 2; ++g) {
                const int c0 = g * 512 + lane * 8;
                ld8(m1, modp + 2 * DM + c0);
                for (int j = 0; j < 8; ++j) v[8 * g + j] = ALPHA * xa[8 * g + j] + m1[j] * ya[8 * g + j];
            }
            ln_stats16(v, mu, rstd);
            for (int g = 0; g < 2; ++g) {
                const int c0 = g * 512 + lane * 8;
                ld8(m1, p.in[I_LN_MIX_G] + l * DM + c0); ld8(m2, p.in[I_LN_MIX_B] + l * DM + c0);
                for (int j = 0; j < 8; ++j) v[8 * g + j] = (v[8 * g + j] - mu) * rstd * m1[j] + m2[j];
                st8f(dst + c0, v + 8 * g);
            }
            ln_stats16(v, mu, rstd);
            float lg[NEXP];
            for (int e = 0; e < NEXP; ++e) lg[e] = 0.f;
            for (int g = 0; g < 2; ++g) {
                const int c0 = g * 512 + lane * 8;
                ld8(m1, modp + 4 * DM + c0); ld8(m2, modp + 3 * DM + c0);
                for (int j = 0; j < 8; ++j) o[j] = (v[8 * g + j] - mu) * rstd * (1.0f + m1[j]) + m2[j];
                store8(urow + c0, o);
                if (route) for (int j = 0; j < 8; ++j) { ld8(t8, rw + (long)(c0 + j) * NEXP); for (int e = 0; e < NEXP; ++e) lg[e] += o[j] * t8[e]; }
            }
            if (route) {
                for (int e = 0; e < NEXP; ++e) lg[e] = wave_sum(lg[e]) + rb[e];
                if (lane == 0) {
                    int e1 = 0;
                    for (int e = 1; e < NEXP; ++e) if (lg[e] > lg[e1]) e1 = e;
                    int e2 = (e1 == 0) ? 1 : 0;
                    for (int e = 0; e < NEXP; ++e) if (e != e1 && lg[e] > lg[e2]) e2 = e;
                    float ex = expf(lg[e2] - lg[e1]);
                    float g1 = 1.0f / (1.0f + ex);
                    p.tok_e[row * 2] = e1; p.tok_e[row * 2 + 1] = e2;
                    p.tok_g[row * 2] = g1; p.tok_g[row * 2 + 1] = ex * g1;
                    lc[wave * NEXP + e1] += 1;
                    lc[wave * NEXP + e2] += 1;
                }
            }
        } else {
            float* dst = lat ? p.out + (long)row * DM : p.hctx + (long)(row - NLAT) * DM;
            for (int g = 0; g < 2; ++g) {
                const int c0 = g * 512 + lane * 8;
                ld8(m1, modp + 5 * DM + c0);
                for (int j = 0; j < 8; ++j) v[8 * g + j] = ALPHA * xa[8 * g + j] + m1[j] * ya[8 * g + j];
            }
            ln_stats16(v, mu, rstd);
            for (int g = 0; g < 2; ++g) {
                const int c0 = g * 512 + lane * 8;
                ld8(m1, p.in[I_LN_FFN_G] + l * DM + c0); ld8(m2, p.in[I_LN_FFN_B] + l * DM + c0);
                for (int j = 0; j < 8; ++j) v[8 * g + j] = (v[8 * g + j] - mu) * rstd * m1[j] + m2[j];
                st8f(dst + c0, v + 8 * g);
            }
            if (l + 1 < DEPTH) {
                const float* modn = p.mod + ((long)(l + 1) * (BATCH + 1) + row_modidx(row)) * 6 * DM;
                ln_stats16(v, mu, rstd);
                for (int g = 0; g < 2; ++g) {
                    const int c0 = g * 512 + lane * 8;
                    ld8(m1, modn + DM + c0); ld8(m2, modn + c0);
                    for (int j = 0; j < 8; ++j) o[j] = (v[8 * g + j] - mu) * rstd * (1.0f + m1[j]) + m2[j];
                    store8(urow + c0, o);
                }
            }
        }
        for (int i = 0; i < 16; ++i) { xa[i] = xb[i]; ya[i] = yb[i]; }
    }
    if (route) {
        int* cnt = (int*)(p.ctl + CTL_MOE);
        __syncthreads();
        if (tid < NEXP) {
            int tot = 0;
            for (int w = 0; w < NW; ++w) tot += lc[w * NEXP + tid];
            if (tot) atomicAdd(&cnt[tid], tot);
        }
        __syncthreads();
    }
}

__device__ __forceinline__ void st_router(const Params& p, int wv, unsigned char* lds, int l) {
    const int tid = TIDX(), wave = tid >> 6, lane = tid & 63;
    const int j = l / 2;
    const float* rw = p.in[I_ROUTER_W] + (long)j * DM * NEXP;
    const float* rb = p.in[I_ROUTER_B] + j * NEXP;
    int* cnt = (int*)(p.ctl + CTL_MOE);
    int* lc = (int*)lds;
    if (tid < NW * NEXP) lc[tid] = 0;
    __syncthreads();
    for (int i = BIDX() * NT + tid; i < MOE_CAP; i += NBLK() * NT) p.slot_asg[i] = -1;
    for (int base = BIDX() * NW; base < NLAT; base += NBLK() * NW) {
        const int row = base + wave;
        const float* modp = p.mod + ((long)l * (BATCH + 1) + row_modidx(row)) * 6 * DM;
        float v[16], mu, rstd;
        for (int i = 0; i < 16; ++i) v[i] = p.out[(long)row * DM + i * 64 + lane];
        ln_stats16(v, mu, rstd);
        float lg[NEXP];
        for (int e = 0; e < NEXP; ++e) lg[e] = 0.f;
        for (int i = 0; i < 16; ++i) {
            int c = i * 64 + lane;
            float vv = (v[i] - mu) * rstd * (1.0f + modp[4 * DM + c]) + modp[3 * DM + c];
            for (int e = 0; e < NEXP; ++e) lg[e] += vv * rw[c * NEXP + e];
        }
        for (int e = 0; e < NEXP; ++e) lg[e] = wave_sum(lg[e]) + rb[e];
        if (lane == 0) {
            int e1 = 0;
            for (int e = 1; e < NEXP; ++e) if (lg[e] > lg[e1]) e1 = e;
            int e2 = (e1 == 0) ? 1 : 0;
            for (int e = 0; e < NEXP; ++e) if (e != e1 && lg[e] > lg[e2]) e2 = e;
            float ex = expf(lg[e2] - lg[e1]);
            float g1 = 1.0f / (1.0f + ex);
            p.tok_e[row * 2] = e1; p.tok_e[row * 2 + 1] = e2;
            p.tok_g[row * 2] = g1; p.tok_g[row * 2 + 1] = ex * g1;
            lc[wave * NEXP + e1] += 1;
            lc[wave * NEXP + e2] += 1;
        }
    }
    __syncthreads();
    if (tid < NEXP) {
        int tot = 0;
        for (int w = 0; w < NW; ++w) tot += lc[w * NEXP + tid];
        if (tot) atomicAdd(&cnt[tid], tot);
    }
    __syncthreads();
}
__device__ __forceinline__ void moe_offsets(const Params& p, int* pstart, int* pend) {
    const int* cnt = (const int*)(p.ctl + CTL_MOE);
    int acc = 0;
    for (int e = 0; e < NEXP; ++e) {
        int c = cnt[e];
        pstart[e] = acc;
        acc += (c + 255) / 256 * 256;
        pend[e] = acc;
    }
}
__device__ __forceinline__ void st_place(const Params& p, int wv, unsigned char* lds) {
    const int tid = TIDX();
    int pstart[NEXP], pend[NEXP];
    moe_offsets(p, pstart, pend);
    int* fill = (int*)(p.ctl + CTL_MOE) + 8;
    int* lcnt = (int*)lds;
    int* lpos = lcnt + 16;
    const int per = (2 * NLAT + NBLK() - 1) / NBLK();
    const int a0 = BIDX() * per, a1 = (a0 + per < 2 * NLAT) ? a0 + per : 2 * NLAT;
    if (tid < 32) lcnt[tid] = 0;
    __syncthreads();
    for (int a = a0 + tid; a < a1; a += NT) atomicAdd(&lcnt[p.tok_e[a]], 1);
    __syncthreads();
    if (tid < NEXP) { const int c = lcnt[tid]; lcnt[tid] = c ? atomicAdd(&fill[tid], c) : 0; }
    __syncthreads();
    for (int a = a0 + tid; a < a1; a += NT) {
        const int e = p.tok_e[a];
        const int pos = lcnt[e] + atomicAdd(&lpos[e], 1);
        int ps = 0;
        for (int q = 0; q < NEXP; ++q) ps = (q == e) ? pstart[q] : ps;
        p.slot_asg[ps + pos] = a;
    }
    __syncthreads();
}

enum { G_PROJ, G_OUT, G_FFN1, G_FFN2, G_MFFN1, G_MFFN2, G_GLU };
#ifndef REFMASK
#define REFMASK 0
#endif
#if defined(EMU)
#define GEMM_CALL(mode, EPI, SCH, GA) gemm_phase<EPI, SCH, GA>(lds, wv, g, S, E)
#else
#define GEMM_CALL(mode, EPI, SCH, GA) do { if ((REFMASK >> (mode)) & 1) gemm_phase_ref<EPI, SCH, GA>(wv, g, S, E); else gemm_phase<EPI, SCH, GA>(lds, wv, g, S, E); } while (0)
#endif
template <int MODE>
__device__ __forceinline__ void st_gemm(const Params& p, int wv, unsigned char* lds, int l, int pass) {
    const bool last = (l == DEPTH - 1);
    const int G = NBLK(), c = BIDX();
    if (MODE == G_PROJ) {
        Gemm g{p.u, p.win_t + (size_t)l * NPROJ_T * DM, NTOK, NPROJ_T, DM, nullptr};
        StaticOrder S; S.init(NTOK, NPROJ_T, G, c);
        EpiProj E{p.proj, p.loga, p.rot, p.in[I_GLA_BA] + l * 256};
        GEMM_CALL(G_PROJ, EpiProj, StaticOrder, false);
    } else if (MODE == G_OUT) {
        const int M = last ? NLAT : NTOK;
        Gemm g{p.mix, p.wout_t + (size_t)l * DM * DM, M, DM, DM, nullptr};
        StaticOrder S; S.init(M, DM, G, c);
        EpiPlain E{p.u, DM};
        GEMM_CALL(G_OUT, EpiPlain, StaticOrder, false);
    } else if (MODE == G_GLU && false) {
        const int M = last ? NLAT : NTOK;
        Gemm g{p.gbuf, p.wglu_t + (size_t)l * 256 * 256, M, 256, 256, nullptr};
        StaticOrder S; S.init(M, 256, G, c);
        EpiGlu E{p.mix, p.gbuf, p.in[I_S5_GLU_B] + l * 256};
        GEMM_CALL(G_GLU, EpiGlu, StaticOrder, false);
    } else if (MODE == G_FFN1) {
        Gemm g{p.u, p.w13_t, NTOK, 2 * DFF, DM, nullptr};
        StaticOrder S; S.init(NTOK, 2 * DFF, G, c);
        EpiSwiglu E{p.proj, 0};
        GEMM_CALL(G_FFN1, EpiSwiglu, StaticOrder, false);
    } else if (MODE == G_FFN2) {
        Gemm g{p.proj, p.w2_t, NTOK, DM, DFF, nullptr};
        StaticOrder S; S.init(NTOK, DM, G, c);
        EpiPlain E{p.u, DM};
        GEMM_CALL(G_FFN2, EpiPlain, StaticOrder, false);
    } else {
        int pstart[NEXP], pend[NEXP];
        moe_offsets(p, pstart, pend);
        const int used = pend[NEXP - 1] / 256;
        const int t0 = pass * MOE_PT;
        int nt = used - t0; if (nt > MOE_PT) nt = MOE_PT;
        if (nt <= 0) return;
        MoeOrder S; S.t0 = t0;
        for (int e = 0; e < NEXP; ++e) S.pend[e] = pend[e];
        if (MODE == G_MFFN1) {
            S.so.init(nt * 256, 2 * DFF, G, c); S.estride = (size_t)2 * DFF * DM;
            Gemm g{p.u, p.wmoe13, nt * 256, 2 * DFF, DM, p.slot_asg};
            EpiSwiglu E{p.hch, t0 * 256};
            GEMM_CALL(G_MFFN1, EpiSwiglu, MoeOrder, true);
        } else {
            S.so.init(nt * 256, DM, G, c); S.estride = (size_t)DM * DFF;
            Gemm g{p.hch - (size_t)t0 * 256 * DFF, p.wmoe2, nt * 256, DM, DFF, nullptr};
            EpiMoeOut E{p.ys, p.slot_asg, p.tok_g};
            GEMM_CALL(G_MFFN2, EpiMoeOut, MoeOrder, false);
        }
    }
}

__device__ __forceinline__ void st_glu(const Params& p, int wv, unsigned char* lds, int l) {
    const int M = (l == DEPTH - 1) ? NLAT : NTOK;
    float(*As)[132] = (float(*)[132])lds;
    float(*Bs)[68] = (float(*)[68])(lds + 16 * 132 * 4);
    const float* W = p.in[I_S5_GLU_W] + (long)l * 256 * 256;
    const float* g = p.osum;
    const int tid = TIDX(), ty = tid >> 4, tx = tid & 15;
    const int ar = tid >> 2, ak = (tid & 3) * 4;
    const int bk = (tid >> 4) & 15, bc = (tid & 15) * 4;
    const int ntm = M / 128, ntn = 4;
    for (int tile = BIDX(); tile < ntm * ntn; tile += NBLK()) {
        const int m0 = (tile / ntn) * 128, n0 = (tile % ntn) * 64;
        float acc[4][4];
        for (int i = 0; i < 4; ++i) for (int j = 0; j < 4; ++j) acc[i][j] = 0.f;
        for (int k0 = 0; k0 < 256; k0 += 16) {
            for (int q = 0; q < 4; ++q) As[ak + q][ar] = g[(long)(m0 + ar) * 256 + k0 + ak + q];
            if (tid < 256) for (int q = 0; q < 4; ++q) Bs[bk][bc + q] = W[(k0 + bk) * 256 + n0 + bc + q];
            __syncthreads();
            for (int k = 0; k < 16; ++k) {
                float a[4], b[4];
                for (int i = 0; i < 4; ++i) a[i] = As[k][ty * 4 + i];
                for (int j = 0; j < 4; ++j) b[j] = Bs[k][tx * 4 + j];
                for (int i = 0; i < 4; ++i) for (int j = 0; j < 4; ++j) acc[i][j] += a[i] * b[j];
            }
            __syncthreads();
        }
        for (int i = 0; i < 4; ++i) for (int j = 0; j < 4; ++j) {
            int r = m0 + ty * 4 + i, c = n0 + tx * 4 + j;
            float gv = g[(long)r * 256 + c];
            p.mix[(long)r * DM + 512 + c] = f2a(gv * sigmoid_f(acc[i][j] + p.in[I_S5_GLU_B][l * 256 + c]));
        }
    }
}

#define GLP 264
__device__ __forceinline__ f32x4 mm16(f32x4 acc, const act_t* A, int pa, const act_t* Bt, int pb, int K, int lane);
__device__ __forceinline__ void st_glu2(const Params& p, int wv, unsigned char* lds, int l, int bid, int nb) {
    const int tid = TIDX(), wave = tid >> 6, lane = tid & 63;
    const int M = (l == DEPTH - 1) ? NLAT : NTOK;
    act_t* gt = (act_t*)lds; act_t* ot = gt + 64 * GLP;
    const act_t* Wt = p.wglu_t + (size_t)l * 256 * 256;
    for (int u = bid; u < M / 64; u += nb) {
        const int row0 = u * 64;
        for (int e = tid; e < 64 * 32; e += NT) { const int r = e >> 5, c8 = (e & 31) * 8; copy8(gt + r * GLP + c8, p.gbuf + (size_t)(row0 + r) * 256 + c8); }
        __syncthreads();
        for (int q = 0; q < 2; ++q) {
            const int n = 2 * wave + q, c = 16 * n + (lane & 15);
            const float bq = p.in[I_S5_GLU_B][l * 256 + c];
            for (int rb = 0; rb < 4; ++rb) {
                f32x4 acc = (f32x4){0.f, 0.f, 0.f, 0.f};
                acc = mm16(acc, gt + 16 * rb * GLP, GLP, Wt + (size_t)16 * n * 256, 256, 256, lane);
                for (int r = 0; r < 4; ++r) {
                    const int t = 16 * rb + 4 * (lane >> 4) + r;
                    ot[t * GLP + c] = f2a(a2f(gt[t * GLP + c]) * sigmoid_f(acc[r] + bq));
                }
            }
        }
        __syncthreads();
        for (int e = tid; e < 64 * 32; e += NT) { const int r = e >> 5, c8 = (e & 31) * 8; copy8(p.mix + (size_t)(row0 + r) * DM + 512 + c8, ot + r * GLP + c8); }
        __syncthreads();
    }
}
__device__ __forceinline__ float hy_short(const Params& p, int l, int row, int c) {
    const bool lat = row < NLAT;
    const int n = lat ? SEQ : CTXL;
    const int t = lat ? row % SEQ : (row - NLAT) % CTXL;
    const float* cw = p.in[I_HY_CONV_W] + (long)l * 3 * 768;
    float s = p.in[I_HY_CONV_B][l * 768 + c];
    for (int jj = 0; jj < 3; ++jj) {
        int tt = t + jj - 1;
        if (tt >= 0 && tt < n) s += a2f(p.proj[(long)(row + jj - 1) * PROJ_W + O_HP + c]) * cw[jj * 768 + c];
    }
    return s;
}
__device__ __forceinline__ void st_hy_ctx_pre(const Params& p, int wv, int l, int bid, int nb) {
    const int tid = TIDX();
    for (long it = (long)bid * NT + tid; it < (long)NCTX * 256; it += (long)nb * NT) {
        int row = NLAT + (int)(it >> 8), ch = it & 255;
        p.hz[(long)row * 256 + ch] = f2a(hy_short(p, l, row, 256 + ch) * hy_short(p, l, row, 512 + ch));
    }
}
__device__ __forceinline__ void st_hy_ctx_conv(const Params& p, int wv, int l, int bid, int nb) {
    const int tid = TIDX();
    for (long it = (long)bid * NT + tid; it < (long)NCTX * 256; it += (long)nb * NT) {
        int row = NLAT + (int)(it >> 8), ch = it & 255;
        const int n = CTXL;
        const int t = (row - NLAT) % CTXL;
        const int rbase = row - t;
        const float* circ = p.filt + (long)l * FILT_LAYER_FLOATS;
        float acc4[4] = {0.f, 0.f, 0.f, 0.f};
#pragma unroll 4
        for (int s2 = 0; s2 < n; s2 += 4) {
#pragma unroll
            for (int q = 0; q < 4; ++q) {
                int idx = t - (s2 + q); if (idx < 0) idx += 2 * n;
                acc4[q] += circ[(long)idx * 256 + ch] * a2f(p.hz[(long)(rbase + s2 + q) * 256 + ch]);
            }
        }
        float yv = ((acc4[0] + acc4[1]) + (acc4[2] + acc4[3])) * p.fnorm[l * 256 + ch];
        float z = a2f(p.hz[(long)row * 256 + ch]);
        float x0 = hy_short(p, l, row, ch);
        p.mix[(long)row * DM + 768 + ch] = f2a(x0 * (yv + z * p.in[I_HY_BIAS][l * 256 + ch]));
    }
}
struct cpx { float x, y; };
__device__ __forceinline__ cpx cmul(cpx a, cpx b) { cpx r; r.x = a.x * b.x - a.y * b.y; r.y = a.x * b.y + a.y * b.x; return r; }
__device__ __forceinline__ cpx cmulc(cpx a, cpx b) { cpx r; r.x = a.x * b.x + a.y * b.y; r.y = a.y * b.x - a.x * b.y; return r; }
__device__ __forceinline__ int fslot(int i) { return i + (i >> 5); }
#define FSLOTS (FN + (FN >> 5))
template <int NB, bool INV>
__device__ __forceinline__ void fft_pass(cpx* x, const cpx* tw, int shift, int tid) {
    for (int g = tid; g < (FN >> NB); g += NT) {
        const int low = g & ((1 << shift) - 1), high = g >> shift;
        const int base = (high << (shift + NB)) | low;
        cpx v[1 << NB];
#pragma unroll
        for (int j = 0; j < (1 << NB); ++j) v[j] = x[fslot(base | (j << shift))];
#pragma unroll
        for (int q = 0; q < NB; ++q) {
            const int lb = INV ? q : NB - 1 - q, ml = 1 << lb, gb = shift + lb;
#pragma unroll
            for (int j = 0; j < (1 << NB); ++j) {
                if (j & ml) continue;
                const cpx w = tw[((1 << gb) - 1) + ((base | (j << shift)) & ((1 << gb) - 1))];
                if (!INV) { cpx a = v[j], b2 = v[j + ml], d; v[j].x = a.x + b2.x; v[j].y = a.y + b2.y; d.x = a.x - b2.x; d.y = a.y - b2.y; v[j + ml] = cmul(d, w); }
                else { cpx a = v[j], b2 = cmulc(v[j + ml], w); v[j].x = a.x + b2.x; v[j].y = a.y + b2.y; v[j + ml].x = a.x - b2.x; v[j + ml].y = a.y - b2.y; }
            }
        }
#pragma unroll
        for (int j = 0; j < (1 << NB); ++j) x[fslot(base | (j << shift))] = v[j];
    }
    __syncthreads();
}
__device__ __forceinline__ void fft_fwd(cpx* x, const cpx* tw, int tid) {
#if FLOG == 13
    fft_pass<3, false>(x, tw, 10, tid); fft_pass<3, false>(x, tw, 7, tid); fft_pass<3, false>(x, tw, 4, tid); fft_pass<4, false>(x, tw, 0, tid);
#elif FLOG == 10
    fft_pass<3, false>(x, tw, 7, tid); fft_pass<3, false>(x, tw, 4, tid); fft_pass<4, false>(x, tw, 0, tid);
#else
    fft_pass<3, false>(x, tw, 6, tid); fft_pass<3, false>(x, tw, 3, tid); fft_pass<3, false>(x, tw, 0, tid);
#endif
}
__device__ __forceinline__ void fft_inv(cpx* x, const cpx* tw, int tid) {
#if FLOG == 13
    fft_pass<4, true>(x, tw, 0, tid); fft_pass<3, true>(x, tw, 4, tid); fft_pass<3, true>(x, tw, 7, tid); fft_pass<3, true>(x, tw, 10, tid);
#elif FLOG == 10
    fft_pass<4, true>(x, tw, 0, tid); fft_pass<3, true>(x, tw, 4, tid); fft_pass<3, true>(x, tw, 7, tid);
#else
    fft_pass<3, true>(x, tw, 0, tid); fft_pass<3, true>(x, tw, 3, tid); fft_pass<3, true>(x, tw, 6, tid);
#endif
}
__device__ __forceinline__ void fft_load_tw(const Params& p, cpx* tw, int tid) {
    for (int i = tid; i < FN - 1; i += NT) { tw[i].x = p.fft_tw[2 * i]; tw[i].y = p.fft_tw[2 * i + 1]; }
}
__device__ __forceinline__ void st_hy_taps(const Params& p, int wv, unsigned char* lds, int l, int bid, int nb) {
    const int tid = TIDX();
    float* hd = (float*)lds;
    const int w = tid >> 8, c = tid & 255;
    float fw[64];
#pragma unroll
    for (int j = 0; j < 64; ++j) fw[j] = p.in[I_HY_FW3][(long)l * 64 * 512 + j * 512 + w * 256 + c];
    const float dec = fabsf(p.in[I_HY_DECAY][(l * 2 + w) * 256 + c]);
    float* circ = p.hspec + (size_t)c * FN * 2;
    for (int u = bid; u < SEQ / 16; u += nb) {
        const int t0 = u * 16;
        for (int e = tid; e < 16 * 64; e += NT) hd[e] = p.hdn2[((size_t)l * SEQ + t0) * 64 + e];
        __syncthreads();
        for (int r = 0; r < 16; ++r) {
            const int t = t0 + r;
            float f = 0.f;
#pragma unroll
            for (int j = 0; j < 64; ++j) f += hd[r * 64 + j] * fw[j];
            const float tn = (float)((double)t / (double)(SEQ - 1));
            const float val = f * expf(-tn * dec);
            if (w == 0) circ[t] = val; else if (t >= 1) circ[FN - t] = val;
            if (w == 1 && t == 0) circ[SEQ] = 0.f;
        }
        __syncthreads();
    }
}
__device__ __forceinline__ void st_hy_spec(const Params& p, int wv, unsigned char* lds, int l, int bid, int nb) {
    const int tid = TIDX();
    cpx* x = (cpx*)lds; cpx* tw = x + FSLOTS; float* part = (float*)(tw + FN);
    if (bid < 256) fft_load_tw(p, tw, tid);
    for (int c = bid; c < 256; c += nb) {
        float* H = p.hspec + (size_t)c * FN * 2;
        float asum = 0.f;
        for (int i = tid; i < FN; i += NT) { const float val = H[i]; x[fslot(i)].x = val; x[fslot(i)].y = 0.f; asum += fabsf(val); }
        asum = wave_sum(asum);
        if ((tid & 63) == 0) part[tid >> 6] = asum;
        __syncthreads();
        float tot = 0.f;
        for (int q = 0; q < NW; ++q) tot += part[q];
        const float sc = 1.0f / (tot * (float)FN);
        fft_fwd(x, tw, tid);
        for (int i = tid; i < FN; i += NT) { cpx v = x[fslot(i)]; H[2 * i] = v.x * sc; H[2 * i + 1] = v.y * sc; }
        __syncthreads();
    }
}
#define HT 32
__device__ __forceinline__ void hy_stage(const Params& p, act_t* tl, int pitch, int b, int t0, int c0, int ncg, int tid) {
    for (int e = tid; e < (HT + 2) * ncg; e += NT) {
        const int r = e / ncg, cg = e % ncg, t = t0 - 1 + r;
        act_t* dst = tl + r * pitch + cg * 8;
        if (t >= 0 && t < SEQ) copy8(dst, p.proj + (long)(b * SEQ + t) * PROJ_W + O_HP + c0 + cg * 8);
        else {
#if defined(EMU)
            for (int i = 0; i < 8; ++i) dst[i] = f2a(0.f);
#else
            unsigned zz = 0u; asm volatile("" : "+v"(zz));
            *(u32x4*)dst = (u32x4){zz, zz, zz, zz};
#endif
        }
    }
}
__device__ __forceinline__ float hy_short_lds(const act_t* tl, int pitch, int r, int cc, const float* w3, float bias) {
    return bias + a2f(tl[r * pitch + cc]) * w3[0] + a2f(tl[(r + 1) * pitch + cc]) * w3[1] + a2f(tl[(r + 2) * pitch + cc]) * w3[2];
}
__device__ __forceinline__ void st_hy_pre(const Params& p, int wv, unsigned char* lds, int l, int bid, int nb) {
    const int tid = TIDX(), wave = tid >> 6, lane = tid & 63;
    float* tile = (float*)lds;
    act_t* tl = (act_t*)(tile + HT * 257);
    const int ch = tid & 255;
    const float* cw = p.in[I_HY_CONV_W] + (long)l * 3 * 768;
    const float w1[3] = {cw[256 + ch], cw[768 + 256 + ch], cw[1536 + 256 + ch]}, w2[3] = {cw[512 + ch], cw[768 + 512 + ch], cw[1536 + 512 + ch]};
    const float b1 = p.in[I_HY_CONV_B][l * 768 + 256 + ch], b2 = p.in[I_HY_CONV_B][l * 768 + 512 + ch];
    for (int u = bid; u < BATCH * (SEQ / HT); u += nb) {
        const int b = u / (SEQ / HT), t0 = (u % (SEQ / HT)) * HT;
        hy_stage(p, tl, 520, b, t0, 256, 64, tid);
        __syncthreads();
        for (int r = tid >> 8; r < HT; r += 2) tile[r * 257 + ch] = hy_short_lds(tl, 520, r, ch, w1, b1) * hy_short_lds(tl, 520, r, 256 + ch, w2, b2);
        __syncthreads();
        for (int c = wave * 2 + (lane >> 5); c < 256; c += 2 * NW) p.hz[((size_t)(b * 256 + c)) * SEQ + t0 + (lane & 31)] = f2a(tile[(lane & 31) * 257 + c]);
        __syncthreads();
    }
}
__device__ __forceinline__ void st_hy_fft(const Params& p, int wv, unsigned char* lds, int l, int bid, int nb) {
    const int tid = TIDX();
    cpx* x = (cpx*)lds; cpx* tw = x + FSLOTS;
    const int NPAIR = (BATCH + 1) / 2;
    if (bid < 256 * NPAIR) fft_load_tw(p, tw, tid);
    for (int u = bid; u < 256 * NPAIR; u += nb) {
        const int c = u / NPAIR, q = u % NPAIR, b1 = 2 * q, b2 = 2 * q + 1;
        act_t* z1 = p.hz + ((size_t)(b1 * 256 + c)) * SEQ;
        act_t* z2 = p.hz + ((size_t)((b2 < BATCH ? b2 : b1) * 256 + c)) * SEQ;
        for (int i8 = tid; i8 < FN / 8; i8 += NT) {
            float a[8] = {0.f, 0.f, 0.f, 0.f, 0.f, 0.f, 0.f, 0.f}, c2[8] = {0.f, 0.f, 0.f, 0.f, 0.f, 0.f, 0.f, 0.f};
            if (i8 * 8 < SEQ) { load8f(a, z1 + i8 * 8); if (b2 < BATCH) load8f(c2, z2 + i8 * 8); }
            for (int j = 0; j < 8; ++j) { cpx v; v.x = a[j]; v.y = c2[j]; x[fslot(i8 * 8 + j)] = v; }
        }
        __syncthreads();
        fft_fwd(x, tw, tid);
        const float* H = p.hspec + (size_t)c * FN * 2;
        for (int i = tid; i < FN; i += NT) { cpx h; h.x = H[2 * i]; h.y = H[2 * i + 1]; x[fslot(i)] = cmul(x[fslot(i)], h); }
        __syncthreads();
        fft_inv(x, tw, tid);
        for (int i8 = tid; i8 < SEQ / 8; i8 += NT) {
            float a[8], c2[8];
            for (int j = 0; j < 8; ++j) { cpx v = x[fslot(i8 * 8 + j)]; a[j] = v.x; c2[j] = v.y; }
            store8(z1 + i8 * 8, a); if (b2 < BATCH) store8(z2 + i8 * 8, c2);
        }
        __syncthreads();
    }
}
__device__ __forceinline__ void st_hy_post(const Params& p, int wv, unsigned char* lds, int l, int bid, int nb) {
    const int tid = TIDX(), wave = tid >> 6, lane = tid & 63;
    float* tile = (float*)lds;
    act_t* tl = (act_t*)(tile + HT * 257);
    const int ch = tid & 255;
    const float* cw = p.in[I_HY_CONV_W] + (long)l * 3 * 768;
    const float w0[3] = {cw[ch], cw[768 + ch], cw[1536 + ch]}, w1[3] = {cw[256 + ch], cw[768 + 256 + ch], cw[1536 + 256 + ch]}, w2[3] = {cw[512 + ch], cw[768 + 512 + ch], cw[1536 + 512 + ch]};
    const float b0 = p.in[I_HY_CONV_B][l * 768 + ch], b1 = p.in[I_HY_CONV_B][l * 768 + 256 + ch], b2 = p.in[I_HY_CONV_B][l * 768 + 512 + ch];
    const float hb = p.in[I_HY_BIAS][l * 256 + ch];
    for (int u = bid; u < BATCH * (SEQ / HT); u += nb) {
        const int b = u / (SEQ / HT), t0 = (u % (SEQ / HT)) * HT;
        hy_stage(p, tl, 776, b, t0, 0, 96, tid);
        for (int c = wave * 2 + (lane >> 5); c < 256; c += 2 * NW) tile[(lane & 31) * 257 + c] = a2f(p.hz[((size_t)(b * 256 + c)) * SEQ + t0 + (lane & 31)]);
        __syncthreads();
        for (int r = tid >> 8; r < HT; r += 2) {
            const float z = hy_short_lds(tl, 776, r, 256 + ch, w1, b1) * hy_short_lds(tl, 776, r, 512 + ch, w2, b2);
            const float x0 = hy_short_lds(tl, 776, r, ch, w0, b0);
            p.mix[(long)(b * SEQ + t0 + r) * DM + 768 + ch] = f2a(x0 * (tile[r * 257 + ch] + z * hb));
        }
        __syncthreads();
    }
}
#define RC 128
#define NCH_CTX (CTXL / RC)
#define NCH_LAT (SEQ / RC)
#define NCHK (NCH_CTX + NCH_LAT)
__device__ __forceinline__ int chunk_row0(int b, int cidx) { return cidx < NCH_CTX ? NLAT + b * CTXL + cidx * RC : b * SEQ + (cidx - NCH_CTX) * RC; }
__device__ __forceinline__ int chunk_at(int dir, int k) { if (!dir) return k; return k < NCH_CTX ? NCH_CTX - 1 - k : NCH_CTX + (NCH_LAT - 1 - (k - NCH_CTX)); }
typedef short bf16x8v __attribute__((ext_vector_type(8)));
__device__ __forceinline__ f32x4 mm16(f32x4 acc, const act_t* A, int pa, const act_t* Bt, int pb, int K, int lane) {
#if defined(EMU)
    for (int r = 0; r < 4; ++r) {
        const act_t* ap = A + (4 * (lane >> 4) + r) * pa; const act_t* bp = Bt + (lane & 15) * pb;
        float sacc = 0.f;
        for (int k = 0; k < K; ++k) sacc += a2f(ap[k]) * a2f(bp[k]);
        acc[r] += sacc;
    }
    return acc;
#else
    const act_t* ap = A + (lane & 15) * pa + 8 * (lane >> 4); const act_t* bp = Bt + (lane & 15) * pb + 8 * (lane >> 4);
#pragma unroll 8
    for (int k0 = 0; k0 < K; k0 += 32) {
        const bf16x8v a = *(const bf16x8v*)(ap + k0), b = *(const bf16x8v*)(bp + k0);
        acc = __builtin_amdgcn_mfma_f32_16x16x32_bf16(a, b, acc, 0, 0, 0);
    }
    return acc;
#endif
}
#define RPK (RC + 8)
#define RPQ 72
__device__ __forceinline__ void st_ret_a(const Params& p, int wv, unsigned char* lds, int l, int bid, int nb) {
    const int tid = TIDX(), wave = tid >> 6, lane = tid & 63;
    act_t* kTf = (act_t*)lds; act_t* kTb = kTf + 64 * RPK; act_t* vT = kTb + 64 * RPK;
    for (int u = bid; u < BATCH * 4 * NCHK; u += nb) {
        const int cidx = u % NCHK, h = (u / NCHK) & 3, b = u / (NCHK * 4);
        const int row0 = chunk_row0(b, cidx);
        const float lgf = log_sigmoid_f(p.in[I_RET_DECAY][(l * 2 + 0) * 4 + h]), lgb = log_sigmoid_f(p.in[I_RET_DECAY][(l * 2 + 1) * 4 + h]);
        for (int e = tid; e < RC * 8; e += NT) {
            const int sx = e >> 3, d8 = (e & 7) * 8;
            const act_t* pr = p.proj + (long)(row0 + sx) * PROJ_W;
            float kv[8], vv[8];
            load8f(kv, pr + O_RK + h * 64 + d8); load8f(vv, pr + O_RV + h * 64 + d8);
            const float df = expf(lgf * (float)(RC - 1 - sx)), db = expf(lgb * (float)sx);
            for (int j = 0; j < 8; ++j) {
                kTf[(d8 + j) * RPK + sx] = f2a(kv[j] * df);
                kTb[(d8 + j) * RPK + sx] = f2a(kv[j] * db);
                vT[(d8 + j) * RPK + sx] = f2a(vv[j]);
            }
        }
        __syncthreads();
        {
            const int dir = wave >> 2, db = wave & 3;
            const act_t* Ak = (dir ? kTb : kTf) + 16 * db * RPK;
            float* D = p.retD + ((size_t)(((b * 4 + h) * 2 + dir) * NCHK + cidx)) * 4096;
            for (int n = 0; n < 4; ++n) {
                f32x4 acc = (f32x4){0.f, 0.f, 0.f, 0.f};
                acc = mm16(acc, Ak, RPK, vT + 16 * n * RPK, RPK, RC, lane);
                for (int r = 0; r < 4; ++r) D[(16 * db + 4 * (lane >> 4) + r) * 64 + 16 * n + (lane & 15)] = acc[r];
            }
        }
        __syncthreads();
    }
}
__device__ __forceinline__ void st_ret_b(const Params& p, int wv, int l, int bid, int nb) {
    const int tid = TIDX();
    for (int it = bid * NT + tid; it < BATCH * 4 * 2 * 4096; it += nb * NT) {
        const int el = it & 4095, seq = it >> 12, dir = seq & 1, h = (seq >> 1) & 3;
        const float gC = expf((float)RC * log_sigmoid_f(p.in[I_RET_DECAY][(l * 2 + dir) * 4 + h]));
        float* base = p.retD + (size_t)seq * NCHK * 4096 + el;
        float S = 0.f;
#pragma unroll 1
        for (int kb = 0; kb < NCHK; kb += 17) {
            float Dv[17];
#pragma unroll
            for (int j = 0; j < 17; ++j) Dv[j] = (kb + j < NCHK) ? base[(size_t)chunk_at(dir, kb + j) * 4096] : 0.f;
#pragma unroll
            for (int j = 0; j < 17; ++j) if (kb + j < NCHK) { base[(size_t)chunk_at(dir, kb + j) * 4096] = S; S = gC * S + Dv[j]; }
        }
    }
}
__device__ __forceinline__ void st_ret_c(const Params& p, int wv, unsigned char* lds, int l, int bid, int nb) {
    const int tid = TIDX(), wave = tid >> 6, lane = tid & 63;
    const bool need_ctx = (l != DEPTH - 1);
    act_t* qs = (act_t*)lds; act_t* ks = qs + RC * RPQ; act_t* P = qs;
    act_t* vT = ks + RC * RPQ; act_t* qt = vT + 64 * RPK; act_t* ST = qt + RC * RPK; float* mt = (float*)(ST + 64 * RPK);
    float* of = (float*)qt;
    for (int u = bid; u < BATCH * 4 * NCHK; u += nb) {
        const int cidx = u % NCHK, h = (u / NCHK) & 3, b = u / (NCHK * 4);
        if (cidx < NCH_CTX && !need_ctx) continue;
        const int row0 = chunk_row0(b, cidx);
        const float lgf = log_sigmoid_f(p.in[I_RET_DECAY][(l * 2 + 0) * 4 + h]), lgb = log_sigmoid_f(p.in[I_RET_DECAY][(l * 2 + 1) * 4 + h]);
        for (int e = tid; e < RC * 8; e += NT) {
            const int sx = e >> 3, d8 = (e & 7) * 8;
            const act_t* pr = p.proj + (long)(row0 + sx) * PROJ_W;
            float qv[8], vv[8], q1[8], q2[8];
            load8f(qv, pr + O_RQ + h * 64 + d8); load8f(vv, pr + O_RV + h * 64 + d8);
            copy8(qs + sx * RPQ + d8, pr + O_RQ + h * 64 + d8);
            copy8(ks + sx * RPQ + d8, pr + O_RK + h * 64 + d8);
            const float e1 = expf(lgf * (float)(sx + 1)), e2 = expf(lgb * (float)(RC - sx));
            for (int j = 0; j < 8; ++j) { vT[(d8 + j) * RPK + sx] = f2a(vv[j]); q1[j] = qv[j] * e1; q2[j] = qv[j] * e2; }
            store8(qt + sx * RPK + d8, q1); store8(qt + sx * RPK + 64 + d8, q2);
        }
        for (int e = tid; e < 2 * 64 * 16; e += NT) {
            const int dir = e >> 10, d = (e >> 4) & 63, e4 = (e & 15) * 4;
            const f32x4 sv = *(const f32x4*)(p.retD + ((size_t)(((b * 4 + h) * 2 + dir) * NCHK + cidx)) * 4096 + d * 64 + e4);
            for (int j = 0; j < 4; ++j) ST[(e4 + j) * RPK + dir * 64 + d] = f2a(sv[j]);
        }
        if (tid < 2 * RC - 1) { const int dl = tid - (RC - 1); mt[tid] = dl > 0 ? expf(lgf * (float)dl) : (dl < 0 ? expf(lgb * (float)(-dl)) : 2.0f); }
        __syncthreads();
        f32x4 racc[8];
        for (int n = 0; n < 8; ++n) { racc[n] = (f32x4){0.f, 0.f, 0.f, 0.f}; racc[n] = mm16(racc[n], qs + 16 * wave * RPQ, RPQ, ks + 16 * n * RPQ, RPQ, 64, lane); }
        __syncthreads();
        for (int n = 0; n < 8; ++n) for (int r = 0; r < 4; ++r) {
            const int t = 16 * wave + 4 * (lane >> 4) + r, sx = 16 * n + (lane & 15);
            P[t * RPK + sx] = f2a(racc[n][r] * mt[t - sx + RC - 1]);
        }
        __syncthreads();
        f32x4 oacc[4];
        for (int n = 0; n < 4; ++n) {
            oacc[n] = (f32x4){0.f, 0.f, 0.f, 0.f};
            oacc[n] = mm16(oacc[n], P + 16 * wave * RPK, RPK, vT + 16 * n * RPK, RPK, RC, lane);
            oacc[n] = mm16(oacc[n], qt + 16 * wave * RPK, RPK, ST + 16 * n * RPK, RPK, 128, lane);
        }
        __syncthreads();
        for (int n = 0; n < 4; ++n) for (int r = 0; r < 4; ++r) of[(16 * wave + 4 * (lane >> 4) + r) * 68 + 16 * n + (lane & 15)] = oacc[n][r];
        __syncthreads();
        {
            const int c = h * 64 + lane;
            const float gg = p.in[I_RET_GN_G][l * 256 + c], gb2 = p.in[I_RET_GN_B][l * 256 + c];
            float gate[16];
#pragma unroll
            for (int rr = 0; rr < 16; ++rr) gate[rr] = a2f(p.proj[(long)(row0 + 16 * wave + rr) * PROJ_W + O_RG + c]);
#pragma unroll
            for (int rr = 0; rr < 16; ++rr) {
                const int t = 16 * wave + rr, row = row0 + t;
                const float o = of[t * 68 + lane];
                const float mu = wave_sum(o) * (1.0f / 64.0f);
                const float dd = o - mu;
                const float var = wave_sum(dd * dd) * (1.0f / 64.0f);
                const float yv = dd * (1.0f / sqrtf(var + LN_EPS)) * gg + gb2;
                p.mix[(long)row * DM + c] = f2a(yv * silu_f(gate[rr]));
            }
        }
        __syncthreads();
    }
}
#define GC 64
#define GNCH_CTX (CTXL / GC)
#define GNCH_LAT (SEQ / GC)
#define GNCHK (GNCH_CTX + GNCH_LAT)
__device__ __forceinline__ int gchunk_row0(int b, int cidx) { return cidx < GNCH_CTX ? NLAT + b * CTXL + cidx * GC : b * SEQ + (cidx - GNCH_CTX) * GC; }
__device__ __forceinline__ int gchunk_at(int dir, int k) { if (!dir) return k; return k < GNCH_CTX ? GNCH_CTX - 1 - k : GNCH_CTX + (GNCH_LAT - 1 - (k - GNCH_CTX)); }
#define GP 72
__device__ __forceinline__ void gla_cumsum(const Params& p, float* cs, int row0, int h, int tid) {
    for (int e = tid; e < 2 * GC * 8; e += NT) {
        const int dir = e >> 9, t = (e >> 3) & 63, d4 = (e & 7) * 4;
        *(f32x4*)(cs + dir * GC * 32 + t * 32 + d4) = *(const f32x4*)(p.loga + (long)(row0 + t) * 256 + dir * 128 + h * 32 + d4);
    }
    __syncthreads();
    {
        float* seg = cs + 2 * GC * 32;
        const int col = tid & 63, sg = tid >> 6, dir = col >> 5, d = col & 31;
        float* c = cs + dir * GC * 32 + d;
        float run = 0.f;
        for (int q = 0; q < 8; ++q) { const int t = dir ? GC - 1 - (sg * 8 + q) : sg * 8 + q; run += c[t * 32]; c[t * 32] = run; }
        seg[sg * 64 + col] = run;
        __syncthreads();
        float off = 0.f;
        for (int q = 0; q < sg; ++q) off += seg[q * 64 + col];
        if (sg) for (int q = 0; q < 8; ++q) { const int t = dir ? GC - 1 - (sg * 8 + q) : sg * 8 + q; c[t * 32] += off; }
    }
    __syncthreads();
}
__device__ __forceinline__ void st_gla_a(const Params& p, int wv, unsigned char* lds, int l, int bid, int nb) {
    const int tid = TIDX(), wave = tid >> 6, lane = tid & 63;
    float* cs = (float*)lds; act_t* kTf = (act_t*)(cs + 2 * GC * 32 + 512); act_t* kTb = kTf + 32 * GP; act_t* vT = kTb + 32 * GP;
    for (int u = bid; u < BATCH * 4 * GNCHK; u += nb) {
        const int cidx = u % GNCHK, h = (u / GNCHK) & 3, b = u / (GNCHK * 4);
        const int row0 = gchunk_row0(b, cidx);
        gla_cumsum(p, cs, row0, h, tid);
        for (int e = tid; e < GC * 4; e += NT) {
            const int sx = e >> 2, d8 = (e & 3) * 8;
            float kv[8];
            load8f(kv, p.proj + (long)(row0 + sx) * PROJ_W + O_GK + h * 32 + d8);
            for (int j = 0; j < 8; ++j) {
                const int d = d8 + j;
                kTf[d * GP + sx] = f2a(kv[j] * expf(cs[(GC - 1) * 32 + d] - cs[sx * 32 + d]));
                kTb[d * GP + sx] = f2a(kv[j] * expf(cs[GC * 32 + d] - cs[GC * 32 + sx * 32 + d]));
            }
        }
        for (int e = tid; e < GC * 8; e += NT) {
            const int sx = e >> 3, e8 = (e & 7) * 8;
            float vv[8];
            load8f(vv, p.proj + (long)(row0 + sx) * PROJ_W + O_GV + h * 64 + e8);
            for (int j = 0; j < 8; ++j) vT[(e8 + j) * GP + sx] = f2a(vv[j]);
        }
        const size_t ub = (size_t)(b * 4 + h) * 2;
        if (tid < 64) { const int dir = tid >> 5, d = tid & 31; p.glaE[((ub + dir) * GNCHK + cidx) * 32 + d] = expf(dir ? cs[GC * 32 + d] : cs[(GC - 1) * 32 + d]); }
        __syncthreads();
        {
            const int dir = wave >> 2, db = (wave >> 1) & 1, nh = wave & 1;
            float* D = p.glaD + ((ub + dir) * GNCHK + cidx) * 2048;
            for (int q = 0; q < 2; ++q) {
                const int n = nh * 2 + q;
                f32x4 acc = (f32x4){0.f, 0.f, 0.f, 0.f};
                acc = mm16(acc, (dir ? kTb : kTf) + 16 * db * GP, GP, vT + 16 * n * GP, GP, GC, lane);
                for (int r = 0; r < 4; ++r) D[(16 * db + 4 * (lane >> 4) + r) * 64 + 16 * n + (lane & 15)] = acc[r];
            }
        }
        __syncthreads();
    }
}
__device__ __forceinline__ void st_gla_b(const Params& p, int wv, int l, int bid, int nb) {
    const int tid = TIDX();
    for (int it = bid * NT + tid; it < BATCH * 4 * 2 * 2048; it += nb * NT) {
        const int el = it & 2047, seq = it >> 11, dir = seq & 1, d = el >> 6;
        float* base = p.glaD + (size_t)seq * GNCHK * 2048 + el;
        const float* eb = p.glaE + (size_t)seq * GNCHK * 32 + d;
        float S = 0.f;
#pragma unroll 1
        for (int kb = 0; kb < GNCHK; kb += 17) {
            float Dv[17], Ev[17];
#pragma unroll
            for (int j = 0; j < 17; ++j) { const int c = gchunk_at(dir, kb + j < GNCHK ? kb + j : 0); Dv[j] = base[(size_t)c * 2048]; Ev[j] = eb[c * 32]; }
#pragma unroll
            for (int j = 0; j < 17; ++j) if (kb + j < GNCHK) { base[(size_t)gchunk_at(dir, kb + j) * 2048] = S; S = Ev[j] * S + Dv[j]; }
        }
    }
}
__device__ __forceinline__ void st_gla_c(const Params& p, int wv, unsigned char* lds, int l, int bid, int nb) {
    const int tid = TIDX(), wave = tid >> 6, lane = tid & 63;
    const bool need_ctx = (l != DEPTH - 1);
    float* cs = (float*)lds; act_t* qt = (act_t*)(cs + 2 * GC * 32 + 512); act_t* kt = qt + GC * GP; act_t* vT = kt + GC * GP; act_t* P = vT + 64 * GP; act_t* ST = P + GC * GP;
    float* of = (float*)(ST + 64 * GP);
    for (int u = bid; u < BATCH * 4 * GNCHK; u += nb) {
        const int cidx = u % GNCHK, h = (u / GNCHK) & 3, b = u / (GNCHK * 4);
        if (cidx < GNCH_CTX && !need_ctx) continue;
        const int row0 = gchunk_row0(b, cidx);
        gla_cumsum(p, cs, row0, h, tid);
        for (int e = tid; e < GC * 8; e += NT) {
            const int sx = e >> 3, c8 = (e & 7) * 8, dir = c8 >> 5, d8 = c8 & 31;
            const act_t* pr = p.proj + (long)(row0 + sx) * PROJ_W;
            float qv[8], kv[8], vv[8], qo[8], ko[8];
            load8f(qv, pr + O_GQ + h * 32 + d8); load8f(kv, pr + O_GK + h * 32 + d8); load8f(vv, pr + O_GV + h * 64 + c8);
            for (int j = 0; j < 8; ++j) {
                const float cv = cs[dir * GC * 32 + sx * 32 + d8 + j];
                qo[j] = qv[j] * expf(cv); ko[j] = kv[j] * expf(-cv);
                vT[(c8 + j) * GP + sx] = f2a(vv[j]);
            }
            store8(qt + sx * GP + c8, qo); store8(kt + sx * GP + c8, ko);
        }
        const size_t ub = (size_t)(b * 4 + h) * 2;
        for (int e = tid; e < 2 * 32 * 16; e += NT) {
            const int dir = e >> 9, d = (e >> 4) & 31, e4 = (e & 15) * 4;
            const f32x4 sv = *(const f32x4*)(p.glaD + ((ub + dir) * GNCHK + cidx) * 2048 + d * 64 + e4);
            for (int j = 0; j < 4; ++j) ST[(e4 + j) * GP + dir * 32 + d] = f2a(sv[j]);
        }
        __syncthreads();
        {
            const int rb = wave & 3, nh = wave >> 2;
            for (int q = 0; q < 2; ++q) {
                const int n = nh * 2 + q;
                f32x4 rf = (f32x4){0.f, 0.f, 0.f, 0.f}, rbk = (f32x4){0.f, 0.f, 0.f, 0.f};
                rf = mm16(rf, qt + 16 * rb * GP, GP, kt + 16 * n * GP, GP, 32, lane);
                rbk = mm16(rbk, qt + 16 * rb * GP + 32, GP, kt + 16 * n * GP + 32, GP, 32, lane);
                for (int r = 0; r < 4; ++r) {
                    const int t = 16 * rb + 4 * (lane >> 4) + r, sx = 16 * n + (lane & 15);
                    P[t * GP + sx] = f2a((sx <= t ? rf[r] : 0.f) + (sx >= t ? rbk[r] : 0.f));
                }
            }
        }
        __syncthreads();
        {
            const int rb = wave & 3, nh = wave >> 2;
            for (int q = 0; q < 2; ++q) {
                const int n = nh * 2 + q;
                f32x4 acc = (f32x4){0.f, 0.f, 0.f, 0.f};
                acc = mm16(acc, P + 16 * rb * GP, GP, vT + 16 * n * GP, GP, GC, lane);
                acc = mm16(acc, qt + 16 * rb * GP, GP, ST + 16 * n * GP, GP, 64, lane);
                for (int r = 0; r < 4; ++r) of[(16 * rb + 4 * (lane >> 4) + r) * 68 + 16 * n + (lane & 15)] = acc[r];
            }
        }
        __syncthreads();
        {
            const int c = h * 64 + lane;
            const float ng = p.in[I_GLA_NORM_G][l * 256 + c];
            float gate[8];
#pragma unroll
            for (int rr = 0; rr < 8; ++rr) gate[rr] = a2f(p.proj[(long)(row0 + 8 * wave + rr) * PROJ_W + O_GR + c]);
#pragma unroll
            for (int rr = 0; rr < 8; ++rr) {
                const int t = 8 * wave + rr, row = row0 + t;
                const float o = of[t * 68 + lane];
                const float ms = wave_sum(o * o) * (1.0f / 64.0f);
                const float yv = o * (1.0f / sqrtf(ms + LN_EPS)) * ng;
                p.mix[(long)row * DM + 256 + c] = f2a(yv * silu_f(gate[rr]));
            }
        }
        __syncthreads();
    }
}
#define SC 64
#define SNCHK ((CTXL + SEQ) / SC)
#define SNCOL (BATCH * SNCHK)
#define SNCT ((SNCOL + 15) / 16)
#define SPU (SC * 16 + 8)
#define SPH 264
__device__ __forceinline__ void st_s5_tables(const Params& p, int wv, int l, int bid, int nb) {
    const int tid = TIDX();
    for (int it = bid * NT + tid; it < 16 * 127 * 256; it += nb * NT) {
        const int pp = it & 15, pq = (it >> 4) & 15, dl = (it >> 8) % 127, g = it / (127 * 256);
        const int delta = dl - 63;
        float val = 0.f;
        for (int d = 0; d < 2; ++d) {
            if (d == 0 ? delta < 0 : delta > 0) continue;
            const int tau = delta < 0 ? -delta : delta, pg = (l * 2 + d) * 16 + g;
            const float* cre = p.in[I_S5_C_RE] + ((size_t)pg * 16 + pq) * 64; const float* cim = p.in[I_S5_C_IM] + ((size_t)pg * 16 + pq) * 64;
            const float* pw = p.s5pw + ((size_t)pg * 65 + tau) * 128;
            float acc = 0.f;
            for (int n = 0; n < 64; ++n) {
                const float* tb = p.s5tab + ((size_t)pg * 64 + n) * 34;
                const float wr = pw[2 * n], wi = pw[2 * n + 1], br = tb[2 + pp], bi = tb[18 + pp];
                const float vr = wr * br - wi * bi, vi = wr * bi + wi * br;
                acc += cre[n] * vr - cim[n] * vi;
            }
            val += acc;
        }
        p.s5Tc[it] = f2a(val);
    }
    for (int it = bid * NT + tid; it < 16 * 1024 * 256; it += nb * NT) {
        const int k = it & 255, row = (it >> 8) & 1023, g = it >> 18;
        const int d = k >> 7, ri = (k >> 6) & 1, n = k & 63, i = row >> 4, pq = row & 15, pg = (l * 2 + d) * 16 + g;
        const int ex = d ? SC - i : i + 1;
        const float cr = p.in[I_S5_C_RE][((size_t)pg * 16 + pq) * 64 + n], ci = p.in[I_S5_C_IM][((size_t)pg * 16 + pq) * 64 + n];
        const float wr = p.s5pw[(((size_t)pg * 65 + ex) * 64 + n) * 2], wi = p.s5pw[(((size_t)pg * 65 + ex) * 64 + n) * 2 + 1];
        p.s5Win[it] = f2a(ri ? -(cr * wi + ci * wr) : (cr * wr - ci * wi));
    }
    for (int it = bid * NT + tid; it < 16 * 2 * 128 * 1024; it += nb * NT) {
        const int k = it & 1023, nri = (it >> 10) & 127, d = (it >> 17) & 1, g = it >> 18;
        const int j = k >> 4, pp = k & 15, ri = nri >> 6, n = nri & 63, pg = (l * 2 + d) * 16 + g;
        const int ex = d ? j : SC - 1 - j;
        const float* tb = p.s5tab + ((size_t)pg * 64 + n) * 34;
        const float wr = p.s5pw[(((size_t)pg * 65 + ex) * 64 + n) * 2], wi = p.s5pw[(((size_t)pg * 65 + ex) * 64 + n) * 2 + 1];
        const float br = tb[2 + pp], bi = tb[18 + pp];
        p.s5Wend[it] = f2a(ri ? (wr * bi + wi * br) : (wr * br - wi * bi));
    }
}
__device__ __forceinline__ void s5_load_cols(const Params& p, act_t* U, int g, int ct, int tid) {
    for (int e = tid; e < 16 * SC * 2; e += NT) {
        const int hf = e & 1, j = (e >> 1) & 63, cl = e >> 7, col = ct * 16 + cl;
        act_t* dst = U + cl * SPU + j * 16 + hf * 8;
        if (SNCOL % 16 == 0 || col < SNCOL) copy8(dst, p.proj + (long)(gchunk_row0(col / SNCHK, col % SNCHK) + j) * PROJ_W + O_SU + g * 16 + hf * 8);
        else { float z8[8] = {0.f, 0.f, 0.f, 0.f, 0.f, 0.f, 0.f, 0.f}; store8(dst, z8); }
    }
}
__device__ __forceinline__ void st_s5_a(const Params& p, int wv, unsigned char* lds, int l, int bid, int nb) {
    const int tid = TIDX(), wave = tid >> 6, lane = tid & 63;
    act_t* U = (act_t*)lds;
    for (int u = bid; u < 16 * SNCT; u += nb) {
        const int ct = u % SNCT, g = u / SNCT;
        s5_load_cols(p, U, g, ct, tid);
        __syncthreads();
        for (int dir = 0; dir < 2; ++dir) {
            f32x4 acc = (f32x4){0.f, 0.f, 0.f, 0.f};
            acc = mm16(acc, p.s5Wend + ((size_t)(g * 2 + dir) * 128 + 16 * wave) * 1024, 1024, U, SPU, 1024, lane);
            const int col = ct * 16 + (lane & 15);
            if (col < SNCOL) {
                const int b = col / SNCHK, cidx = col % SNCHK;
                float* S = p.s5S + ((size_t)((b * 16 + g) * 2 + dir) * SNCHK + cidx) * 128;
                for (int r = 0; r < 4; ++r) S[16 * wave + 4 * (lane >> 4) + r] = acc[r];
            }
        }
        __syncthreads();
    }
}
__device__ __forceinline__ void st_s5_b(const Params& p, int wv, int l, int bid, int nb) {
    const int tid = TIDX();
    for (int it = bid * NT + tid; it < BATCH * 16 * 2 * 64; it += nb * NT) {
        const int n = it & 63, seq = it >> 6, dir = seq & 1, g = (seq >> 1) & 15, pg = (l * 2 + dir) * 16 + g;
        const float lr = p.s5pw[(((size_t)pg * 65 + SC) * 64 + n) * 2], li = p.s5pw[(((size_t)pg * 65 + SC) * 64 + n) * 2 + 1];
        float* base = p.s5S + (size_t)seq * SNCHK * 128 + n;
        float hr = 0.f, hi = 0.f;
#pragma unroll 1
        for (int kb = 0; kb < SNCHK; kb += 17) {
            float sr[17], si[17];
#pragma unroll
            for (int j = 0; j < 17; ++j) { const int c = gchunk_at(dir, kb + j < SNCHK ? kb + j : 0); sr[j] = base[c * 128]; si[j] = base[c * 128 + 64]; }
#pragma unroll
            for (int j = 0; j < 17; ++j) if (kb + j < SNCHK) {
                const int c = gchunk_at(dir, kb + j);
                base[c * 128] = hr; base[c * 128 + 64] = hi;
                const float nr = lr * hr - li * hi + sr[j], ni = lr * hi + li * hr + si[j];
                hr = nr; hi = ni;
            }
        }
    }
}
__device__ __forceinline__ f32x4 mm16_toep(f32x4 acc, const act_t* Tc, int i, const act_t* U, int lane) {
#if defined(EMU)
    for (int r = 0; r < 4; ++r) {
        const int pq = 4 * (lane >> 4) + r, cl = lane & 15;
        float sacc = 0.f;
        for (int j = 0; j < SC; ++j) for (int pp = 0; pp < 16; ++pp) sacc += a2f(Tc[((i - j + 63) * 16 + pq) * 16 + pp]) * a2f(U[cl * SPU + j * 16 + pp]);
        acc[r] += sacc;
    }
    return acc;
#else
    const int pq = lane & 15, kq = lane >> 4;
    const act_t* bp = U + (lane & 15) * SPU + 8 * kq;
    for (int ks = 0; ks < SC / 2; ++ks) {
        const int j = 2 * ks + (kq >> 1);
        const bf16x8v a = *(const bf16x8v*)(Tc + ((i - j + 63) * 16 + pq) * 16 + 8 * (kq & 1)), b = *(const bf16x8v*)(bp + ks * 32);
        acc = __builtin_amdgcn_mfma_f32_16x16x32_bf16(a, b, acc, 0, 0, 0);
    }
    return acc;
#endif
}
__device__ __forceinline__ void st_s5_c(const Params& p, int wv, unsigned char* lds, int l, int bid, int nb) {
    const int tid = TIDX(), wave = tid >> 6, lane = tid & 63;
    const bool need_ctx = (l != DEPTH - 1);
    act_t* U = (act_t*)lds; act_t* Hc = U + 16 * SPU; act_t* Tc = Hc + 16 * SPH;
    for (int u = bid; u < 16 * SNCT; u += nb) {
        const int ct = u % SNCT, g = u / SNCT;
        s5_load_cols(p, U, g, ct, tid);
        for (int e = tid; e < 16 * 64; e += NT) {
            const int k4 = (e & 63) * 4, cl = e >> 6, col = ct * 16 + cl;
            float v[4] = {0.f, 0.f, 0.f, 0.f};
            if (col < SNCOL) { const f32x4 sv = *(const f32x4*)(p.s5S + ((size_t)(((col / SNCHK) * 16 + g) * 2 + (k4 >> 7)) * SNCHK + col % SNCHK) * 128 + (k4 & 127)); v[0] = sv[0]; v[1] = sv[1]; v[2] = sv[2]; v[3] = sv[3]; }
            store4(Hc + cl * SPH + k4, v);
        }
        for (int e = tid; e < 127 * 32; e += NT) copy8(Tc + e * 8, p.s5Tc + (size_t)g * 127 * 256 + e * 8);
        __syncthreads();
        const int col = ct * 16 + (lane & 15);
        const bool valid = col < SNCOL && (need_ctx || (col % SNCHK) >= GNCH_CTX);
        const int row0 = valid ? gchunk_row0(col / SNCHK, col % SNCHK) : 0;
        float dsk[4];
        for (int r = 0; r < 4; ++r) dsk[r] = p.in[I_S5_D][l * 256 + g * 16 + 4 * (lane >> 4) + r];
        for (int i = wave; i < SC; i += NW) {
            f32x4 acc = (f32x4){0.f, 0.f, 0.f, 0.f};
            acc = mm16_toep(acc, Tc, i, U, lane);
            acc = mm16(acc, p.s5Win + ((size_t)g * 1024 + i * 16) * 256, 256, Hc, SPH, 256, lane);
            if (valid) {
                float o[4];
                for (int r = 0; r < 4; ++r) {
                    const int pq = 4 * (lane >> 4) + r;
                    const float yv = acc[r] + dsk[r] * a2f(U[(lane & 15) * SPU + i * 16 + pq]);
                    o[r] = gelu_tanh_f(yv);
                }
                store4(p.gbuf + (size_t)(row0 + i) * 256 + g * 16 + 4 * (lane >> 4), o);
            }
        }
        __syncthreads();
    }
}
__device__ __forceinline__ int scan_row(int b, int dir, int step, bool& isctx) {
    isctx = step < CTXL;
    if (isctx) { int t = dir ? CTXL - 1 - step : step; return NLAT + b * CTXL + t; }
    int s2 = step - CTXL; int t = dir ? SEQ - 1 - s2 : s2; return b * SEQ + t;
}
__device__ __forceinline__ void st_scan_ret(const Params& p, int wv, int l, int bid, int nb) {
    const int tid = TIDX();
    const bool need_ctx = (l != DEPTH - 1);
    for (int it = bid * NT + tid; it < BATCH * 256; it += nb * NT) {
        const int b = it >> 8, h = (it >> 6) & 3, e = it & 63;
        for (int dir = 0; dir < 2; ++dir) {
            float dec = p.in[I_RET_DECAY][(l * 2 + dir) * 4 + h];
            float g = expf(log_sigmoid_f(dec));
            float S[64];
            for (int d = 0; d < 64; ++d) S[d] = 0.f;
            for (int step = 0; step < CTXL + SEQ; ++step) {
                bool isctx; const int row = scan_row(b, dir, step, isctx);
                const act_t* pr = p.proj + (long)row * PROJ_W;
                float v = a2f(pr[O_RV + h * 64 + e]);
                float o = 0.f;
                for (int d = 0; d < 64; ++d) {
                    float k = a2f(pr[O_RK + h * 64 + d]);
                    float q = a2f(pr[O_RQ + h * 64 + d]);
                    S[d] = g * S[d] + k * v;
                    o += q * S[d];
                }
                if (!isctx || need_ctx) {
                    float* dst = p.osum + (long)row * 256 + h * 64 + e;
                    if (dir == 0) *dst = o; else *dst += o;
                }
            }
        }
    }
}
__device__ __forceinline__ void st_scan_gla(const Params& p, int wv, int l, int bid, int nb) {
    const int tid = TIDX();
    const bool need_ctx = (l != DEPTH - 1);
    for (int it = bid * NT + tid; it < BATCH * 256; it += nb * NT) {
        const int b = it >> 8, h = (it >> 6) & 3, e = it & 63;
        for (int dir = 0; dir < 2; ++dir) {
            float S[32];
            for (int d = 0; d < 32; ++d) S[d] = 0.f;
            for (int step = 0; step < CTXL + SEQ; ++step) {
                bool isctx; const int row = scan_row(b, dir, step, isctx);
                const act_t* pr = p.proj + (long)row * PROJ_W;
                const float* la = p.loga + (long)row * 256 + dir * 128 + h * 32;
                float v = a2f(pr[O_GV + h * 64 + e]);
                float o = 0.f;
                for (int d = 0; d < 32; ++d) {
                    float k = a2f(pr[O_GK + h * 32 + d]);
                    float q = a2f(pr[O_GQ + h * 32 + d]);
                    S[d] = expf(la[d]) * S[d] + k * v;
                    o += q * S[d];
                }
                if (!isctx || need_ctx) {
                    float* dst = p.osum + (long)row * 256 + h * 64 + e;
                    if (dir == 0) *dst = o; else *dst += o;
                }
            }
        }
    }
}
__device__ __forceinline__ void st_scan_s5(const Params& p, int wv, unsigned char* lds, int l, int bid, int nb) {
    const bool need_ctx = (l != DEPTH - 1);
    float* sh = (float*)lds;
    const int tid = TIDX(), gl = tid >> 6, n = tid & 63;
    float* hsh = sh + gl * 128;
    for (int blk = bid; blk < BATCH * 2; blk += nb) {
        const int b = blk >> 1, g = (blk & 1) * 8 + gl;
        for (int dir = 0; dir < 2; ++dir) {
            const int pg = (l * 2 + dir) * 16 + g;
            const float* tb = p.s5tab + ((size_t)pg * 64 + n) * 34;
            float bbr[16], bbi[16];
            for (int q = 0; q < 16; ++q) { bbr[q] = tb[2 + q]; bbi[q] = tb[18 + q]; }
            const float flr = tb[0], fli = tb[1];
            const float* cre = p.in[I_S5_C_RE] + ((long)pg * 16 + (n & 15)) * 64;
            const float* cim = p.in[I_S5_C_IM] + ((long)pg * 16 + (n & 15)) * 64;
            float hr = 0.f, hi = 0.f;
            for (int step = 0; step < CTXL + SEQ; ++step) {
                bool isctx; const int row = scan_row(b, dir, step, isctx);
                const act_t* uu = p.proj + (long)row * PROJ_W + O_SU + g * 16;
                float br = 0.f, bi = 0.f;
                for (int q = 0; q < 16; ++q) { float uv = a2f(uu[q]); br += bbr[q] * uv; bi += bbi[q] * uv; }
                float nr = flr * hr - fli * hi + br;
                float ni = flr * hi + fli * hr + bi;
                hr = nr; hi = ni;
                hsh[n] = hr; hsh[64 + n] = hi;
                __syncthreads();
                if (n < 16 && (!isctx || need_ctx)) {
                    float yv = 0.f;
                    for (int m = 0; m < 64; ++m) yv += cre[m] * hsh[m] - cim[m] * hsh[64 + m];
                    float* dst = p.osum + (long)row * 256 + g * 16 + n;
                    if (dir == 0) *dst = yv; else *dst += yv;
                }
                __syncthreads();
            }
        }
    }
}
__device__ __forceinline__ void st_finish(const Params& p, int wv, int l, int which) {
    const int tid = TIDX(), wave = tid >> 6, lane = tid & 63;
    const int nrows = (l == DEPTH - 1) ? NLAT : NTOK;
    for (int base = BIDX() * NW; base < nrows; base += NBLK() * NW) {
        const int row = base + wave;
        const act_t* pr = p.proj + (long)row * PROJ_W;
        for (int h = 0; h < 4; ++h) {
            int c = h * 64 + lane;
            float* op = p.osum + (long)row * 256 + c;
            float o = *op;
            if (which == 0) {
                float mu = wave_sum(o) * (1.0f / 64.0f);
                float d = o - mu;
                float var = wave_sum(d * d) * (1.0f / 64.0f);
                float yv = d * (1.0f / sqrtf(var + LN_EPS)) * p.in[I_RET_GN_G][l * 256 + c] + p.in[I_RET_GN_B][l * 256 + c];
                p.mix[(long)row * DM + c] = f2a(yv * silu_f(a2f(pr[O_RG + c])));
            } else if (which == 1) {
                float ms = wave_sum(o * o) * (1.0f / 64.0f);
                float yv = o * (1.0f / sqrtf(ms + LN_EPS)) * p.in[I_GLA_NORM_G][l * 256 + c];
                p.mix[(long)row * DM + 256 + c] = f2a(yv * silu_f(a2f(pr[O_GR + c])));
            } else {
                float yv = o + p.in[I_S5_D][l * 256 + c] * a2f(pr[O_SU + c]);
                *op = gelu_tanh_f(yv);
            }
        }
    }
}

#ifdef EMU
#define PHASE(call) emu_launch(EMU_GRID, NT, [&]() { unsigned char* lds = emu_lds(); (void)lds; call; })
#else
#define PHASE(call) do { call; GRID_BAR(); } while (0)
#endif

#ifndef PHMASK
#define PHMASK 0xffffffffu
#endif
#ifndef PREFIX_K
#define PREFIX_K 0
#endif
#define PHASEN(i, call) do { if (((PHMASK >> (i)) & 1u) && (KSTOP == 0 || ((i) < 3 ? (i) : 3 + 20 * lcur_ + ((i) - 3)) <= KSTOP)) PHASE(call); } while (0)
#ifndef DUPSEL
#define DUPSEL 0
#endif
#ifndef DUPN
#define DUPN 3
#endif
#define ROT(o) ((bidx + (o)) % nbk)
#define REP(k, call) do { call; if (DUPSEL == (k)) for (int _r = 0; _r < DUPN; ++_r) { call; } } while (0)
#ifdef EMU
static const int KSTOP = 0;
static void forward(const Params& p)
#else
template <int KSTOP> __global__ void __launch_bounds__(NT, 2) fwd_megakernel(Params p)
#endif
{
#ifndef EMU
    extern __shared__ __attribute__((aligned(16))) unsigned char lds[];
    {
        volatile LAS unsigned* misc = (volatile LAS unsigned*)((LAS unsigned char*)lds + LDS_MISC);
        if (threadIdx.x < 64) misc[threadIdx.x] = 0u;
        __syncthreads();
    }
    (void)xcd_barrier_post(p.ctl, (volatile LAS unsigned*)((LAS unsigned char*)lds + LDS_MISC) + 8);
    const int wv = __builtin_amdgcn_readfirstlane(threadIdx.x >> 6);
#define nbk NBLK()
#define bidx BIDX()
#else
    const int nbk = EMU_GRID; const int wv = 0; (void)wv;
#define bidx ((int)blockIdx.x)
#endif
    int lcur_ = 0;
    PHASEN(1, REP(1, st_prep(p, wv, lds)));
    PHASEN(2, REP(2, (st_prep2(p, wv), st_ln(p, wv, lds, 0, 0), st_s5_tables(p, wv, 0, bidx, nbk), st_hy_taps(p, wv, lds, 0, bidx, nbk))));
#pragma unroll 1
    for (int l = 0; l < DEPTH; ++l) {
        lcur_ = l;
        PHASEN(3, REP(3, st_gemm<G_PROJ>(p, wv, lds, l, 0)));
        PHASEN(4, { REP(4, st_ret_a(p, wv, lds, l, ROT(0), nbk)); REP(5, st_gla_a(p, wv, lds, l, ROT(128), nbk)); REP(6, st_s5_a(p, wv, lds, l, ROT(64), nbk)); REP(7, st_hy_spec(p, wv, lds, l, bidx, nbk)); REP(8, st_hy_pre(p, wv, lds, l, bidx, nbk)); if (l == 0) st_hy_ctx_pre(p, wv, l, bidx, nbk); });
        PHASEN(5, (st_ret_b(p, wv, l, bidx, nbk), st_gla_b(p, wv, l, bidx, nbk), st_s5_b(p, wv, l, bidx, nbk)));
        PHASEN(6, { REP(9, st_ret_c(p, wv, lds, l, ROT(0), nbk)); REP(10, st_gla_c(p, wv, lds, l, ROT(160), nbk)); REP(11, st_s5_c(p, wv, lds, l, ROT(192), nbk)); st_hy_fft(p, wv, lds, l, bidx, nbk); if (l == 0) st_hy_ctx_conv(p, wv, l, bidx, nbk); });
        PHASEN(10, { REP(12, st_hy_post(p, wv, lds, l, bidx, nbk)); REP(13, st_glu2(p, wv, lds, l, bidx, nbk)); });
        PHASEN(11, REP(14, st_gemm<G_OUT>(p, wv, lds, l, 0)));
        if ((l & 1) == 0) {
            PHASEN(12, st_ln(p, wv, lds, l, 1));
            PHASEN(13, REP(15, st_gemm<G_FFN1>(p, wv, lds, l, 0)));
            PHASEN(14, REP(16, st_gemm<G_FFN2>(p, wv, lds, l, 0)));
        } else {
            PHASEN(15, { st_ln(p, wv, lds, l, 1); REP(19, st_convert_items(p, wv, lds, 1)); });
            PHASEN(17, st_place(p, wv, lds));
#pragma unroll 1
            for (int ps = 0; ps < MOE_NPASS; ++ps) {
                PHASEN(18, REP(17, st_gemm<G_MFFN1>(p, wv, lds, l, ps)));
                PHASEN(19, REP(18, st_gemm<G_MFFN2>(p, wv, lds, l, ps)));
            }
        }
        PHASEN(20, (st_ln(p, wv, lds, l, 2), (l + 1 < DEPTH ? (st_s5_tables(p, wv, l + 1, bidx, nbk), st_hy_taps(p, wv, lds, l + 1, bidx, nbk)) : (void)0)));
        if (DUPSEL == 20) for (int _r = 0; _r < 10; ++_r) { PHASE((void)0); }
    }
}

static inline size_t align_up(size_t v, size_t a) { return (v + a - 1) / a * a; }
#ifdef EMU
Params g_dbg_params;
#endif

extern "C" void kernel_launch(void* const* d_in, const int* in_sizes, int n_in, void* d_out, int out_size, void* d_ws,
                              size_t ws_size, hipStream_t stream) {
    Params p{};
    for (int i = 0; i < N_IN; ++i) p.in[i] = (const float*)d_in[i];
    p.out = (float*)d_out;
    char* ws = (char*)d_ws;
    size_t off = 0;
    auto take = [&](size_t bytes) { char* r = ws + off; off = align_up(off + bytes, 256); return r; };
    const size_t A = sizeof(act_t);
    p.ctl = (unsigned*)take(CTL_WORDS * 4);
    const size_t big_a = (size_t)NTOK * PROJ_W * A + (size_t)NTOK * 256 * A;
    const size_t big_b = (size_t)NEXP * 3 * DM * DFF * A + (size_t)MOE_PT * 256 * DFF * A;
    const size_t big_c = big_a + (size_t)2 * 16 * 1024 * 256 * A;
    char* big = take(big_c > big_b ? big_c : big_b);
    p.proj = (act_t*)big;
    p.hz = (act_t*)(big + (size_t)NTOK * PROJ_W * A);
    p.wmoe13 = (act_t*)big;
    p.wmoe2 = p.wmoe13 + (size_t)NEXP * 2 * DFF * DM;
    p.hch = p.wmoe2 + (size_t)NEXP * DM * DFF;
    p.u = (act_t*)take((size_t)NTOK * DM * A > (size_t)NTOK * DM * 2 ? (size_t)NTOK * DM * A : (size_t)NTOK * DM * 2);
    p.retD = (float*)p.u;
    p.glaD = p.retD + (size_t)NTOK * 256;
    p.glaE = (float*)take((size_t)BATCH * 4 * 2 * ((CTXL + SEQ) / 64) * 32 * 4);
    char* mixr = take((size_t)NTOK * DM * A + (size_t)2 * NTOK * 256 * 4);
    p.mix = (act_t*)mixr;
    p.osum = (float*)(mixr + (size_t)NTOK * DM * A);
    p.gbuf = (act_t*)p.osum;
    p.loga = p.osum + (size_t)NTOK * 256;
    p.ys = (act_t*)mixr;
    p.win_t = (act_t*)take((size_t)DEPTH * NPROJ_T * DM * A);
    p.wout_t = (act_t*)take((size_t)DEPTH * DM * DM * A);
    p.w13_t = (act_t*)take((size_t)2 * DFF * DM * A);
    p.w2_t = (act_t*)take((size_t)DM * DFF * A);
    p.wglu_t = (act_t*)take((size_t)DEPTH * 256 * 256 * A);
    p.mod = (float*)take((size_t)DEPTH * (BATCH + 1) * 6 * DM * 4);
    p.hctx = (float*)take((size_t)NCTX * DM * 4);
    p.filt = (float*)take((size_t)DEPTH * FILT_LAYER_FLOATS * 4);
    p.fnorm = (float*)take((size_t)DEPTH * 256 * 4);
    p.hdn2 = (float*)take((size_t)DEPTH * SEQ * 64 * 4);
    p.fft_tw = (float*)take((size_t)FN * 2 * 4);
    p.hspec = (float*)take((size_t)256 * FN * 2 * 4);
    p.rot = (float*)take((size_t)SEQ * 32 * 2 * 4);
    p.s5tab = (float*)take((size_t)DEPTH * 2 * 16 * 64 * 34 * 4);
    p.s5pw = (float*)take((size_t)DEPTH * 2 * 16 * 65 * 64 * 2 * 4);
    p.s5Tc = (act_t*)take((size_t)16 * 127 * 256 * A);
    p.s5S = (float*)take((size_t)BATCH * 16 * 2 * ((CTXL + SEQ) / 64) * 128 * 4);
    p.s5Win = (act_t*)(big + big_a);
    p.s5Wend = p.s5Win + (size_t)16 * 1024 * 256;
    p.tok_e = (int*)take((size_t)NLAT * 2 * 4);
    p.tok_g = (float*)take((size_t)NLAT * 2 * 4);
    p.slot_asg = (int*)take((size_t)MOE_CAP * 4);
#ifdef EMU
    g_dbg_params = p;
    memset(p.ctl, 0, CTL_WORDS * 4);
    forward(p);
#else
    if (off > ws_size) return;
    static int grid_blocks = 0;
    if (!grid_blocks) {
        int dev = 0, cus = 0;
        (void)hipGetDevice(&dev);
        (void)hipDeviceGetAttribute(&cus, hipDeviceAttributeMultiprocessorCount, dev);
        (void)hipFuncSetAttribute((const void*)fwd_megakernel<0>, hipFuncAttributeMaxDynamicSharedMemorySize, LDS_BYTES);
#if PREFIX_K > 0
        (void)hipFuncSetAttribute((const void*)fwd_megakernel<PREFIX_K>, hipFuncAttributeMaxDynamicSharedMemorySize, LDS_BYTES);
#endif
        grid_blocks = cus;
    }
#if PREFIX_K > 0
    (void)hipMemsetAsync(p.ctl, 0, CTL_WORDS * 4, stream);
    hipLaunchKernelGGL(fwd_megakernel<PREFIX_K>, dim3(grid_blocks), dim3(NT), LDS_BYTES, stream, p);
#endif
    (void)hipMemsetAsync(p.ctl, 0, CTL_WORDS * 4, stream);
    hipLaunchKernelGGL(fwd_megakernel<0>, dim3(grid_blocks), dim3(NT), LDS_BYTES, stream, p);
#endif
}
```

```cpp
#ifndef EMU
#include <hip/hip_runtime.h>
#endif
#include <stdint.h>
#include <math.h>

#ifndef BATCH
#define BATCH 8
#endif
#ifndef SEQ
#define SEQ 4096
#endif
#ifndef CTXL
#define CTXL 256
#endif
#define NT 512
#define NW 8
#define DM 1024
#define DEPTH 2
#define GRID_W 64
#define DPROJ_IN 2848
#define PROJ_W 2816
#define NPROJ_T 3072
#define DFF 2816
#define NEXP 8
#define NLAT (BATCH * SEQ)
#define NCTX (BATCH * CTXL)
#define NTOK (NLAT + NCTX)
#define MOE_CAP (2 * NLAT + NEXP * 256)
#define MOE_TILES (MOE_CAP / 256)
#ifndef MOE_PT
#define MOE_PT 128
#endif
#define MOE_NPASS ((MOE_TILES + MOE_PT - 1) / MOE_PT)
#define MOE_TAIL_T0 ((MOE_NPASS - 1) * MOE_PT)
#define MOE_TAIL_ROWS ((MOE_TILES - MOE_TAIL_T0) * 256)
#define KSPLIT 4
#define LN_EPS 1e-5f
#define ALPHA 1.4142135623730951f
#define O_RQ 0
#define O_RK 256
#define O_RV 512
#define O_RG 768
#define O_GQ 1024
#define O_GK 1152
#define O_GV 1280
#define O_GR 1536
#define O_SU 1792
#define O_HP 2048

enum { I_X, I_C, I_CTX, I_CCTX, I_ADA_W, I_ADA_B, I_W_IN, I_RET_DECAY, I_RET_GN_G, I_RET_GN_B, I_GLA_WA, I_GLA_BA,
       I_GLA_NORM_G, I_S5_LAM_RE, I_S5_LAM_IM, I_S5_LOG_DT, I_S5_B_RE, I_S5_B_IM, I_S5_C_RE, I_S5_C_IM, I_S5_D,
       I_S5_GLU_W, I_S5_GLU_B, I_HY_CONV_W, I_HY_CONV_B, I_HY_FW1, I_HY_FB1, I_HY_FREQ, I_HY_FW2, I_HY_FB2, I_HY_FW3,
       I_HY_DECAY, I_HY_BIAS, I_W_OUT, I_LN_MIX_G, I_LN_MIX_B, I_LN_FFN_G, I_LN_FFN_B, I_FFN_W1, I_FFN_W3, I_FFN_W2,
       I_ROUTER_W, I_ROUTER_B, I_MOE_W1, I_MOE_W3, I_MOE_W2, N_IN };

typedef float f32x4 __attribute__((ext_vector_type(4)));
typedef unsigned u32x4 __attribute__((ext_vector_type(4)));

#ifdef EMU_F32ACT
typedef float act_t;
__device__ __forceinline__ float a2f(act_t v) { return v; }
__device__ __forceinline__ act_t f2a(float f) { return f; }
#else
typedef unsigned short act_t;
__device__ __forceinline__ float a2f(act_t v) { union { unsigned u; float f; } c; c.u = ((unsigned)v) << 16; return c.f; }
#if defined(EMU)
__device__ __forceinline__ act_t f2a(float f) { union { unsigned u; float f; } c; c.f = f; unsigned u = c.u; u += 0x7fffu + ((u >> 16) & 1u); return (act_t)(u >> 16); }
#else
__device__ __forceinline__ unsigned pk_bf16(float lo, float hi) { unsigned r; asm("v_cvt_pk_bf16_f32 %0, %1, %2" : "=v"(r) : "v"(lo), "v"(hi)); return r; }
__device__ __forceinline__ act_t f2a(float f) { return (act_t)(pk_bf16(f, f) & 0xffffu); }
#endif
#endif
__device__ __forceinline__ void store8(act_t* p, const float* v) {
#if defined(EMU)
    for (int i = 0; i < 8; ++i) p[i] = f2a(v[i]);
#else
    u32x4 w;
    w.x = pk_bf16(v[0], v[1]); w.y = pk_bf16(v[2], v[3]); w.z = pk_bf16(v[4], v[5]); w.w = pk_bf16(v[6], v[7]);
    *(u32x4*)p = w;
#endif
}

__device__ __forceinline__ void copy8(act_t* dst, const act_t* src) {
#if defined(EMU)
    for (int i = 0; i < 8; ++i) dst[i] = src[i];
#else
    *(u32x4*)dst = *(const u32x4*)src;
#endif
}
__device__ __forceinline__ void load8f(float* v, const act_t* src) {
#if defined(EMU)
    for (int i = 0; i < 8; ++i) v[i] = a2f(src[i]);
#else
    const u32x4 w = *(const u32x4*)src;
    v[0] = __builtin_bit_cast(float, w.x << 16); v[1] = __builtin_bit_cast(float, w.x & 0xffff0000u);
    v[2] = __builtin_bit_cast(float, w.y << 16); v[3] = __builtin_bit_cast(float, w.y & 0xffff0000u);
    v[4] = __builtin_bit_cast(float, w.z << 16); v[5] = __builtin_bit_cast(float, w.z & 0xffff0000u);
    v[6] = __builtin_bit_cast(float, w.w << 16); v[7] = __builtin_bit_cast(float, w.w & 0xffff0000u);
#endif
}
__device__ __forceinline__ void store4(act_t* p, const float* v) {
#if defined(EMU)
    for (int i = 0; i < 4; ++i) p[i] = f2a(v[i]);
#else
    typedef unsigned u32x2 __attribute__((ext_vector_type(2)));
    u32x2 w; w.x = pk_bf16(v[0], v[1]); w.y = pk_bf16(v[2], v[3]);
    *(u32x2*)p = w;
#endif
}
__device__ __forceinline__ void ld4f(float* v, const float* src) {
#if defined(EMU)
    for (int i = 0; i < 4; ++i) v[i] = src[i];
#else
    const f32x4 a = *(const f32x4*)src; v[0] = a[0]; v[1] = a[1]; v[2] = a[2]; v[3] = a[3];
#endif
}
struct A8 {
#if defined(EMU)
    act_t v[8];
#else
    u32x4 w;
#endif
};
__device__ __forceinline__ A8 ld_a8(const act_t* src) {
    A8 r;
#if defined(EMU)
    for (int i = 0; i < 8; ++i) r.v[i] = src[i];
#else
    r.w = *(const u32x4*)src;
#endif
    return r;
}
__device__ __forceinline__ void st_a8(act_t* dst, const A8& a) {
#if defined(EMU)
    for (int i = 0; i < 8; ++i) dst[i] = a.v[i];
#else
    *(u32x4*)dst = a.w;
#endif
}
__device__ __forceinline__ void a8f(float* v, const A8& a) {
#if defined(EMU)
    for (int i = 0; i < 8; ++i) v[i] = a2f(a.v[i]);
#else
    v[0] = __builtin_bit_cast(float, a.w.x << 16); v[1] = __builtin_bit_cast(float, a.w.x & 0xffff0000u);
    v[2] = __builtin_bit_cast(float, a.w.y << 16); v[3] = __builtin_bit_cast(float, a.w.y & 0xffff0000u);
    v[4] = __builtin_bit_cast(float, a.w.z << 16); v[5] = __builtin_bit_cast(float, a.w.z & 0xffff0000u);
    v[6] = __builtin_bit_cast(float, a.w.w << 16); v[7] = __builtin_bit_cast(float, a.w.w & 0xffff0000u);
#endif
}
struct Params {
    const float* in[N_IN];
    float* out;
    unsigned* ctl;
    float* mod;
    act_t* proj;
    act_t* hz;
    act_t* wmoe13;
    act_t* wmoe2;
    act_t* hch;
    act_t* u;
    float* retD;
    float* glaD;
    float* glaE;
    act_t* mix;
    float* osum;
    act_t* gbuf;
    act_t* wglu_t;
    float* loga;
    act_t* ys;
    act_t* win_t;
    act_t* wout_t;
    act_t* w13_t;
    act_t* w2_t;
    float* hctx;
    float* filt;
    float* fnorm;
    float* hdn2;
    float* fft_tw;
    float* hspec;
    float* rot;
    float* s5tab;
    float* s5pw;
    act_t* s5Tc;
    act_t* s5Win;
    act_t* s5Wend;
    float* s5S;
    int* tok_e;
    float* tok_g;
    int* slot_asg;
    int* tok_slot;
    int* tail_asg;
    float* tail_g;
    act_t* pbuf_d;
    act_t* pbuf_m;
};
#define CTL_MOE 4096
#define CTL_WORDS 4224
#define FILT_LAYER_FLOATS (2 * CTXL * 256)
#define FN (2 * SEQ)
#if SEQ == 4096
#define FLOG 13
#elif SEQ == 512
#define FLOG 10
#elif SEQ == 256
#define FLOG 9
#endif

#define LDS_RING 131072
#define LDS_BYTES 147456
#define LDS_MISC (LDS_BYTES - 256)
#ifdef EMU
#define GRID_BAR()
#else
#define LAS __attribute__((address_space(3)))
#define XB_TMO      128
#define XB_XCNT(j)  (256  + 64 * (j))
#define XB_XSUB(j)  (1280 + 64 * (j))
#define XB_XGEN(j)  (2304 + 64 * (j))
#define XB_TOP      3328
#define XB_TOPGEN   3392
#define XCD_BAR_WORDS 3456
#define XB_SPIN_CAP (1u << 26)
__device__ __forceinline__ unsigned xb_ld(unsigned* p)              { return __hip_atomic_load(p, __ATOMIC_RELAXED, __HIP_MEMORY_SCOPE_AGENT); }
__device__ __forceinline__ unsigned xb_add(unsigned* p, unsigned v) { return __hip_atomic_fetch_add(p, v, __ATOMIC_RELAXED, __HIP_MEMORY_SCOPE_AGENT); }
__device__ __forceinline__ unsigned xb_xcc_id() { return (unsigned)__builtin_amdgcn_s_getreg((3 << 11) | 20) & 0xFu; }
#define XB_SPIN(cond, bar) do { unsigned _sp = 0; while (cond) { __builtin_amdgcn_s_sleep(1); \
    if ((++_sp & 255u) == 0u) { if (xb_ld(&(bar)[XB_TMO])) break; if (_sp > XB_SPIN_CAP) { atomicAdd(&(bar)[XB_TMO], 1u); break; } } } } while (0)
struct XcdBarrier { unsigned* bar; unsigned x; volatile LAS unsigned* st; };
__device__ __forceinline__ XcdBarrier xcd_barrier_post(unsigned* bar, volatile LAS unsigned* st) {
    XcdBarrier b; b.bar = bar; b.x = xb_xcc_id(); b.st = st;
    if (threadIdx.x == 0) (void)xb_add(&bar[XB_XCNT(b.x)], 1u);
    return b;
}
__device__ __forceinline__ void xcd_barrier_complete(unsigned* bar, unsigned x, unsigned& nloc, unsigned& nx) {
    const unsigned G = gridDim.x * gridDim.y * gridDim.z;
    unsigned sum, cnt, mine, sp = 0u;
    for (;;) {
        sum = 0u; cnt = 0u; mine = 0u;
#pragma unroll
        for (unsigned j = 0; j < 16; ++j) { const unsigned c = xb_ld(&bar[XB_XCNT(j)]); sum += c; cnt += (c > 0u) ? 1u : 0u; mine = (j == x) ? c : mine; }
        if (sum == G) break;
        __builtin_amdgcn_s_sleep(1);
        if ((++sp & 255u) == 0u) { if (xb_ld(&bar[XB_TMO])) break; if (sp > XB_SPIN_CAP) { atomicAdd(&bar[XB_TMO], 1u); break; } }
    }
    nloc = mine > 0u ? mine : 1u; nx = cnt > 0u ? cnt : 1u;
}
__device__ __forceinline__ void xcd_barrier(const XcdBarrier& b) {
    asm volatile("s_waitcnt vmcnt(0)" ::: "memory");
    __syncthreads();
    if (threadIdx.x == 0) {
        unsigned* bar = b.bar;
        __builtin_amdgcn_s_waitcnt(0);
        unsigned nloc = b.st[0], nx = b.st[1];
        if (nloc == 0u) { xcd_barrier_complete(bar, b.x, nloc, nx); b.st[0] = nloc; b.st[1] = nx; }
        const unsigned old = xb_add(&bar[XB_XSUB(b.x)], 1u);
        const unsigned gen = old / nloc;
        if (old + 1u == (gen + 1u) * nloc) {
            __builtin_amdgcn_fence(__ATOMIC_RELEASE, "agent");
            asm volatile("s_waitcnt vmcnt(0)" ::: "memory");
            const unsigned og = xb_add(&bar[XB_TOP], 1u);
            const unsigned tg = og / nx;
            if (og + 1u == (tg + 1u) * nx) xb_add(&bar[XB_TOPGEN], 1u);
            else XB_SPIN(xb_ld(&bar[XB_TOPGEN]) == tg, bar);
            __builtin_amdgcn_fence(__ATOMIC_ACQUIRE, "agent");
            xb_add(&bar[XB_XGEN(b.x)], 1u);
            asm volatile("s_waitcnt vmcnt(0)" ::: "memory");
        } else {
            XB_SPIN(xb_ld(&bar[XB_XGEN(b.x)]) == gen, bar);
            __builtin_amdgcn_fence(__ATOMIC_ACQUIRE, "agent");
            asm volatile("s_waitcnt vmcnt(0)" ::: "memory");
        }
    }
    __syncthreads();
}
#define GRID_BAR() do { XcdBarrier _b; _b.bar = p.ctl; _b.x = xb_xcc_id(); _b.st = (volatile LAS unsigned*)((LAS unsigned char*)lds + LDS_MISC) + 8; xcd_barrier(_b); } while (0)
#endif

#ifdef EMU
#define TIDX() ((int)threadIdx.x)
#define BIDX() ((int)blockIdx.x)
#define NBLK() ((int)gridDim.x)
#else
#define BIDX() bid_opaque()
#define NBLK() nblk_opaque()
__device__ __forceinline__ int tid_opaque(int wv) { int t; asm volatile("v_mbcnt_lo_u32_b32 %0, -1, 0\n\tv_mbcnt_hi_u32_b32 %0, -1, %0\n\tv_lshl_add_u32 %0, %1, 6, %0" : "=&v"(t) : "s"(wv)); return t; }
#define TIDX() tid_opaque(wv)
__device__ __forceinline__ int bid_opaque() { int t = blockIdx.x; asm volatile("" : "+s"(t)); return t; }
__device__ __forceinline__ int nblk_opaque() { int t = gridDim.x; asm volatile("" : "+s"(t)); return t; }
#endif
#ifdef EMU
__device__ __forceinline__ float wave_sum(float v) {
    for (int o = 32; o > 0; o >>= 1) v += __shfl_xor(v, o);
    return v;
}
__device__ __forceinline__ float quad_sum(float v) { v += __shfl_xor(v, 1); v += __shfl_xor(v, 2); return v; }
__device__ __forceinline__ float oct_sum(float v) { v += __shfl_xor(v, 1); v += __shfl_xor(v, 2); v += __shfl_xor(v, 4); return v; }
#else
__device__ __forceinline__ float wave_sum(float v) {
#define WS_DPP(ctrl) v += __builtin_bit_cast(float, __builtin_amdgcn_update_dpp(0, __builtin_bit_cast(int, v), (ctrl), 0xf, 0xf, false))
    WS_DPP(0xB1); WS_DPP(0x4E); WS_DPP(0x141); WS_DPP(0x140);
#undef WS_DPP
    v += __builtin_bit_cast(float, __builtin_amdgcn_update_dpp(0, __builtin_bit_cast(int, v), 0x142, 0xa, 0xf, false));
    v += __builtin_bit_cast(float, __builtin_amdgcn_update_dpp(0, __builtin_bit_cast(int, v), 0x143, 0xc, 0xf, false));
    return __builtin_bit_cast(float, __builtin_amdgcn_readlane(__builtin_bit_cast(int, v), 63));
}
__device__ __forceinline__ float quad_sum(float v) {
#define WS_DPP(ctrl) v += __builtin_bit_cast(float, __builtin_amdgcn_update_dpp(0, __builtin_bit_cast(int, v), (ctrl), 0xf, 0xf, false))
    WS_DPP(0xB1); WS_DPP(0x4E);
    return v;
}
__device__ __forceinline__ float oct_sum(float v) {
    WS_DPP(0xB1); WS_DPP(0x4E); WS_DPP(0x141);
#undef WS_DPP
    return v;
}
#endif
__device__ __forceinline__ float silu_f(float x) { return x / (1.0f + expf(-x)); }
__device__ __forceinline__ float sigmoid_f(float x) { return 1.0f / (1.0f + expf(-x)); }
__device__ __forceinline__ float log_sigmoid_f(float x) { return fminf(x, 0.0f) - log1pf(expf(-fabsf(x))); }
#ifdef EMU
__device__ __forceinline__ float exp_fast(float x) { return expf(x); }
__device__ __forceinline__ float silu_fast(float x) { return x / (1.0f + expf(-x)); }
#else
__device__ __forceinline__ float exp_fast(float x) { return __expf(x); }
__device__ __forceinline__ float silu_fast(float x) { return x * __builtin_amdgcn_rcpf(1.0f + __expf(-x)); }
#endif
__device__ __forceinline__ float sigmoid_fast(float x) {
#ifdef EMU
    return 1.0f / (1.0f + expf(-x));
#else
    return __builtin_amdgcn_rcpf(1.0f + __expf(-x));
#endif
}
__device__ __forceinline__ float gelu_fast(float x) { return x * sigmoid_fast(2.0f * 0.7978845608028654f * (x + 0.044715f * x * x * x)); }
#ifdef EMU
#define EPI_FENCE()
__device__ __forceinline__ float log_sigmoid_fast(float x) { return log_sigmoid_f(x); }
#else
#define EPI_FENCE() asm volatile("" ::: "memory")
__device__ __forceinline__ float log_sigmoid_fast(float x) { return fminf(x, 0.0f) - __logf(1.0f + __expf(-fabsf(x))); }
#endif
__device__ __forceinline__ float gelu_tanh_f(float x) {
    return 0.5f * x * (1.0f + tanhf(0.7978845608028654f * (x + 0.044715f * x * x * x)));
}
__device__ __forceinline__ void ln_stats16(const float* v, float& mu, float& rstd) {
    float s = 0.f;
    for (int i = 0; i < 16; ++i) s += v[i];
    s = wave_sum(s);
    mu = s * (1.0f / DM);
    float q = 0.f;
    for (int i = 0; i < 16; ++i) { float d = v[i] - mu; q += d * d; }
    q = wave_sum(q);
    rstd = 1.0f / sqrtf(q * (1.0f / DM) + LN_EPS);
}
__device__ __forceinline__ int row_modidx(int row) { return row < NLAT ? row / SEQ : BATCH; }

struct Unit { int pm, pn; };
struct Gemm { const act_t* A; const act_t* Bt; int M, N, K; const int* rowmap; int Kl = 0; };
#define GBM 256
#define GNXCD 8
#define GWGM 8
struct StaticOrder {
    int nM, nN, nwg, G, c;
    __device__ void init(int M, int N, int G_, int c_) { nM = M / GBM; nN = N / GBM; nwg = nM * nN; G = G_; c = c_; }
    __device__ bool next(int i, Unit& u) const {
        const long L = (long)i * G + c; if (L >= nwg) return false;
        int wgid = (int)L; { const int q = nwg / GNXCD, r = nwg % GNXCD, xcd = wgid % GNXCD, off = wgid / GNXCD; wgid = (xcd < r ? xcd * (q + 1) : r * (q + 1) + (xcd - r) * q) + off; }
        const int nig = GWGM * nN, gid = wgid / nig, fm = gid * GWGM, gsz = (nM - fm) < GWGM ? (nM - fm) : GWGM;
        u.pm = fm + ((wgid % nig) % gsz); u.pn = (wgid % nig) / gsz; return true;
    }
    __device__ __forceinline__ const act_t* b_base(const Unit& u, const Gemm& g) const { return g.Bt + (size_t)u.pn * GBM * g.K; }
};
struct MoeOrder {
    StaticOrder so; int t0; int pend[NEXP]; size_t estride;
    __device__ bool next(int i, Unit& u) const { if (!so.next(i, u)) return false; u.pm += t0; return true; }
    __device__ __forceinline__ const act_t* b_base(const Unit& u, const Gemm& g) const {
        int e = 0;
#pragma unroll
        for (int q = 0; q < NEXP - 1; ++q) e += (u.pm * 256 >= pend[q]) ? 1 : 0;
        return g.Bt + (size_t)e * estride + (size_t)u.pn * GBM * g.K;
    }
};

template <class Epi, class Sched, bool GATHER>
__device__ __forceinline__ void gemm_phase_ref(int wv, const Gemm g, const Sched& S, const Epi& E) {
    const int tid = TIDX(), wid = tid >> 6, lane = tid & 63, wr = wid >> 2, wc = wid & 3, fr = lane & 15, fq = lane >> 4;
    Unit cur;
    for (int ui = 0; S.next(ui, cur); ++ui) {
        f32x4 acc[2][2][4][2];
        const act_t* Bt = S.b_base(cur, g);
        _Pragma("unroll") for (int ai = 0; ai < 2; ++ai) _Pragma("unroll") for (int bj = 0; bj < 2; ++bj) _Pragma("unroll") for (int m = 0; m < 4; ++m) _Pragma("unroll") for (int n = 0; n < 2; ++n) _Pragma("unroll") for (int j = 0; j < 4; ++j) {
            int r = cur.pm * 256 + ai * 128 + wr * 64 + m * 16 + fr;
            int cl = Epi::PERM ? (bj * 128 + wc * 32 + 8 * fq + 4 * n + j) : (bj * 128 + wc * 32 + 16 * n + 4 * fq + j);
            long ar = r;
            if (GATHER) { int a = g.rowmap[r]; ar = a >= 0 ? (a >> 1) : 0; }
            const act_t* ap = g.A + ar * g.K; const act_t* bp = Bt + (long)cl * g.K;
            float s = 0.f;
            const int KL = g.Kl ? g.Kl : g.K;
            _Pragma("unroll 4") for (int k = 0; k < KL; ++k) s += a2f(ap[k]) * a2f(bp[k]);
            acc[ai][bj][m][n][j] = s;
        }
        E(acc, cur, wr, wc, fr, fq);
    }
}
#ifdef EMU
template <class Epi, class Sched, bool GATHER>
void gemm_phase(unsigned char*, int wv, const Gemm g, const Sched& S, const Epi& E) { gemm_phase_ref<Epi, Sched, GATHER>(wv, g, S, E); }
#else
namespace pg8 {
#define PG8_LAS __attribute__((address_space(3)))
typedef short bf16x8 __attribute__((ext_vector_type(8)));
constexpr int BM = 256, BK = 64, HALF = 128, HTB = HALF * BK * 2, STAGE_BYTES = 8 * HTB;
__device__ __forceinline__ int lds_byte(int r, int c) { const int st = (r >> 4) * 2 + (c >> 5), rr = r & 15, cc = c & 31, ob = rr * 64 + cc * 2; return st * 1024 + (ob ^ (((ob >> 9) & 1) << 5)); }
__device__ __forceinline__ void stage_rc(int b, int& R, int& C) { const int st = b / 1024, sb = b % 1024, swz = sb ^ (((sb >> 9) & 1) << 5); R = (st >> 1) * 16 + swz / 64; C = (st & 1) * 32 + (swz % 64) / 2; }
__device__ __forceinline__ int perm32(int rho) { const int n = rho >> 4, i = rho & 15; return 8 * (i >> 2) + 4 * n + (i & 3); }
template <class Epi, class Sched, bool GATHER>
__device__ __forceinline__ void gemm_phase(PG8_LAS unsigned char* lds, int wv, const Gemm g, const Sched& S, const Epi& E) {
    const int tid = TIDX(), wid = __builtin_amdgcn_readfirstlane(tid >> 6), lane = tid & 63, wr = wid >> 2, wc = wid & 3, fr = lane & 15, fq = lane >> 4;
    const int K = g.K, nt = (g.Kl ? g.Kl : K) / BK;
    unsigned voffA[2], voffB[2];
    unsigned gc0[2], gc1[2], gn0[2], gn1[2];
    int sR[2], sC[2];
#pragma unroll
    for (int i = 0; i < 2; ++i) { int R, C; stage_rc(tid * 16 + i * 8192, R, C); sR[i] = R; sC[i] = C; const int Rb = Epi::PERM ? ((R & ~31) + perm32(R & 31)) : R;
        voffA[i] = (unsigned)(R * K + C) * 2u; voffB[i] = (unsigned)(Rb * K + C) * 2u; }
    const size_t kstep = (size_t)(BK * 2);
    const size_t hstep = (size_t)HALF * K * 2;
    const size_t tstep = 2 * hstep;
    const unsigned ldsw = (unsigned)wid * 1024u;
    const int aoff = lds_byte(wr * 64 + fr, fq * 8), boff = lds_byte(wc * 32 + fr, fq * 8);
    auto g_offs = [&](const Unit& u, unsigned (&o0)[2], unsigned (&o1)[2]) {
#pragma unroll
        for (int i = 0; i < 2; ++i) {
            const int a0 = g.rowmap[u.pm * BM + sR[i]], a1 = g.rowmap[u.pm * BM + HALF + sR[i]];
            const int r0 = a0 >= 0 ? (a0 >> 1) : 0, r1 = a1 >= 0 ? (a1 >> 1) : 0;
            o0[i] = (unsigned)(r0 * K + sC[i]) * 2u; o1[i] = (unsigned)(r1 * K + sC[i]) * 2u;
        }
    };
#define PG8_SA(b, h) (((b) * 2 + (h)) * HTB)
#define PG8_SB(b, h) ((4 + (b) * 2 + (h)) * HTB)
#define PG8_STAGE(bufoff, gbase, voff) do { _Pragma("unroll") for (int _i = 0; _i < 2; ++_i) { unsigned _o = (voff)[_i]; if (GATHER) asm volatile("" : "+v"(_o)); \
        __builtin_amdgcn_global_load_lds((const unsigned*)((const char*)(gbase) + _o), (PG8_LAS unsigned*)(lds + (bufoff) + ldsw + _i * 8192), 16, 0, 0); } } while (0)
#define PG8_STAGE_A(bufoff, h, tile, koff, o0, o1) do { if constexpr (GATHER) { if (h) PG8_STAGE(bufoff, gA + (koff), o1); else PG8_STAGE(bufoff, gA + (koff), o0); } \
        else PG8_STAGE(bufoff, (tile) + (koff) + (h) * hstep, voffA); } while (0)
#define PG8_LDA(dst, b, h) do { _Pragma("unroll") for (int m = 0; m < 4; ++m) _Pragma("unroll") for (int k = 0; k < 2; ++k) dst[m][k] = *(const PG8_LAS bf16x8*)(lds + PG8_SA(b, h) + aoff + m * 2048 + k * 1024); } while (0)
#define PG8_LDB(dst, b, h) do { _Pragma("unroll") for (int n = 0; n < 2; ++n) _Pragma("unroll") for (int k = 0; k < 2; ++k) dst[n][k] = *(const PG8_LAS bf16x8*)(lds + PG8_SB(b, h) + boff + n * 2048 + k * 1024); } while (0)
#define PG8_MMA(ai, bj, At, Bt) do { __builtin_amdgcn_s_setprio(1); _Pragma("unroll") for (int m = 0; m < 4; ++m) _Pragma("unroll") for (int n = 0; n < 2; ++n) _Pragma("unroll") for (int k = 0; k < 2; ++k) \
        acc[ai][bj][m][n] = __builtin_amdgcn_mfma_f32_16x16x32_bf16(Bt[n][k], At[m][k], acc[ai][bj][m][n], 0, 0, 0); __builtin_amdgcn_s_setprio(0); } while (0)
#define PG8_WAIT_V(n) asm volatile("s_waitcnt vmcnt(" #n ")" ::: "memory")
#define PG8_WAIT_L(n) asm volatile("s_waitcnt lgkmcnt(" #n ")" ::: "memory")
#define PG8_BAR __builtin_amdgcn_s_barrier()
#define PG8_SCHED __builtin_amdgcn_sched_barrier(0)
    Unit cur, nxt; int ui = 0;
    if (!S.next(0, cur)) return;
    float zf = 0.f; asm volatile("" : "+v"(zf));
    f32x4 acc[2][2][4][2];
#pragma unroll
    for (int a = 0; a < 2; ++a)
#pragma unroll
        for (int b = 0; b < 2; ++b)
#pragma unroll
            for (int m = 0; m < 4; ++m)
#pragma unroll
                for (int n = 0; n < 2; ++n) acc[a][b][m][n] = (f32x4){zf, zf, zf, zf};
    bf16x8 At[4][2], B0[2][2], B1[2][2];
    const char* gA = (const char*)g.A;
    const char* cA = gA + (size_t)cur.pm * tstep;
    const char* cB = (const char*)S.b_base(cur, g);
    if constexpr (GATHER) g_offs(cur, gc0, gc1);
    {
        PG8_STAGE(PG8_SB(0, 0), cB, voffB); PG8_STAGE(PG8_SB(0, 1), cB + hstep, voffB); PG8_STAGE_A(PG8_SA(0, 0), 0, cA, 0, gc0, gc1); PG8_STAGE_A(PG8_SA(0, 1), 1, cA, 0, gc0, gc1);
        if (wr == 1) PG8_BAR;
        PG8_WAIT_V(2); PG8_BAR;
        PG8_STAGE(PG8_SB(1, 0), cB + kstep, voffB); PG8_STAGE_A(PG8_SA(1, 0), 0, cA, kstep, gc0, gc1); PG8_STAGE(PG8_SB(1, 1), cB + hstep + kstep, voffB);
        PG8_WAIT_V(6); PG8_BAR;
    }
    for (;;) {
        const bool has_next = S.next(ui + 1, nxt);
        const char* nA = has_next ? gA + (size_t)nxt.pm * tstep : cA;
        const char* nB = has_next ? (const char*)S.b_base(nxt, g) : cB;
        if constexpr (GATHER) { if (has_next) g_offs(nxt, gn0, gn1); else { gn0[0] = gc0[0]; gn0[1] = gc0[1]; gn1[0] = gc1[0]; gn1[1] = gc1[1]; } }
        for (int t = 0; t < nt; t += 2) {
            const bool last = (t == nt - 2);
            const size_t k1 = (size_t)(t + 1) * kstep;
            const char* tA = last ? nA : cA;
            const size_t k2 = last ? 0 : (size_t)(t + 2) * kstep, k3 = k2 + kstep;
            const char* b2 = last ? nB : cB + (size_t)(t + 2) * kstep; const char* b3 = b2 + kstep;
            unsigned w0[2], w1[2];
            if constexpr (GATHER) { w0[0] = last ? gn0[0] : gc0[0]; w0[1] = last ? gn0[1] : gc0[1]; w1[0] = last ? gn1[0] : gc1[0]; w1[1] = last ? gn1[1] : gc1[1]; }
            PG8_LDB(B0, 0, 0); PG8_LDB(B1, 0, 1); PG8_SCHED; PG8_LDA(At, 0, 0); PG8_STAGE_A(PG8_SA(1, 1), 1, cA, k1, gc0, gc1);
            PG8_WAIT_V(8); PG8_WAIT_L(0); PG8_BAR; PG8_MMA(0, 0, At, B0); PG8_MMA(0, 1, At, B1); PG8_BAR; PG8_SCHED;
            PG8_LDA(At, 0, 1); PG8_STAGE(PG8_SB(0, 0), b2, voffB); PG8_STAGE(PG8_SB(0, 1), b2 + hstep, voffB); PG8_STAGE_A(PG8_SA(0, 0), 0, tA, k2, w0, w1);
            PG8_WAIT_V(8); PG8_WAIT_L(0); PG8_BAR; PG8_MMA(1, 0, At, B0); PG8_MMA(1, 1, At, B1); PG8_BAR; PG8_SCHED;
            PG8_LDB(B0, 1, 0); PG8_LDB(B1, 1, 1); PG8_SCHED; PG8_LDA(At, 1, 0); PG8_STAGE_A(PG8_SA(0, 1), 1, tA, k2, w0, w1);
            PG8_WAIT_V(8); PG8_WAIT_L(0); PG8_BAR; PG8_MMA(0, 0, At, B0); PG8_MMA(0, 1, At, B1); PG8_BAR; PG8_SCHED;
            PG8_LDA(At, 1, 1); PG8_STAGE(PG8_SB(1, 0), b3, voffB); PG8_STAGE(PG8_SB(1, 1), b3 + hstep, voffB); PG8_STAGE_A(PG8_SA(1, 0), 0, tA, k3, w0, w1);
            PG8_WAIT_V(8); PG8_WAIT_L(0); PG8_BAR; PG8_MMA(1, 0, At, B0); PG8_MMA(1, 1, At, B1); PG8_BAR; PG8_SCHED;
        }
        if (wr == 0) PG8_BAR;
        { const int t2 = TIDX(); E(acc, cur, wr, wc, t2 & 15, (t2 >> 4) & 3); }
        if (!has_next) break;
#pragma unroll
        for (int a = 0; a < 2; ++a)
#pragma unroll
            for (int b = 0; b < 2; ++b)
#pragma unroll
                for (int m = 0; m < 4; ++m)
#pragma unroll
                    for (int n = 0; n < 2; ++n) acc[a][b][m][n] = (f32x4){zf, zf, zf, zf};
        cur = nxt; cA = nA; cB = nB; ++ui;
        if constexpr (GATHER) { gc0[0] = gn0[0]; gc0[1] = gn0[1]; gc1[0] = gn1[0]; gc1[1] = gn1[1]; }
        if (wr == 1) PG8_BAR;
    }
    PG8_WAIT_V(0);
    PG8_BAR;
#undef PG8_SA
#undef PG8_SB
#undef PG8_STAGE
#undef PG8_STAGE_A
#undef PG8_LDA
#undef PG8_LDB
#undef PG8_MMA
#undef PG8_WAIT_V
#undef PG8_WAIT_L
#undef PG8_BAR
#undef PG8_SCHED
}
}
template <class Epi, class Sched, bool GATHER>
__device__ __forceinline__ void gemm_phase(unsigned char* lds, int wv, const Gemm g, const Sched& S, const Epi& E) {
    pg8::gemm_phase<Epi, Sched, GATHER>((PG8_LAS unsigned char*)lds, wv, g, S, E);
}
#endif

struct EpiPlain {
    static constexpr bool PERM = true;
    act_t* O; int ldc;
    __device__ __forceinline__ void operator()(const f32x4 (&acc)[2][2][4][2], const Unit& u, int wr, int wc, int fr, int fq) const {
        const int row0 = u.pm * 256 + wr * 64 + fr, col0 = u.pn * 256 + wc * 32 + 8 * fq;
        for (int ai = 0; ai < 2; ++ai) for (int m = 0; m < 4; ++m) {
            act_t* rowp = O + (size_t)(row0 + ai * 128 + m * 16) * ldc + col0;
            for (int bj = 0; bj < 2; ++bj) {
                float v[8];
                for (int j = 0; j < 4; ++j) { v[j] = acc[ai][bj][m][0][j]; v[4 + j] = acc[ai][bj][m][1][j]; }
                store8(rowp + bj * 128, v);
            }
            EPI_FENCE();
        }
    }
};
struct EpiProj {
    static constexpr bool PERM = true;
    act_t* O; float* loga; const float* rot; const float* ba;
    __device__ __forceinline__ void operator()(const f32x4 (&acc)[2][2][4][2], const Unit& u, int wr, int wc, int fr, int fq) const {
        const int row0 = u.pm * 256 + wr * 64 + fr;
        if (u.pn == 11) {
            const int col0 = wc * 32 + 8 * fq;
            float bav[2][8];
            ld4f(bav[0], ba + col0); ld4f(bav[0] + 4, ba + col0 + 4); ld4f(bav[1], ba + col0 + 128); ld4f(bav[1] + 4, ba + col0 + 132);
            for (int ai = 0; ai < 2; ++ai) for (int m = 0; m < 4; ++m) {
                float* rowp = loga + (size_t)(row0 + ai * 128 + m * 16) * 256 + col0;
                for (int bj = 0; bj < 2; ++bj) for (int n = 0; n < 2; ++n) {
                    float o4[4];
                    for (int j = 0; j < 4; ++j) o4[j] = log_sigmoid_fast(acc[ai][bj][m][n][j] + bav[bj][4 * n + j]) * (1.0f / 16.0f);
                    *(f32x4*)(rowp + bj * 128 + 4 * n) = (f32x4){o4[0], o4[1], o4[2], o4[3]};
                    EPI_FENCE();
                }
            }
        } else if (u.pn <= 1) {
            const bool lat = u.pm * 256 < NLAT;
            for (int ai = 0; ai < 2; ++ai) for (int m = 0; m < 4; ++m) {
                const int row = row0 + ai * 128 + m * 16;
                act_t* rowp = O + (size_t)row * PROJ_W + u.pn * 256 + wc * 64 + 8 * fq;
                float o1[8], o2[8], rr[16];
                const float* rt = rot + ((size_t)(row % SEQ) * 32 + 8 * fq) * 2;
                if (lat) { ld4f(rr, rt); ld4f(rr + 4, rt + 4); ld4f(rr + 8, rt + 8); ld4f(rr + 12, rt + 12); }
                else { for (int q = 0; q < 8; ++q) { rr[2 * q] = 1.f; rr[2 * q + 1] = 0.f; } }
                for (int n = 0; n < 2; ++n) for (int j = 0; j < 4; ++j) {
                    float t1 = acc[ai][0][m][n][j], t2 = acc[ai][1][m][n][j];
                    const float cs = rr[(4 * n + j) * 2], sn = rr[(4 * n + j) * 2 + 1];
                    o1[4 * n + j] = t1 * cs - t2 * sn;
                    o2[4 * n + j] = t1 * sn + t2 * cs;
                }
                store8(rowp, o1);
                store8(rowp + 32, o2);
                EPI_FENCE();
            }
        } else {
            const int col0 = u.pn * 256 + wc * 32 + 8 * fq;
            for (int ai = 0; ai < 2; ++ai) for (int m = 0; m < 4; ++m) {
                act_t* rowp = O + (size_t)(row0 + ai * 128 + m * 16) * PROJ_W + col0;
                for (int bj = 0; bj < 2; ++bj) {
                    float v[8];
                    for (int j = 0; j < 4; ++j) { v[j] = acc[ai][bj][m][0][j]; v[4 + j] = acc[ai][bj][m][1][j]; }
                    store8(rowp + bj * 128, v);
                }
                EPI_FENCE();
            }
        }
    }
};
struct EpiSwiglu {
    static constexpr bool PERM = true;
    act_t* H; int row_off; int nostore;
    __device__ __forceinline__ void operator()(const f32x4 (&acc)[2][2][4][2], const Unit& u, int wr, int wc, int fr, int fq) const {
        const int row0 = u.pm * 256 + wr * 64 + fr - row_off, col0 = u.pn * 128 + wc * 32 + 8 * fq;
#if !defined(EMU)
        if (nostore) {
            for (int ai = 0; ai < 2; ++ai) for (int m = 0; m < 4; ++m) for (int bj = 0; bj < 2; ++bj) for (int n = 0; n < 2; ++n) asm volatile("" :: "v"(acc[ai][bj][m][n]));
            return;
        }
#endif
        for (int ai = 0; ai < 2; ++ai) for (int m = 0; m < 4; ++m) {
            float v[8];
            for (int n = 0; n < 2; ++n) for (int j = 0; j < 4; ++j) v[4 * n + j] = silu_fast(acc[ai][0][m][n][j]) * acc[ai][1][m][n][j];
            store8(H + (size_t)(row0 + ai * 128 + m * 16) * DFF + col0, v);
            EPI_FENCE();
        }
    }
};
struct EpiMoeOut {
    static constexpr bool PERM = true;
    act_t* ys; const int* slot_asg; const float* tok_g;
    __device__ __forceinline__ void operator()(const f32x4 (&acc)[2][2][4][2], const Unit& u, int wr, int wc, int fr, int fq) const {
        const int row0 = u.pm * 256 + wr * 64 + fr, col0 = u.pn * 256 + wc * 32 + 8 * fq;
        for (int ai = 0; ai < 2; ++ai) for (int m = 0; m < 4; ++m) {
            const int as = slot_asg[row0 + ai * 128 + m * 16];
            if (as < 0) continue;
            const float gt = tok_g[as];
            act_t* rowp = ys + (size_t)as * DM + col0;
            for (int bj = 0; bj < 2; ++bj) {
                float v[8];
                for (int j = 0; j < 4; ++j) { v[j] = gt * acc[ai][bj][m][0][j]; v[4 + j] = gt * acc[ai][bj][m][1][j]; }
                store8(rowp + bj * 128, v);
            }
            EPI_FENCE();
        }
    }
};

struct EpiGlu {
    static constexpr bool PERM = true;
    act_t* mix; const act_t* g; const float* bias;
    __device__ __forceinline__ void operator()(const f32x4 (&acc)[2][2][4][2], const Unit& u, int wr, int wc, int fr, int fq) const {
        const int row0 = u.pm * 256 + wr * 64 + fr, col0 = wc * 32 + 8 * fq;
        _Pragma("unroll") for (int ai = 0; ai < 2; ++ai) _Pragma("unroll") for (int m = 0; m < 4; ++m) {
            const size_t row = (size_t)(row0 + ai * 128 + m * 16);
            _Pragma("unroll") for (int bj = 0; bj < 2; ++bj) {
                float gv[8], v[8];
                load8f(gv, g + row * 256 + col0 + bj * 128);
                _Pragma("unroll") for (int j = 0; j < 4; ++j) {
                    v[j] = gv[j] * sigmoid_f(acc[ai][bj][m][0][j] + bias[col0 + bj * 128 + j]);
                    v[4 + j] = gv[4 + j] * sigmoid_f(acc[ai][bj][m][1][j] + bias[col0 + bj * 128 + 4 + j]);
                }
                store8(mix + row * DM + 512 + col0 + bj * 128, v);
            }
            EPI_FENCE();
        }
    }
};
#ifdef EMU
#define WAVE_SYNC() __syncthreads()
#else
#define WAVE_SYNC() asm volatile("s_waitcnt lgkmcnt(0)" ::: "memory")
#endif
struct TrItem { const float* W; act_t* WT; int Nsrc, K, k0, n0, drow0; float scale; bool ok; };
__device__ __forceinline__ void tr_load(const TrItem& t, float (&v)[32], int lane) {
#if defined(EMU)
    for (int i = 0; i < 32; ++i) { const int kk = 2 * i + (lane >> 5); v[i] = t.W[(size_t)(t.k0 + kk) * t.Nsrc + t.n0 + (lane & 31)]; }
#else
    _Pragma("unroll") for (int i = 0; i < 8; ++i) {
        const f32x4 x = *(const f32x4*)(t.W + (size_t)(t.k0 + 8 * i + (lane >> 3)) * t.Nsrc + t.n0 + (lane & 7) * 4);
        v[4 * i] = x[0]; v[4 * i + 1] = x[1]; v[4 * i + 2] = x[2]; v[4 * i + 3] = x[3];
    }
#endif
}
__device__ __forceinline__ void tr_store(const TrItem& t, const float (&v)[32], float* scr, int lane) {
#if defined(EMU)
    for (int i = 0; i < 32; ++i) { const int kk = 2 * i + (lane >> 5); scr[kk * 33 + (lane & 31)] = v[i]; }
#else
    _Pragma("unroll") for (int i = 0; i < 8; ++i) { float* d = scr + (8 * i + (lane >> 3)) * 33 + (lane & 7) * 4; d[0] = v[4 * i]; d[1] = v[4 * i + 1]; d[2] = v[4 * i + 2]; d[3] = v[4 * i + 3]; }
#endif
    WAVE_SYNC();
    const int c = lane & 7;
    for (int j = 0; j < 4; ++j) {
        const int n = (lane >> 3) + 8 * j; const float* sp = scr + (8 * c) * 33 + n;
        float o[8];
        for (int q = 0; q < 8; ++q) o[q] = sp[q * 33] * t.scale;
        store8(t.WT + (size_t)(t.drow0 + n) * t.K + t.k0 + 8 * c, o);
    }
    WAVE_SYNC();
}
__device__ __forceinline__ int win_dest(int n0, float& scale) {
    scale = 1.0f;
    if (n0 < 512) {
        const int base = n0 & ~255, s = n0 & 255, h = s >> 6, hi = (s >> 5) & 1;
        if (n0 >= 256) scale = 0.125f;
        return base + hi * 128 + h * 32;
    }
    if (n0 >= O_GQ && n0 < O_GK) scale = 0.17677669529663687f;
    if (n0 < 1792) return n0;
    if (n0 == 1792) return -1;
    return n0 - 32;
}
__device__ __forceinline__ void st_convert_items(const Params& p, int wv, unsigned char* lds, int which  ) {
    const int tid = TIDX(), wave = tid >> 6, lane = tid & 63;
    float* scr = (float*)lds + wave * (64 * 33 + 16);
    const int gw = BIDX() * NW + wave, NGW = NBLK() * NW;
    const int I_IN = (DM / 64) * (DPROJ_IN / 32), I_OUT = (DM / 64) * (DM / 32), I_F1 = (DM / 64) * (DFF / 32), I_F2 = (DFF / 64) * (DM / 32);
    const int I_GL = (256 / 64) * (256 / 32);
    const int total = which == 0 ? (DEPTH * (I_IN + I_OUT) + 2 * I_F1 + I_F2 + DEPTH * I_GL) : NEXP * (2 * I_F1 + I_F2);
    const int trips = (total + NGW - 1) / NGW;
    auto decode = [&](int tr) {
        int it = tr * NGW + gw;
        const bool valid = it < total && tr < trips;
        if (!valid) it = 0;
        const float* W; int Nsrc, K, k0, n0, drow0; act_t* WT; float scale = 1.0f;
        if (which == 0) {
            if (it < DEPTH * I_IN) {
                const int l = it / I_IN, r = it % I_IN; const int nblk = DPROJ_IN / 32;
                W = p.in[I_W_IN] + (size_t)l * DM * DPROJ_IN; Nsrc = DPROJ_IN; K = DM; k0 = 64 * (r / nblk); n0 = 32 * (r % nblk);
                WT = p.win_t + (size_t)l * NPROJ_T * DM; drow0 = win_dest(n0, scale);
            } else if (it < DEPTH * (I_IN + I_OUT)) {
                const int q = it - DEPTH * I_IN; const int l = q / I_OUT, r = q % I_OUT; const int nblk = DM / 32;
                W = p.in[I_W_OUT] + (size_t)l * DM * DM; Nsrc = DM; K = DM; k0 = 64 * (r / nblk); n0 = 32 * (r % nblk);
                WT = p.wout_t + (size_t)l * DM * DM; drow0 = n0;
            } else {
                int q = it - DEPTH * (I_IN + I_OUT);
                if (q < 2 * I_F1) {
                    const int w3 = q / I_F1, r = q % I_F1; const int nblk = DFF / 32;
                    W = p.in[w3 ? I_FFN_W3 : I_FFN_W1]; Nsrc = DFF; K = DM; k0 = 64 * (r / nblk); n0 = 32 * (r % nblk);
                    WT = p.w13_t; drow0 = (n0 / 128) * 256 + w3 * 128 + (n0 % 128);
                } else if (q < 2 * I_F1 + I_F2) {
                    const int r = q - 2 * I_F1; const int nblk = DM / 32;
                    W = p.in[I_FFN_W2]; Nsrc = DM; K = DFF; k0 = 64 * (r / nblk); n0 = 32 * (r % nblk);
                    WT = p.w2_t; drow0 = n0;
                } else {
                    const int r2 = q - 2 * I_F1 - I_F2; const int ll = r2 / I_GL, r = r2 % I_GL; const int nblk = 256 / 32;
                    W = p.in[I_S5_GLU_W] + (size_t)ll * 256 * 256; Nsrc = 256; K = 256; k0 = 64 * (r / nblk); n0 = 32 * (r % nblk);
                    WT = p.wglu_t + (size_t)ll * 256 * 256; drow0 = n0;
                }
            }
        } else {
            const int per = 2 * I_F1 + I_F2; const int e = it / per; int q = it % per;
            if (q < 2 * I_F1) {
                const int w3 = q / I_F1, r = q % I_F1; const int nblk = DFF / 32;
                W = p.in[w3 ? I_MOE_W3 : I_MOE_W1] + (size_t)e * DM * DFF; Nsrc = DFF; K = DM; k0 = 64 * (r / nblk); n0 = 32 * (r % nblk);
                WT = p.wmoe13 + (size_t)e * 2 * DFF * DM; drow0 = (n0 / 128) * 256 + w3 * 128 + (n0 % 128);
            } else {
                const int r = q - 2 * I_F1; const int nblk = DM / 32;
                W = p.in[I_MOE_W2] + (size_t)e * DFF * DM; Nsrc = DM; K = DFF; k0 = 64 * (r / nblk); n0 = 32 * (r % nblk);
                WT = p.wmoe2 + (size_t)e * DM * DFF; drow0 = n0;
            }
        }
        TrItem t; t.W = W; t.WT = WT; t.Nsrc = Nsrc; t.K = K; t.k0 = k0; t.n0 = n0; t.drow0 = drow0; t.scale = scale; t.ok = valid && drow0 >= 0;
        return t;
    };
    TrItem cur0 = decode(0), cur1 = decode(1);
    float cv0[32], cv1[32], nv0[32], nv1[32];
    if (cur0.ok) tr_load(cur0, cv0, lane);
    if (cur1.ok) tr_load(cur1, cv1, lane);
#pragma unroll 1
    for (int tr = 0; tr < trips; tr += 2) {
        const TrItem nxt0 = decode(tr + 2), nxt1 = decode(tr + 3);
        if (nxt0.ok) tr_load(nxt0, nv0, lane);
        if (nxt1.ok) tr_load(nxt1, nv1, lane);
        if (cur0.ok) tr_store(cur0, cv0, scr, lane); else { WAVE_SYNC(); WAVE_SYNC(); }
        if (cur1.ok) tr_store(cur1, cv1, scr, lane); else { WAVE_SYNC(); WAVE_SYNC(); }
        cur0 = nxt0; cur1 = nxt1;
        _Pragma("unroll") for (int i = 0; i < 32; ++i) { cv0[i] = nv0[i]; cv1[i] = nv1[i]; }
    }
}

__device__ __forceinline__ void st_prep(const Params& p, int wv, unsigned char* lds) {
    const int tid = TIDX(), nb = NBLK(), bid = BIDX();
    {
        float* sc = (float*)lds;
        float* red = sc + (BATCH + 1) * DM;
        const int wave = tid >> 6, lane = tid & 63;
        const int ngrp = DEPTH * 6 * DM / 64;
        if (bid < ngrp) {
            for (int e = tid; e < (BATCH + 1) * DM; e += NT) { const int bb = e / DM, k = e % DM; sc[e] = silu_f(bb < BATCH ? p.in[I_C][bb * DM + k] : p.in[I_CCTX][k]); }
        }
        __syncthreads();
        for (int grp = bid; grp < ngrp; grp += nb) {
            const int c0 = (grp * 64) % (6 * DM), l = (grp * 64) / (6 * DM);
            const float* w = p.in[I_ADA_W] + (long)l * DM * 6 * DM + c0 + lane + (long)(wave * (DM / NW)) * 6 * DM;
            const float* scw = sc + wave * (DM / NW);
            float acc[BATCH + 1];
            _Pragma("unroll") for (int bb = 0; bb <= BATCH; ++bb) acc[bb] = 0.f;
#pragma unroll 8
            for (int k = 0; k < DM / NW; ++k) { const float wv2 = w[(long)k * 6 * DM]; _Pragma("unroll") for (int bb = 0; bb <= BATCH; ++bb) acc[bb] += scw[bb * DM + k] * wv2; }
            _Pragma("unroll") for (int bb = 0; bb <= BATCH; ++bb) red[(wave * (BATCH + 1) + bb) * 64 + lane] = acc[bb];
            __syncthreads();
            for (int e = tid; e < (BATCH + 1) * 64; e += NT) {
                const int bb = e >> 6, ln = e & 63;
                float sum = p.in[I_ADA_B][l * 6 * DM + c0 + ln];
                for (int w2 = 0; w2 < NW; ++w2) sum += red[(w2 * (BATCH + 1) + bb) * 64 + ln];
                p.mod[((long)l * (BATCH + 1) + bb) * 6 * DM + c0 + ln] = sum;
            }
            __syncthreads();
        }
    }
    for (int it = bid * NT + tid; it < SEQ * 32; it += nb * NT) {
        int t = it / 32, f = it % 32;
        float pos = f < 16 ? (float)(t / GRID_W) : (float)(t % GRID_W);
        float inv = exp2f(-(float)(f & 15) * (13.287712379549449f / 16.0f));
        float ang = pos * inv;
        p.rot[it * 2] = cosf(ang);
        p.rot[it * 2 + 1] = sinf(ang);
    }
    for (int it = bid * NT + tid; it < FN - 1; it += nb * NT) {
        int gb = 0; while ((2 << gb) - 1 <= it) ++gb;
        const int k = it - ((1 << gb) - 1);
        double ang = -2.0 * M_PI * (double)k / (double)(2 << gb);
        p.fft_tw[it * 2] = (float)cos(ang); p.fft_tw[it * 2 + 1] = (float)sin(ang);
    }
    for (long it = (long)bid * NT + tid; it < (long)DEPTH * 256 * DM; it += (long)nb * NT) {
        int k = it % DM; int c = (it / DM) % 256; int l = it / (DM * 256);
        int dir = c >> 7, j = c & 127;
        const float* wi = p.in[I_W_IN] + ((size_t)l * DM + k) * DPROJ_IN + 1792 + 16 * dir;
        const float* wa = p.in[I_GLA_WA] + ((size_t)(l * 2 + dir) * 16) * 128 + j;
        float s = 0.f, w16[16];
        ld4f(w16, wi); ld4f(w16 + 4, wi + 4); ld4f(w16 + 8, wi + 8); ld4f(w16 + 12, wi + 12);
        for (int i = 0; i < 16; ++i) s += w16[i] * wa[i * 128];
        p.win_t[((size_t)l * NPROJ_T + 2816 + c) * DM + k] = f2a(s);
    }
    {
        const int wave = tid >> 6, lane = tid & 63;
        float* h1 = (float*)lds + wave * 128;
        float* h2 = h1 + 64;
        const int per_layer = SEQ + CTXL;
        for (int base = bid * NW; base < DEPTH * per_layer; base += nb * NW) {
            int it = base + wave;
            int l = it / per_layer;
            int r = it % per_layer;
            int which = r < SEQ ? 0 : 1;
            int n = which ? CTXL : SEQ;
            int t = which ? r - SEQ : r;
            float* circ = p.filt + (long)l * FILT_LAYER_FLOATS;
            const float tn = (float)((double)t / (double)(n - 1));
            const float* fw1 = p.in[I_HY_FW1] + l * 33 * 64;
            const float* fw2 = p.in[I_HY_FW2] + l * 64 * 64;
            const float* fw3 = p.in[I_HY_FW3] + l * 64 * 512;
            const float fr = p.in[I_HY_FREQ][l * 64 + lane];
            float a = p.in[I_HY_FB1][l * 64 + lane] + tn * fw1[lane];
#pragma unroll 2
            for (int k = 0; k < 16; ++k) {
                double band = 1e-4 + (double)k * ((15.0 - 1e-4) / 15.0);
                double turns = band * (double)t / (double)n;
                float ang = (float)((turns - floor(turns)) * (2.0 * M_PI));
                a += cosf(ang) * fw1[(1 + k) * 64 + lane];
                a += -sinf(ang) * fw1[(17 + k) * 64 + lane];
            }
            h1[lane] = sinf(fr * a);
            __syncthreads();
            float a2 = p.in[I_HY_FB2][l * 64 + lane];
#pragma unroll 8
            for (int i = 0; i < 64; ++i) a2 += h1[i] * fw2[i * 64 + lane];
            h2[lane] = sinf(fr * a2);
            if (!which) p.hdn2[((size_t)l * SEQ + t) * 64 + lane] = h2[lane];
            __syncthreads();
#pragma unroll 1
            for (int cc = 0; cc < (which ? 8 : 0); ++cc) {
                int c = cc * 64 + lane;
                float f = 0.0f;
#pragma unroll 8
                for (int i = 0; i < 64; ++i) f += h2[i] * fw3[i * 512 + c];
                int w = c >> 8, ch = c & 255;
                float dec = fabsf(p.in[I_HY_DECAY][(l * 2 + w) * 256 + ch]);
                f *= expf(-tn * dec);
                if (w == 0) circ[(long)t * 256 + ch] = f;
                else if (t >= 1) circ[(long)(2 * n - t) * 256 + ch] = f;
                if (t == 0 && w == 1) circ[(long)n * 256 + ch] = 0.0f;
            }
            __syncthreads();
        }
    }
    for (int it = bid * NT + tid; it < DEPTH * 2 * 16 * 64; it += nb * NT) {
        const int n = it & 63, pg = it >> 6;
        double lre = p.in[I_S5_LAM_RE][it], lim = p.in[I_S5_LAM_IM][it];
        double dt = exp((double)p.in[I_S5_LOG_DT][pg]);
        double mag = exp(lre * dt);
        double lbr = mag * cos(lim * dt), lbi = mag * sin(lim * dt);
        double den = lre * lre + lim * lim;
        double cr = ((lbr - 1.0) * lre + lbi * lim) / den;
        double ci = (lbi * lre - (lbr - 1.0) * lim) / den;
        float* tb = p.s5tab + (size_t)it * 36;
        tb[0] = (float)lbr; tb[1] = (float)lbi;
#pragma unroll 1
        for (int q = 0; q < 16; ++q) {
            double br = p.in[I_S5_B_RE][((long)pg * 64 + n) * 16 + q], bi = p.in[I_S5_B_IM][((long)pg * 64 + n) * 16 + q];
            tb[4 + q] = (float)(cr * br - ci * bi);
            tb[20 + q] = (float)(cr * bi + ci * br);
        }
    }
    for (int it = bid * NT + tid; it < DEPTH * 2 * 16 * 65 * 64; it += nb * NT) {
        const int n = it & 63, tau = (it >> 6) % 65, pg = it / (65 * 64);
        const double lre = p.in[I_S5_LAM_RE][pg * 64 + n], lim = p.in[I_S5_LAM_IM][pg * 64 + n];
        const double dt = exp((double)p.in[I_S5_LOG_DT][pg]);
        const double mag = exp(lre * dt * (double)tau), ph = lim * dt * (double)tau;
        p.s5pw[(size_t)it * 2] = (float)(mag * cos(ph)); p.s5pw[(size_t)it * 2 + 1] = (float)(mag * sin(ph));
    }
    st_convert_items(p, wv, lds, 0);
}

__device__ __forceinline__ void st_prep2(const Params& p, int wv) {
    const int tid = TIDX(), wave = tid >> 6, lane = tid & 63;
    for (int base = BIDX() * NW; base < DEPTH * 256; base += NBLK() * NW) {
        int it = base + wave;
        int ch = it & 255, l = it >> 8;
        int n = CTXL;
        const float* circ = p.filt + (long)l * FILT_LAYER_FLOATS;
        double s = 0.0;
        for (int i = lane; i < 2 * n; i += 64) s += fabs((double)circ[(long)i * 256 + ch]);
        float hi = (float)s, lo = (float)(s - (double)hi);
        hi = wave_sum(hi); lo = wave_sum(lo);
        if (lane == 0) p.fnorm[it] = (float)(1.0 / ((double)hi + (double)lo));
    }
}

__device__ __forceinline__ void ld8(float* v, const float* src) {
#if defined(EMU)
    for (int i = 0; i < 8; ++i) v[i] = src[i];
#else
    const f32x4 a = *(const f32x4*)src, b = *(const f32x4*)(src + 4);
    v[0] = a[0]; v[1] = a[1]; v[2] = a[2]; v[3] = a[3]; v[4] = b[0]; v[5] = b[1]; v[6] = b[2]; v[7] = b[3];
#endif
}
__device__ __forceinline__ void st8f(float* dst, const float* v) {
#if defined(EMU)
    for (int i = 0; i < 8; ++i) dst[i] = v[i];
#else
    *(f32x4*)dst = (f32x4){v[0], v[1], v[2], v[3]}; *(f32x4*)(dst + 4) = (f32x4){v[4], v[5], v[6], v[7]};
#endif
}
__device__ __forceinline__ void st_ln(const Params& p, int wv, unsigned char* lds, int l, int mode) {
    const int tid = TIDX(), wave = tid >> 6, lane = tid & 63;
    const bool last = (l == DEPTH - 1);
    const int nrows = (mode == 0) ? NTOK : (last ? NLAT : NTOK);
    const bool moe = (l & 1);
    const bool route = (mode == 1) && moe;
    int* lc = (int*)lds;
    float* rtab = (float*)lds + 64;
    if (route) {
        if (tid < NW * NEXP) lc[tid] = 0;
        {
            const float* rw0 = p.in[I_ROUTER_W] + (long)(l / 2) * DM * NEXP;
            for (int r = 2 * wave; r < 2 * wave + 2; ++r) {
                float t8[8];
                ld8(t8, rw0 + (long)((r >> 3) * 512 + lane * 8 + (r & 7)) * NEXP);
                st8f(rtab + lane * 132 + r * 8, t8);
            }
        }
        __syncthreads();
        for (int i = BIDX() * NT + tid; i < MOE_CAP; i += NBLK() * NT) { p.slot_asg[i] = -1; if (i < MOE_TAIL_ROWS) p.tail_asg[i] = -1; }
    }
    const float* rw = p.in[I_ROUTER_W] + (long)(l / 2) * DM * NEXP;
    const float* rb = p.in[I_ROUTER_B] + (l / 2) * NEXP;
    auto fetch = [&](int row, float* xs, float* ys, int sl0, int sl1) {
        const bool lat = row < NLAT;
        const float* src;
        if (mode == 0) src = lat ? p.in[I_X] + (long)row * DM : p.in[I_CTX] + (long)(row - NLAT) * DM;
        else if (mode == 1) src = lat ? ((l == 0 ? p.in[I_X] : p.out) + (long)row * DM) : ((l == 0 ? p.in[I_CTX] : p.hctx) + (long)(row - NLAT) * DM);
        else src = lat ? p.out + (long)row * DM : p.hctx + (long)(row - NLAT) * DM;
        for (int g = 0; g < 2; ++g) {
            const int c0 = g * 512 + lane * 8;
            ld8(xs + 8 * g, src + c0);
            if (mode == 1 || (mode == 2 && !moe && lat)) load8f(ys + 8 * g, p.u + (long)row * DM + c0);
            if (mode == 2 && !moe && !lat) {
                float o2[8];
                for (int j = 0; j < 8; ++j) ys[8 * g + j] = 0.f;
                for (int ks = 0; ks < KSPLIT; ++ks) { load8f(o2, p.pbuf_d + ((size_t)ks * NCTX + (row - NLAT)) * DM + c0); for (int j = 0; j < 8; ++j) ys[8 * g + j] += o2[j]; }
            }
            if (mode == 2 && moe) {
                float o2[8];
                if (sl0 < MOE_TAIL_T0 * 256 && sl1 < MOE_TAIL_T0 * 256) {
                    load8f(ys + 8 * g, p.ys + (long)(row * 2) * DM + c0); load8f(o2, p.ys + (long)(row * 2 + 1) * DM + c0);
                    for (int j = 0; j < 8; ++j) ys[8 * g + j] += o2[j];
                } else {
                    for (int j = 0; j < 8; ++j) ys[8 * g + j] = 0.f;
                    for (int k = 0; k < 2; ++k) {
                        const int slot = k ? sl1 : sl0;
                        if (slot >= MOE_TAIL_T0 * 256) {
                            for (int ks = 0; ks < KSPLIT; ++ks) { load8f(o2, p.pbuf_m + ((size_t)ks * MOE_TAIL_ROWS + (slot - MOE_TAIL_T0 * 256)) * DM + c0); for (int j = 0; j < 8; ++j) ys[8 * g + j] += o2[j]; }
                        } else { load8f(o2, p.ys + (long)(row * 2 + k) * DM + c0); for (int j = 0; j < 8; ++j) ys[8 * g + j] += o2[j]; }
                    }
                }
            }
        }
    };
    const int rpw = (nrows + NBLK() * NW - 1) / (NBLK() * NW);
    const int r_lo = (BIDX() * NW + wave) * rpw, r_hi = (r_lo + rpw < nrows) ? r_lo + rpw : nrows;
    float xa[16], ya[16], xb[16], yb[16];
    float pA[16], pB[16], pC[16], pD[16], pE[16];
    if (mode == 1) for (int g = 0; g < 2; ++g) { ld8(pD + 8 * g, p.in[I_LN_MIX_G] + l * DM + g * 512 + lane * 8); ld8(pE + 8 * g, p.in[I_LN_MIX_B] + l * DM + g * 512 + lane * 8); }
    if (mode == 2) for (int g = 0; g < 2; ++g) { ld8(pD + 8 * g, p.in[I_LN_FFN_G] + l * DM + g * 512 + lane * 8); ld8(pE + 8 * g, p.in[I_LN_FFN_B] + l * DM + g * 512 + lane * 8); }
    int cur_mi = -1;
    int row = r_lo;
    const bool need_slots = (mode == 2) && moe;
    int sn0 = 0, sn1 = 0;
    if (row < r_hi) {
        int s0 = 0, s1 = 0;
        if (need_slots) { s0 = p.tok_slot[row * 2]; s1 = p.tok_slot[row * 2 + 1]; }
        fetch(row, xa, ya, s0, s1);
        if (need_slots && row + 1 < r_hi) { sn0 = p.tok_slot[(row + 1) * 2]; sn1 = p.tok_slot[(row + 1) * 2 + 1]; }
    }
    for (; row < r_hi; ++row) {
        if (row + 1 < r_hi) fetch(row + 1, xb, yb, sn0, sn1);
        if (need_slots && row + 2 < r_hi) { sn0 = p.tok_slot[(row + 2) * 2]; sn1 = p.tok_slot[(row + 2) * 2 + 1]; }
        const bool lat = row < NLAT;
        const int mi = row_modidx(row);
        if (mi != cur_mi) {
            cur_mi = mi;
            const float* modp = p.mod + ((long)l * (BATCH + 1) + mi) * 6 * DM;
            for (int g = 0; g < 2; ++g) {
                const int c0 = g * 512 + lane * 8;
                if (mode == 0) { ld8(pA + 8 * g, modp + DM + c0); ld8(pB + 8 * g, modp + c0); }
                if (mode == 1) { ld8(pA + 8 * g, modp + 2 * DM + c0); ld8(pB + 8 * g, modp + 4 * DM + c0); ld8(pC + 8 * g, modp + 3 * DM + c0); }
                if (mode == 2) {
                    ld8(pA + 8 * g, modp + 5 * DM + c0);
                    if (l + 1 < DEPTH) { const float* modn = p.mod + ((long)(l + 1) * (BATCH + 1) + mi) * 6 * DM; ld8(pB + 8 * g, modn + DM + c0); ld8(pC + 8 * g, modn + c0); }
                }
            }
        }
        act_t* urow = p.u + (long)row * DM;
        float v[16], o[8], t8[8];
        float mu, rstd;
        if (mode == 0) {
            for (int i = 0; i < 16; ++i) v[i] = xa[i];
            ln_stats16(v, mu, rstd);
            for (int g = 0; g < 2; ++g) {
                const int c0 = g * 512 + lane * 8;
                for (int j = 0; j < 8; ++j) o[j] = (v[8 * g + j] - mu) * rstd * (1.0f + pA[8 * g + j]) + pB[8 * g + j];
                store8(urow + c0, o);
            }
        } else if (mode == 1) {
            float* dst = lat ? p.out + (long)row * DM : p.hctx + (long)(row - NLAT) * DM;
            for (int i = 0; i < 16; ++i) v[i] = ALPHA * xa[i] + pA[i] * ya[i];
            ln_stats16(v, mu, rstd);
            for (int g = 0; g < 2; ++g) {
                const int c0 = g * 512 + lane * 8;
                for (int j = 0; j < 8; ++j) v[8 * g + j] = (v[8 * g + j] - mu) * rstd * pD[8 * g + j] + pE[8 * g + j];
                st8f(dst + c0, v + 8 * g);
            }
            ln_stats16(v, mu, rstd);
            float lg[NEXP];
            for (int e = 0; e < NEXP; ++e) lg[e] = 0.f;
            for (int g = 0; g < 2; ++g) {
                const int c0 = g * 512 + lane * 8;
                for (int j = 0; j < 8; ++j) o[j] = (v[8 * g + j] - mu) * rstd * (1.0f + pB[8 * g + j]) + pC[8 * g + j];
                store8(urow + c0, o);
                if (route) for (int j = 0; j < 8; ++j) { ld8(t8, rtab + lane * 132 + (g * 8 + j) * 8); for (int e = 0; e < NEXP; ++e) lg[e] += o[j] * t8[e]; }
            }
            if (route) {
                for (int e = 0; e < NEXP; ++e) lg[e] = wave_sum(lg[e]) + rb[e];
                if (lane == 0) {
                    int e1 = 0;
                    for (int e = 1; e < NEXP; ++e) if (lg[e] > lg[e1]) e1 = e;
                    int e2 = (e1 == 0) ? 1 : 0;
                    for (int e = 0; e < NEXP; ++e) if (e != e1 && lg[e] > lg[e2]) e2 = e;
                    float ex = expf(lg[e2] - lg[e1]);
                    float g1 = 1.0f / (1.0f + ex);
                    p.tok_e[row * 2] = e1; p.tok_e[row * 2 + 1] = e2;
                    p.tok_g[row * 2] = g1; p.tok_g[row * 2 + 1] = ex * g1;
                    lc[wave * NEXP + e1] += 1;
                    lc[wave * NEXP + e2] += 1;
                }
            }
        } else {
            float* dst = lat ? p.out + (long)row * DM : p.hctx + (long)(row - NLAT) * DM;
            for (int i = 0; i < 16; ++i) v[i] = ALPHA * xa[i] + pA[i] * ya[i];
            ln_stats16(v, mu, rstd);
            for (int g = 0; g < 2; ++g) {
                const int c0 = g * 512 + lane * 8;
                for (int j = 0; j < 8; ++j) v[8 * g + j] = (v[8 * g + j] - mu) * rstd * pD[8 * g + j] + pE[8 * g + j];
                st8f(dst + c0, v + 8 * g);
            }
            if (l + 1 < DEPTH) {
                ln_stats16(v, mu, rstd);
                for (int g = 0; g < 2; ++g) {
                    const int c0 = g * 512 + lane * 8;
                    for (int j = 0; j < 8; ++j) o[j] = (v[8 * g + j] - mu) * rstd * (1.0f + pB[8 * g + j]) + pC[8 * g + j];
                    store8(urow + c0, o);
                }
            }
        }
        for (int i = 0; i < 16; ++i) { xa[i] = xb[i]; ya[i] = yb[i]; }
    }
    if (route) {
        int* cnt = (int*)(p.ctl + CTL_MOE);
        __syncthreads();
        if (tid < NEXP) {
            int tot = 0;
            for (int w = 0; w < NW; ++w) tot += lc[w * NEXP + tid];
            if (tot) atomicAdd(&cnt[tid], tot);
        }
        __syncthreads();
    }
}

__device__ __forceinline__ void st_router(const Params& p, int wv, unsigned char* lds, int l) {
    const int tid = TIDX(), wave = tid >> 6, lane = tid & 63;
    const int j = l / 2;
    const float* rw = p.in[I_ROUTER_W] + (long)j * DM * NEXP;
    const float* rb = p.in[I_ROUTER_B] + j * NEXP;
    int* cnt = (int*)(p.ctl + CTL_MOE);
    int* lc = (int*)lds;
    if (tid < NW * NEXP) lc[tid] = 0;
    __syncthreads();
    for (int i = BIDX() * NT + tid; i < MOE_CAP; i += NBLK() * NT) p.slot_asg[i] = -1;
    for (int base = BIDX() * NW; base < NLAT; base += NBLK() * NW) {
        const int row = base + wave;
        const float* modp = p.mod + ((long)l * (BATCH + 1) + row_modidx(row)) * 6 * DM;
        float v[16], mu, rstd;
        for (int i = 0; i < 16; ++i) v[i] = p.out[(long)row * DM + i * 64 + lane];
        ln_stats16(v, mu, rstd);
        float lg[NEXP];
        for (int e = 0; e < NEXP; ++e) lg[e] = 0.f;
        for (int i = 0; i < 16; ++i) {
            int c = i * 64 + lane;
            float vv = (v[i] - mu) * rstd * (1.0f + modp[4 * DM + c]) + modp[3 * DM + c];
            for (int e = 0; e < NEXP; ++e) lg[e] += vv * rw[c * NEXP + e];
        }
        for (int e = 0; e < NEXP; ++e) lg[e] = wave_sum(lg[e]) + rb[e];
        if (lane == 0) {
            int e1 = 0;
            for (int e = 1; e < NEXP; ++e) if (lg[e] > lg[e1]) e1 = e;
            int e2 = (e1 == 0) ? 1 : 0;
            for (int e = 0; e < NEXP; ++e) if (e != e1 && lg[e] > lg[e2]) e2 = e;
            float ex = expf(lg[e2] - lg[e1]);
            float g1 = 1.0f / (1.0f + ex);
            p.tok_e[row * 2] = e1; p.tok_e[row * 2 + 1] = e2;
            p.tok_g[row * 2] = g1; p.tok_g[row * 2 + 1] = ex * g1;
            lc[wave * NEXP + e1] += 1;
            lc[wave * NEXP + e2] += 1;
        }
    }
    __syncthreads();
    if (tid < NEXP) {
        int tot = 0;
        for (int w = 0; w < NW; ++w) tot += lc[w * NEXP + tid];
        if (tot) atomicAdd(&cnt[tid], tot);
    }
    __syncthreads();
}
__device__ __forceinline__ void moe_offsets(const Params& p, int* pstart, int* pend) {
    const int* cnt = (const int*)(p.ctl + CTL_MOE);
    int acc = 0;
    for (int e = 0; e < NEXP; ++e) {
        int c = cnt[e];
        pstart[e] = acc;
        acc += (c + 255) / 256 * 256;
        pend[e] = acc;
    }
}
__device__ __forceinline__ void st_place(const Params& p, int wv, unsigned char* lds) {
    const int tid = TIDX();
    int pstart[NEXP], pend[NEXP];
    moe_offsets(p, pstart, pend);
    int* fill = (int*)(p.ctl + CTL_MOE) + 8;
    int* lcnt = (int*)lds;
    int* lpos = lcnt + 16;
    const int per = (2 * NLAT + NBLK() - 1) / NBLK();
    const int a0 = BIDX() * per, a1 = (a0 + per < 2 * NLAT) ? a0 + per : 2 * NLAT;
    if (tid < 32) lcnt[tid] = 0;
    __syncthreads();
    for (int a = a0 + tid; a < a1; a += NT) atomicAdd(&lcnt[p.tok_e[a]], 1);
    __syncthreads();
    if (tid < NEXP) { const int c = lcnt[tid]; lcnt[tid] = c ? atomicAdd(&fill[tid], c) : 0; }
    __syncthreads();
    for (int a = a0 + tid; a < a1; a += NT) {
        const int e = p.tok_e[a];
        const int pos = lcnt[e] + atomicAdd(&lpos[e], 1);
        int ps = 0;
        for (int q = 0; q < NEXP; ++q) ps = (q == e) ? pstart[q] : ps;
        const int slot = ps + pos;
        p.slot_asg[slot] = a;
        p.tok_slot[a] = slot;
        if (slot >= MOE_TAIL_T0 * 256) { p.tail_asg[slot - MOE_TAIL_T0 * 256] = slot - MOE_TAIL_T0 * 256; p.tail_g[slot - MOE_TAIL_T0 * 256] = p.tok_g[a]; }
    }
    __syncthreads();
}

#ifndef NOSTORE_EXP
#define NOSTORE_EXP 0
#endif
enum { G_PROJ, G_OUT, G_FFN1, G_FFN2, G_MFFN1, G_MFFN2, G_GLU };
#ifndef REFMASK
#define REFMASK 0
#endif
#if defined(EMU)
#define GEMM_CALL(mode, EPI, SCH, GA) gemm_phase<EPI, SCH, GA>(lds, wv, g, S, E)
#else
#define GEMM_CALL(mode, EPI, SCH, GA) do { if ((REFMASK >> (mode)) & 1) gemm_phase_ref<EPI, SCH, GA>(wv, g, S, E); else gemm_phase<EPI, SCH, GA>(lds, wv, g, S, E); } while (0)
#endif
__device__ __forceinline__ void ksplit_range(int K, int ks, int& off, int& len) {
    const int np = K / 128; int o = 0;
    for (int j = 0; j < ks; ++j) o += (np + KSPLIT - 1 - j) / KSPLIT;
    off = o * 128; len = ((np + KSPLIT - 1 - ks) / KSPLIT) * 128;
}
template <int MODE>
__device__ __forceinline__ void st_gemm(const Params& p, int wv, unsigned char* lds, int l, int pass) {
    const bool last = (l == DEPTH - 1);
    const int G = NBLK(), c = BIDX();
    if (MODE == G_PROJ) {
        Gemm g{p.u, p.win_t + (size_t)l * NPROJ_T * DM, NTOK, NPROJ_T, DM, nullptr};
        StaticOrder S; S.init(NTOK, NPROJ_T, G, c);
        EpiProj E{p.proj, p.loga, p.rot, p.in[I_GLA_BA] + l * 256};
        GEMM_CALL(G_PROJ, EpiProj, StaticOrder, false);
    } else if (MODE == G_OUT) {
        const int M = last ? NLAT : NTOK;
        Gemm g{p.mix, p.wout_t + (size_t)l * DM * DM, M, DM, DM, nullptr};
        StaticOrder S; S.init(M, DM, G, c);
        EpiPlain E{p.u, DM};
        GEMM_CALL(G_OUT, EpiPlain, StaticOrder, false);
    } else if (MODE == G_GLU && false) {
        const int M = last ? NLAT : NTOK;
        Gemm g{p.gbuf, p.wglu_t + (size_t)l * 256 * 256, M, 256, 256, nullptr};
        StaticOrder S; S.init(M, 256, G, c);
        EpiGlu E{p.mix, p.gbuf, p.in[I_S5_GLU_B] + l * 256};
        GEMM_CALL(G_GLU, EpiGlu, StaticOrder, false);
    } else if (MODE == G_FFN1) {
        Gemm g{p.u, p.w13_t, NTOK, 2 * DFF, DM, nullptr};
        StaticOrder S; S.init(NTOK, 2 * DFF, G, c);
        EpiSwiglu E{p.proj, 0, NOSTORE_EXP ? pass : 0};
        GEMM_CALL(G_FFN1, EpiSwiglu, StaticOrder, false);
    } else if (MODE == G_FFN2) {
#pragma unroll 1
        for (int call = 0; call <= KSPLIT; ++call) {
            Gemm g{p.proj, p.w2_t, NLAT, DM, DFF, nullptr};
            StaticOrder S; S.init(NLAT, DM, G, c);
            EpiPlain E{p.u, DM};
            if (call > 0) {
                const int ks = call - 1; int off, len; ksplit_range(DFF, ks, off, len);
                g.A = p.proj + (size_t)NLAT * DFF + off; g.Bt = p.w2_t + off; g.M = NCTX; g.Kl = len;
                S.init(NCTX, DM, G, ((c - 32 * ks) % G + G) % G);
                E.O = p.pbuf_d + (size_t)ks * NCTX * DM;
            }
            GEMM_CALL(G_FFN2, EpiPlain, StaticOrder, false);
        }
    } else {
        int pstart[NEXP], pend[NEXP];
        moe_offsets(p, pstart, pend);
        const int used = pend[NEXP - 1] / 256;
        const int t0 = pass * MOE_PT;
        int nt = used - t0; if (nt > MOE_PT) nt = MOE_PT;
        if (nt <= 0) return;
        MoeOrder S; S.t0 = t0;
        for (int e = 0; e < NEXP; ++e) S.pend[e] = pend[e];
        if (MODE == G_MFFN1) {
            S.so.init(nt * 256, 2 * DFF, G, c); S.estride = (size_t)2 * DFF * DM;
            Gemm g{p.u, p.wmoe13, nt * 256, 2 * DFF, DM, p.slot_asg};
            EpiSwiglu E{p.hch, t0 * 256, 0};
            GEMM_CALL(G_MFFN1, EpiSwiglu, MoeOrder, true);
        } else {
            const bool tail = (pass == MOE_NPASS - 1);
            S.estride = (size_t)DM * DFF;
#pragma unroll 1
            for (int ks = 0; ks < (tail ? KSPLIT : 1); ++ks) {
                Gemm g{p.hch - (size_t)t0 * 256 * DFF, p.wmoe2, nt * 256, DM, DFF, nullptr};
                EpiMoeOut E{p.ys, p.slot_asg, p.tok_g};
                S.so.init(nt * 256, DM, G, c);
                if (tail) {
                    int off, len; ksplit_range(DFF, ks, off, len);
                    g.A += off; g.Bt += off; g.Kl = len;
                    S.so.init(nt * 256, DM, G, ((c - 32 * ks) % G + G) % G);
                    E.ys = p.pbuf_m + (size_t)ks * MOE_TAIL_ROWS * DM; E.slot_asg = p.tail_asg - (size_t)t0 * 256; E.tok_g = p.tail_g;
                }
                GEMM_CALL(G_MFFN2, EpiMoeOut, MoeOrder, false);
            }
        }
    }
}

__device__ __forceinline__ void st_glu(const Params& p, int wv, unsigned char* lds, int l) {
    const int M = (l == DEPTH - 1) ? NLAT : NTOK;
    float(*As)[132] = (float(*)[132])lds;
    float(*Bs)[68] = (float(*)[68])(lds + 16 * 132 * 4);
    const float* W = p.in[I_S5_GLU_W] + (long)l * 256 * 256;
    const float* g = p.osum;
    const int tid = TIDX(), ty = tid >> 4, tx = tid & 15;
    const int ar = tid >> 2, ak = (tid & 3) * 4;
    const int bk = (tid >> 4) & 15, bc = (tid & 15) * 4;
    const int ntm = M / 128, ntn = 4;
    for (int tile = BIDX(); tile < ntm * ntn; tile += NBLK()) {
        const int m0 = (tile / ntn) * 128, n0 = (tile % ntn) * 64;
        float acc[4][4];
        for (int i = 0; i < 4; ++i) for (int j = 0; j < 4; ++j) acc[i][j] = 0.f;
        for (int k0 = 0; k0 < 256; k0 += 16) {
            for (int q = 0; q < 4; ++q) As[ak + q][ar] = g[(long)(m0 + ar) * 256 + k0 + ak + q];
            if (tid < 256) for (int q = 0; q < 4; ++q) Bs[bk][bc + q] = W[(k0 + bk) * 256 + n0 + bc + q];
            __syncthreads();
            for (int k = 0; k < 16; ++k) {
                float a[4], b[4];
                for (int i = 0; i < 4; ++i) a[i] = As[k][ty * 4 + i];
                for (int j = 0; j < 4; ++j) b[j] = Bs[k][tx * 4 + j];
                for (int i = 0; i < 4; ++i) for (int j = 0; j < 4; ++j) acc[i][j] += a[i] * b[j];
            }
            __syncthreads();
        }
        for (int i = 0; i < 4; ++i) for (int j = 0; j < 4; ++j) {
            int r = m0 + ty * 4 + i, c = n0 + tx * 4 + j;
            float gv = g[(long)r * 256 + c];
            p.mix[(long)r * DM + 512 + c] = f2a(gv * sigmoid_f(acc[i][j] + p.in[I_S5_GLU_B][l * 256 + c]));
        }
    }
}

#define GLP 264
typedef short bf16x8v __attribute__((ext_vector_type(8)));
__device__ __forceinline__ f32x4 mm16(f32x4 acc, const act_t* A, int pa, const act_t* Bt, int pb, int K, int lane);
__device__ __forceinline__ void st_glu2(const Params& p, int wv, unsigned char* lds, int l, int bid, int nb) {
    const int tid = TIDX(), wave = tid >> 6, lane = tid & 63;
    const int M = (l == DEPTH - 1) ? NLAT : NTOK;
    act_t* gt = (act_t*)lds; act_t* ot = gt + 64 * GLP;
    const act_t* Wt = p.wglu_t + (size_t)l * 256 * 256;
    for (int u = bid; u < M / 64; u += nb) {
        const int row0 = u * 64;
        for (int e = tid; e < 64 * 32; e += NT) { const int r = e >> 5, c8 = (e & 31) * 8; copy8(gt + r * GLP + c8, p.gbuf + (size_t)(row0 + r) * 256 + c8); }
        __syncthreads();
        for (int q = 0; q < 2; ++q) {
            const int n = 2 * wave + q, c = 16 * n + (lane & 15);
            const float bq = p.in[I_S5_GLU_B][l * 256 + c];
            f32x4 acc4[4];
#if defined(EMU)
            for (int rb = 0; rb < 4; ++rb) { acc4[rb] = (f32x4){0.f, 0.f, 0.f, 0.f}; acc4[rb] = mm16(acc4[rb], gt + 16 * rb * GLP, GLP, Wt + (size_t)16 * n * 256, 256, 256, lane); }
#else
            {
                const act_t* bp = Wt + ((size_t)16 * n + (lane & 15)) * 256 + 8 * (lane >> 4);
                const act_t* ap = gt + (lane & 15) * GLP + 8 * (lane >> 4);
                float zf = 0.f; asm volatile("" : "+v"(zf));
                _Pragma("unroll") for (int rb = 0; rb < 4; ++rb) acc4[rb] = (f32x4){zf, zf, zf, zf};
                _Pragma("unroll") for (int k0 = 0; k0 < 256; k0 += 32) {
                    const bf16x8v b = *(const bf16x8v*)(bp + k0);
                    _Pragma("unroll") for (int rb = 0; rb < 4; ++rb) {
                        const bf16x8v a = *(const bf16x8v*)(ap + 16 * rb * GLP + k0);
                        acc4[rb] = __builtin_amdgcn_mfma_f32_16x16x32_bf16(a, b, acc4[rb], 0, 0, 0);
                    }
                }
            }
#endif
            _Pragma("unroll") for (int rb = 0; rb < 4; ++rb) {
                for (int r = 0; r < 4; ++r) {
                    const int t = 16 * rb + 4 * (lane >> 4) + r;
                    ot[t * GLP + c] = f2a(a2f(gt[t * GLP + c]) * sigmoid_fast(acc4[rb][r] + bq));
                }
            }
        }
        __syncthreads();
        for (int e = tid; e < 64 * 32; e += NT) { const int r = e >> 5, c8 = (e & 31) * 8; copy8(p.mix + (size_t)(row0 + r) * DM + 512 + c8, ot + r * GLP + c8); }
        __syncthreads();
    }
}
__device__ __forceinline__ float hy_short(const Params& p, int l, int row, int c) {
    const bool lat = row < NLAT;
    const int n = lat ? SEQ : CTXL;
    const int t = lat ? row % SEQ : (row - NLAT) % CTXL;
    const float* cw = p.in[I_HY_CONV_W] + (long)l * 3 * 768;
    float s = p.in[I_HY_CONV_B][l * 768 + c];
    for (int jj = 0; jj < 3; ++jj) {
        int tt = t + jj - 1;
        if (tt >= 0 && tt < n) s += a2f(p.proj[(long)(row + jj - 1) * PROJ_W + O_HP + c]) * cw[jj * 768 + c];
    }
    return s;
}
__device__ __forceinline__ void st_hy_ctx_pre(const Params& p, int wv, int l, int bid, int nb) {
    const int tid = TIDX();
    for (long it = (long)bid * NT + tid; it < (long)NCTX * 256; it += (long)nb * NT) {
        int row = NLAT + (int)(it >> 8), ch = it & 255;
        p.hz[(long)row * 256 + ch] = f2a(hy_short(p, l, row, 256 + ch) * hy_short(p, l, row, 512 + ch));
    }
}
__device__ __forceinline__ void st_hy_ctx_conv(const Params& p, int wv, int l, int bid, int nb) {
    const int tid = TIDX();
    const float* circ = p.filt + (long)l * FILT_LAYER_FLOATS;
    const int M2 = 2 * CTXL - 1;
    for (int it = bid * NT + tid; it < NCTX * 256 / 8; it += nb * NT) {
        const int ch = it & 255, tg = (it >> 8) % (CTXL / 8), b = it / (256 * (CTXL / 8));
        const int t0 = tg * 8, rbase = NLAT + b * CTXL;
        float y[8], W[8];
        _Pragma("unroll") for (int i = 0; i < 8; ++i) y[i] = 0.f;
        W[0] = 0.f;
        _Pragma("unroll") for (int i = 1; i < 8; ++i) W[i] = circ[(long)((t0 + i) & M2) * 256 + ch];
#pragma unroll 1
        for (int s0 = 0; s0 < CTXL; s0 += 32) {
            float zz[32], cc[32];
            _Pragma("unroll") for (int q = 0; q < 32; ++q) { zz[q] = a2f(p.hz[(long)(rbase + s0 + q) * 256 + ch]); cc[q] = circ[(long)((t0 - s0 - q) & M2) * 256 + ch]; }
            _Pragma("unroll") for (int q = 0; q < 32; ++q) {
                W[(8 - (q & 7)) & 7] = cc[q];
                _Pragma("unroll") for (int i = 0; i < 8; ++i) y[i] += W[(i - q) & 7] * zz[q];
            }
        }
        const float fn = p.fnorm[l * 256 + ch], hb = p.in[I_HY_BIAS][l * 256 + ch];
        _Pragma("unroll") for (int i = 0; i < 8; ++i) {
            const int row = rbase + t0 + i;
            const float z = a2f(p.hz[(long)row * 256 + ch]);
            const float x0 = hy_short(p, l, row, ch);
            p.mix[(long)row * DM + 768 + ch] = f2a(x0 * (y[i] * fn + z * hb));
        }
    }
}
struct cpx { float x, y; };
__device__ __forceinline__ cpx cmul(cpx a, cpx b) { cpx r; r.x = a.x * b.x - a.y * b.y; r.y = a.x * b.y + a.y * b.x; return r; }
__device__ __forceinline__ cpx cmulc(cpx a, cpx b) { cpx r; r.x = a.x * b.x + a.y * b.y; r.y = a.y * b.x - a.x * b.y; return r; }
__device__ __forceinline__ int fslot(int i) { return i + (i >> 5); }
#define FSLOTS (FN + (FN >> 5))
template <int NB, bool INV, int ZM = 0>
__device__ __forceinline__ void fft_pass(cpx* x, const cpx* tw, int shift, int tid) {
    for (int g = tid; g < (FN >> NB); g += NT) {
        const int low = g & ((1 << shift) - 1), high = g >> shift;
        const int base = (high << (shift + NB)) | low;
        cpx v[1 << NB];
#pragma unroll
        for (int j = 0; j < (1 << NB); ++j) { if (ZM == 1 && j >= (1 << (NB - 1))) { v[j].x = 0.f; v[j].y = 0.f; } else v[j] = x[fslot(base | (j << shift))]; }
#pragma unroll
        for (int q = 0; q < NB; ++q) {
            const int lb = INV ? q : NB - 1 - q, ml = 1 << lb, gb = shift + lb;
#pragma unroll
            for (int j = 0; j < (1 << NB); ++j) {
                if (j & ml) continue;
                const cpx w = tw[((1 << gb) - 1) + ((base | (j << shift)) & ((1 << gb) - 1))];
                if (!INV) { cpx a = v[j], b2 = v[j + ml], d; v[j].x = a.x + b2.x; v[j].y = a.y + b2.y; d.x = a.x - b2.x; d.y = a.y - b2.y; v[j + ml] = cmul(d, w); }
                else { cpx a = v[j], b2 = cmulc(v[j + ml], w); v[j].x = a.x + b2.x; v[j].y = a.y + b2.y; v[j + ml].x = a.x - b2.x; v[j + ml].y = a.y - b2.y; }
            }
        }
#pragma unroll
        for (int j = 0; j < (1 << NB); ++j) { if (ZM == 2 && j >= (1 << (NB - 1))) continue; x[fslot(base | (j << shift))] = v[j]; }
    }
    __syncthreads();
}
__device__ __forceinline__ void fft_fwd(cpx* x, const cpx* tw, int tid) {
#if FLOG == 13
    fft_pass<3, false>(x, tw, 10, tid); fft_pass<3, false>(x, tw, 7, tid); fft_pass<3, false>(x, tw, 4, tid); fft_pass<4, false>(x, tw, 0, tid);
#elif FLOG == 10
    fft_pass<3, false>(x, tw, 7, tid); fft_pass<3, false>(x, tw, 4, tid); fft_pass<4, false>(x, tw, 0, tid);
#else
    fft_pass<3, false>(x, tw, 6, tid); fft_pass<3, false>(x, tw, 3, tid); fft_pass<3, false>(x, tw, 0, tid);
#endif
}
__device__ __forceinline__ void fft_inv(cpx* x, const cpx* tw, int tid) {
#if FLOG == 13
    fft_pass<4, true>(x, tw, 0, tid); fft_pass<3, true>(x, tw, 4, tid); fft_pass<3, true>(x, tw, 7, tid); fft_pass<3, true>(x, tw, 10, tid);
#elif FLOG == 10
    fft_pass<4, true>(x, tw, 0, tid); fft_pass<3, true>(x, tw, 4, tid); fft_pass<3, true>(x, tw, 7, tid);
#else
    fft_pass<3, true>(x, tw, 0, tid); fft_pass<3, true>(x, tw, 3, tid); fft_pass<3, true>(x, tw, 6, tid);
#endif
}
template <int NB, bool INV>
__device__ __forceinline__ void fft_regs(cpx (&v)[1 << NB], const cpx* tw, int shift, int base) {
#pragma unroll
    for (int q = 0; q < NB; ++q) {
        const int lb = INV ? q : NB - 1 - q, ml = 1 << lb, gb = shift + lb;
#pragma unroll
        for (int j = 0; j < (1 << NB); ++j) {
            if (j & ml) continue;
            const cpx w = tw[((1 << gb) - 1) + ((base | (j << shift)) & ((1 << gb) - 1))];
            if (!INV) { cpx a = v[j], b2 = v[j + ml], d; v[j].x = a.x + b2.x; v[j].y = a.y + b2.y; d.x = a.x - b2.x; d.y = a.y - b2.y; v[j + ml] = cmul(d, w); }
            else { cpx a = v[j], b2 = cmulc(v[j + ml], w); v[j].x = a.x + b2.x; v[j].y = a.y + b2.y; v[j + ml].x = a.x - b2.x; v[j + ml].y = a.y - b2.y; }
        }
    }
}
template <int NB>
__device__ __forceinline__ void fft_mid(cpx* x, const cpx* tw, const cpx (&h)[1 << NB], int tid) {
    if (tid < (FN >> NB)) {
        const int base = tid << NB;
        cpx v[1 << NB];
#pragma unroll
        for (int j = 0; j < (1 << NB); ++j) v[j] = x[fslot(base | j)];
        fft_regs<NB, false>(v, tw, 0, base);
#pragma unroll
        for (int j = 0; j < (1 << NB); ++j) v[j] = cmul(v[j], h[j]);
        fft_regs<NB, true>(v, tw, 0, base);
#pragma unroll
        for (int j = 0; j < (1 << NB); ++j) x[fslot(base | j)] = v[j];
    }
    __syncthreads();
}
#if FLOG == 13 || FLOG == 10
#define FMID 4
#else
#define FMID 3
#endif
__device__ __forceinline__ void fft_conv(cpx* x, const cpx* tw, const cpx (&h)[1 << FMID], int tid) {
#if FLOG == 13
    fft_pass<3, false, 1>(x, tw, 10, tid); fft_pass<3, false>(x, tw, 7, tid); fft_pass<3, false>(x, tw, 4, tid);
    fft_mid<4>(x, tw, h, tid);
    fft_pass<3, true>(x, tw, 4, tid); fft_pass<3, true>(x, tw, 7, tid); fft_pass<3, true, 2>(x, tw, 10, tid);
#elif FLOG == 10
    fft_pass<3, false>(x, tw, 7, tid); fft_pass<3, false>(x, tw, 4, tid);
    fft_mid<4>(x, tw, h, tid);
    fft_pass<3, true>(x, tw, 4, tid); fft_pass<3, true>(x, tw, 7, tid);
#else
    fft_pass<3, false, 1>(x, tw, 6, tid); fft_pass<3, false>(x, tw, 3, tid);
    fft_mid<3>(x, tw, h, tid);
    fft_pass<3, true>(x, tw, 3, tid); fft_pass<3, true, 2>(x, tw, 6, tid);
#endif
}
__device__ __forceinline__ void fft_load_tw(const Params& p, cpx* tw, int tid) {
    for (int i = tid; i < FN - 1; i += NT) { tw[i].x = p.fft_tw[2 * i]; tw[i].y = p.fft_tw[2 * i + 1]; }
}
__device__ __forceinline__ void st_hy_taps(const Params& p, int wv, unsigned char* lds, int l, int bid, int nb) {
    const int tid = TIDX();
    float* hd = (float*)lds;
    const int w = tid >> 8, c = tid & 255;
    float fw[64];
#pragma unroll
    for (int j = 0; j < 64; ++j) fw[j] = p.in[I_HY_FW3][(long)l * 64 * 512 + j * 512 + w * 256 + c];
    const float dec = fabsf(p.in[I_HY_DECAY][(l * 2 + w) * 256 + c]);
    float* circ = p.hspec + (size_t)c * FN * 2;
    for (int u = bid; u < SEQ / 16; u += nb) {
        const int t0 = u * 16;
        for (int e = tid; e < 16 * 64; e += NT) hd[e] = p.hdn2[((size_t)l * SEQ + t0) * 64 + e];
        __syncthreads();
        float vals[16];
#pragma unroll
        for (int r = 0; r < 16; ++r) {
            const int t = t0 + r;
            float f = 0.f;
#pragma unroll
            for (int j = 0; j < 64; ++j) f += hd[r * 64 + j] * fw[j];
            const float tn = (float)((double)t / (double)(SEQ - 1));
            vals[r] = f * expf(-tn * dec);
        }
        if (w == 0) { st8f(circ + t0, vals); st8f(circ + t0 + 8, vals + 8); }
        else {
            float q4[12];
#pragma unroll
            for (int i = 0; i < 12; ++i) q4[i] = vals[12 - i];
#if defined(EMU)
            for (int i = 0; i < 12; ++i) circ[FN - t0 - 12 + i] = q4[i];
#else
            *(f32x4*)(circ + FN - t0 - 12) = (f32x4){q4[0], q4[1], q4[2], q4[3]}; *(f32x4*)(circ + FN - t0 - 8) = (f32x4){q4[4], q4[5], q4[6], q4[7]}; *(f32x4*)(circ + FN - t0 - 4) = (f32x4){q4[8], q4[9], q4[10], q4[11]};
#endif
            circ[FN - t0 - 13] = vals[13]; circ[FN - t0 - 14] = vals[14]; circ[FN - t0 - 15] = vals[15];
            if (t0 >= 1) circ[FN - t0] = vals[0]; else circ[SEQ] = 0.f;
        }
        __syncthreads();
    }
}
__device__ __forceinline__ void st_hy_spec(const Params& p, int wv, unsigned char* lds, int l, int bid, int nb) {
    const int tid = TIDX();
    cpx* x = (cpx*)lds; cpx* tw = x + FSLOTS; float* part = (float*)(tw + FN);
    if (bid < 256) fft_load_tw(p, tw, tid);
    for (int c = bid; c < 256; c += nb) {
        float* H = p.hspec + (size_t)c * FN * 2;
        float asum = 0.f;
        for (int i = tid; i < FN; i += NT) { const float val = H[i]; x[fslot(i)].x = val; x[fslot(i)].y = 0.f; asum += fabsf(val); }
        asum = wave_sum(asum);
        if ((tid & 63) == 0) part[tid >> 6] = asum;
        __syncthreads();
        float tot = 0.f;
        for (int q = 0; q < NW; ++q) tot += part[q];
        const float sc = 1.0f / (tot * (float)FN);
        fft_fwd(x, tw, tid);
        for (int i = tid; i < FN; i += NT) { cpx v = x[fslot(i)]; H[2 * i] = v.x * sc; H[2 * i + 1] = v.y * sc; }
        __syncthreads();
    }
}
#define HT 32
__device__ __forceinline__ void hy_stage(const Params& p, act_t* tl, int pitch, int b, int t0, int c0, int ncg, int tid) {
    for (int e = tid; e < (HT + 2) * ncg; e += NT) {
        const int r = e / ncg, cg = e % ncg, t = t0 - 1 + r;
        act_t* dst = tl + r * pitch + cg * 8;
        if (t >= 0 && t < SEQ) copy8(dst, p.proj + (long)(b * SEQ + t) * PROJ_W + O_HP + c0 + cg * 8);
        else {
#if defined(EMU)
            for (int i = 0; i < 8; ++i) dst[i] = f2a(0.f);
#else
            unsigned zz = 0u; asm volatile("" : "+v"(zz));
            *(u32x4*)dst = (u32x4){zz, zz, zz, zz};
#endif
        }
    }
}
__device__ __forceinline__ float hy_short_lds(const act_t* tl, int pitch, int r, int cc, const float* w3, float bias) {
    return bias + a2f(tl[r * pitch + cc]) * w3[0] + a2f(tl[(r + 1) * pitch + cc]) * w3[1] + a2f(tl[(r + 2) * pitch + cc]) * w3[2];
}
template <int NI>
__device__ __forceinline__ void hy_fetch(const Params& p, A8 (&r8)[NI], int b, int t0, int c0, int ncg, int tid) {
    _Pragma("unroll") for (int q = 0; q < NI; ++q) {
        const int e = tid + q * NT, r = e / ncg, cg = e % ncg, t = t0 - 1 + r;
        const int tc = t < 0 ? 0 : (t >= SEQ ? SEQ - 1 : t);
        if (e < (HT + 2) * ncg) r8[q] = ld_a8(p.proj + (long)(b * SEQ + tc) * PROJ_W + O_HP + c0 + cg * 8);
    }
}
template <int NI>
__device__ __forceinline__ void hy_put(act_t* tl, int pitch, const A8 (&r8)[NI], int t0, int ncg, int tid) {
    _Pragma("unroll") for (int q = 0; q < NI; ++q) {
        const int e = tid + q * NT, r = e / ncg, cg = e % ncg, t = t0 - 1 + r;
        if (e < (HT + 2) * ncg) {
            act_t* dst = tl + r * pitch + cg * 8;
            if (t >= 0 && t < SEQ) st_a8(dst, r8[q]);
            else {
#if defined(EMU)
                for (int i = 0; i < 8; ++i) dst[i] = f2a(0.f);
#else
                unsigned zz = 0u; asm volatile("" : "+v"(zz));
                *(u32x4*)dst = (u32x4){zz, zz, zz, zz};
#endif
            }
        }
    }
}
__device__ __forceinline__ void st_hy_pre(const Params& p, int wv, unsigned char* lds, int l, int bid, int nb) {
    const int tid = TIDX(), wave = tid >> 6, lane = tid & 63;
    float* tile = (float*)lds;
    act_t* tl = (act_t*)(tile + HT * 257);
    const int ch = tid & 255;
    const float* cw = p.in[I_HY_CONV_W] + (long)l * 3 * 768;
    const float w1[3] = {cw[256 + ch], cw[768 + 256 + ch], cw[1536 + 256 + ch]}, w2[3] = {cw[512 + ch], cw[768 + 512 + ch], cw[1536 + 512 + ch]};
    const float b1 = p.in[I_HY_CONV_B][l * 768 + 256 + ch], b2 = p.in[I_HY_CONV_B][l * 768 + 512 + ch];
    constexpr int NI = ((HT + 2) * 64 + NT - 1) / NT;
    const int total = BATCH * (SEQ / HT);
    A8 r8[NI];
    if (bid < total) hy_fetch<NI>(p, r8, bid / (SEQ / HT), (bid % (SEQ / HT)) * HT, 256, 64, tid);
    for (int u = bid; u < total; u += nb) {
        const int b = u / (SEQ / HT), t0 = (u % (SEQ / HT)) * HT;
        hy_put<NI>(tl, 520, r8, t0, 64, tid);
        __syncthreads();
        if (u + nb < total) hy_fetch<NI>(p, r8, (u + nb) / (SEQ / HT), ((u + nb) % (SEQ / HT)) * HT, 256, 64, tid);
        {
            const int r0 = (tid >> 8) * (HT / 2);
            float pa0 = a2f(tl[r0 * 520 + ch]), pa1 = a2f(tl[(r0 + 1) * 520 + ch]), pb0 = a2f(tl[r0 * 520 + 256 + ch]), pb1 = a2f(tl[(r0 + 1) * 520 + 256 + ch]);
            for (int i = 0; i < HT / 2; ++i) {
                const int r = r0 + i;
                const float na = a2f(tl[(r + 2) * 520 + ch]), nb2 = a2f(tl[(r + 2) * 520 + 256 + ch]);
                tile[r * 257 + ch] = (b1 + pa0 * w1[0] + pa1 * w1[1] + na * w1[2]) * (b2 + pb0 * w2[0] + pb1 * w2[1] + nb2 * w2[2]);
                pa0 = pa1; pa1 = na; pb0 = pb1; pb1 = nb2;
            }
        }
        __syncthreads();
        for (int c = wave * 2 + (lane >> 5); c < 256; c += 2 * NW) p.hz[((size_t)(b * 256 + c)) * SEQ + t0 + (lane & 31)] = f2a(tile[(lane & 31) * 257 + c]);
        __syncthreads();
    }
}
__device__ __forceinline__ void st_hy_fft(const Params& p, int wv, unsigned char* lds, int l, int bid, int nb) {
    const int tid = TIDX();
    cpx* x = (cpx*)lds; cpx* tw = x + FSLOTS;
    const int NPAIR = (BATCH + 1) / 2;
    if (bid < 256) fft_load_tw(p, tw, tid);
    for (int c = bid; c < 256; c += nb) {
        const float* H = p.hspec + (size_t)c * FN * 2;
        cpx h[1 << FMID];
        _Pragma("unroll") for (int j = 0; j < (1 << FMID); ++j) { h[j].x = 0.f; h[j].y = 0.f; }
        if (tid < (FN >> FMID)) {
            _Pragma("unroll") for (int j2 = 0; j2 < (1 << FMID); j2 += 2) { float t4[4]; ld4f(t4, H + 2 * ((tid << FMID) + j2)); h[j2].x = t4[0]; h[j2].y = t4[1]; h[j2 + 1].x = t4[2]; h[j2 + 1].y = t4[3]; }
        }
        A8 za, zb;
        if (tid < SEQ / 8) { za = ld_a8(p.hz + ((size_t)(0 * 256 + c)) * SEQ + tid * 8); zb = ld_a8(p.hz + ((size_t)((1 < BATCH ? 1 : 0) * 256 + c)) * SEQ + tid * 8); }
#pragma unroll 1
        for (int q = 0; q < NPAIR; ++q) {
            const int b1 = 2 * q, b2 = 2 * q + 1;
            act_t* z1 = p.hz + ((size_t)(b1 * 256 + c)) * SEQ;
            act_t* z2 = p.hz + ((size_t)((b2 < BATCH ? b2 : b1) * 256 + c)) * SEQ;
            for (int i8 = tid; i8 < SEQ / 8; i8 += NT) {
                float a[8] = {0.f, 0.f, 0.f, 0.f, 0.f, 0.f, 0.f, 0.f}, c2[8] = {0.f, 0.f, 0.f, 0.f, 0.f, 0.f, 0.f, 0.f};
                if (i8 < SEQ / 8) { a8f(a, za); if (b2 < BATCH) a8f(c2, zb); }
                for (int j = 0; j < 8; ++j) { cpx v; v.x = a[j]; v.y = c2[j]; x[fslot(i8 * 8 + j)] = v; }
            }
            if (q + 1 < NPAIR && tid < SEQ / 8) {
                const int n1 = 2 * q + 2, n2 = 2 * q + 3;
                za = ld_a8(p.hz + ((size_t)(n1 * 256 + c)) * SEQ + tid * 8); zb = ld_a8(p.hz + ((size_t)((n2 < BATCH ? n2 : n1) * 256 + c)) * SEQ + tid * 8);
            }
            __syncthreads();
            fft_conv(x, tw, h, tid);
            for (int i8 = tid; i8 < SEQ / 8; i8 += NT) {
                float a[8], c2[8];
                for (int j = 0; j < 8; ++j) { cpx v = x[fslot(i8 * 8 + j)]; a[j] = v.x; c2[j] = v.y; }
                store8(z1 + i8 * 8, a); if (b2 < BATCH) store8(z2 + i8 * 8, c2);
            }
            __syncthreads();
        }
    }
}
__device__ __forceinline__ void st_hy_post(const Params& p, int wv, unsigned char* lds, int l, int bid, int nb) {
    const int tid = TIDX(), wave = tid >> 6, lane = tid & 63;
    float* tile = (float*)lds;
    act_t* tl = (act_t*)(tile + HT * 257);
    const int ch = tid & 255;
    const float* cw = p.in[I_HY_CONV_W] + (long)l * 3 * 768;
    const float w0[3] = {cw[ch], cw[768 + ch], cw[1536 + ch]}, w1[3] = {cw[256 + ch], cw[768 + 256 + ch], cw[1536 + 256 + ch]}, w2[3] = {cw[512 + ch], cw[768 + 512 + ch], cw[1536 + 512 + ch]};
    const float b0 = p.in[I_HY_CONV_B][l * 768 + ch], b1 = p.in[I_HY_CONV_B][l * 768 + 256 + ch], b2 = p.in[I_HY_CONV_B][l * 768 + 512 + ch];
    const float hb = p.in[I_HY_BIAS][l * 256 + ch];
    constexpr int NI = ((HT + 2) * 96 + NT - 1) / NT, NC = 256 / (2 * NW);
    const int total = BATCH * (SEQ / HT);
    A8 r8[NI]; act_t yv[NC];
    auto fetch = [&](int uu) __attribute__((always_inline)) {
        const int b = uu / (SEQ / HT), t0 = (uu % (SEQ / HT)) * HT;
        hy_fetch<NI>(p, r8, b, t0, 0, 96, tid);
        _Pragma("unroll") for (int k = 0; k < NC; ++k) { const int c = wave * 2 + (lane >> 5) + k * 2 * NW; yv[k] = p.hz[((size_t)(b * 256 + c)) * SEQ + t0 + (lane & 31)]; }
    };
    if (bid < total) fetch(bid);
    for (int u = bid; u < total; u += nb) {
        const int b = u / (SEQ / HT), t0 = (u % (SEQ / HT)) * HT;
        hy_put<NI>(tl, 776, r8, t0, 96, tid);
        _Pragma("unroll") for (int k = 0; k < NC; ++k) { const int c = wave * 2 + (lane >> 5) + k * 2 * NW; tile[(lane & 31) * 257 + c] = a2f(yv[k]); }
        __syncthreads();
        if (u + nb < total) fetch(u + nb);
        {
            const int r0 = (tid >> 8) * (HT / 2);
            float q0[3], q1[3];
            for (int g = 0; g < 3; ++g) { q0[g] = a2f(tl[r0 * 776 + g * 256 + ch]); q1[g] = a2f(tl[(r0 + 1) * 776 + g * 256 + ch]); }
            for (int i = 0; i < HT / 2; ++i) {
                const int r = r0 + i;
                float q2[3];
                for (int g = 0; g < 3; ++g) q2[g] = a2f(tl[(r + 2) * 776 + g * 256 + ch]);
                const float x0 = b0 + q0[0] * w0[0] + q1[0] * w0[1] + q2[0] * w0[2];
                const float z = (b1 + q0[1] * w1[0] + q1[1] * w1[1] + q2[1] * w1[2]) * (b2 + q0[2] * w2[0] + q1[2] * w2[1] + q2[2] * w2[2]);
                p.mix[(long)(b * SEQ + t0 + r) * DM + 768 + ch] = f2a(x0 * (tile[r * 257 + ch] + z * hb));
                for (int g = 0; g < 3; ++g) { q0[g] = q1[g]; q1[g] = q2[g]; }
            }
        }
        __syncthreads();
    }
}
#define RC 128
#define NCH_CTX (CTXL / RC)
#define NCH_LAT (SEQ / RC)
#define NCHK (NCH_CTX + NCH_LAT)
__device__ __forceinline__ int chunk_row0(int b, int cidx) { return cidx < NCH_CTX ? NLAT + b * CTXL + cidx * RC : b * SEQ + (cidx - NCH_CTX) * RC; }
__device__ __forceinline__ int chunk_at(int dir, int k) { if (!dir) return k; return k < NCH_CTX ? NCH_CTX - 1 - k : NCH_CTX + (NCH_LAT - 1 - (k - NCH_CTX)); }
__device__ __forceinline__ f32x4 mm16(f32x4 acc, const act_t* A, int pa, const act_t* Bt, int pb, int K, int lane) {
#if defined(EMU)
    for (int r = 0; r < 4; ++r) {
        const act_t* ap = A + (4 * (lane >> 4) + r) * pa; const act_t* bp = Bt + (lane & 15) * pb;
        float sacc = 0.f;
        for (int k = 0; k < K; ++k) sacc += a2f(ap[k]) * a2f(bp[k]);
        acc[r] += sacc;
    }
    return acc;
#else
    const act_t* ap = A + (lane & 15) * pa + 8 * (lane >> 4); const act_t* bp = Bt + (lane & 15) * pb + 8 * (lane >> 4);
#pragma unroll 8
    for (int k0 = 0; k0 < K; k0 += 32) {
        const bf16x8v a = *(const bf16x8v*)(ap + k0), b = *(const bf16x8v*)(bp + k0);
        acc = __builtin_amdgcn_mfma_f32_16x16x32_bf16(a, b, acc, 0, 0, 0);
    }
    return acc;
#endif
}
#if !defined(EMU)
typedef short s4v __attribute__((ext_vector_type(4)));
__device__ __forceinline__ bf16x8v tr_frag(const act_t* T, int pitch, int k0, int c0, int lane) {
    const int g = lane >> 4, q = (lane >> 2) & 3, pp = lane & 3;
    LAS s4v* a = (LAS s4v*)(T + (k0 + 8 * g + q) * pitch + c0 + 4 * pp);
    const s4v lo = __builtin_amdgcn_ds_read_tr16_b64_v4i16(a);
    const s4v hi = __builtin_amdgcn_ds_read_tr16_b64_v4i16((LAS s4v*)((LAS act_t*)a + 4 * pitch));
    return (bf16x8v){lo[0], lo[1], lo[2], lo[3], hi[0], hi[1], hi[2], hi[3]};
}
__device__ __forceinline__ unsigned pk_bf16_sw(float lo, float hi) {
    unsigned a = __builtin_bit_cast(unsigned, lo), b = __builtin_bit_cast(unsigned, hi);
    a += 0x7fffu + ((a >> 16) & 1u); b += 0x7fffu + ((b >> 16) & 1u);
    return (b & 0xffff0000u) | (a >> 16);
}
__device__ __forceinline__ bf16x8v tr_frag2(const act_t* T, int pitch, int ra, int rb, int c0, int lane) {
    const int g = lane >> 4, q = (lane >> 2) & 3, pp = lane & 3;
    const s4v lo = __builtin_amdgcn_ds_read_tr16_b64_v4i16((LAS s4v*)(T + (ra + 4 * g + q) * pitch + c0 + 4 * pp));
    const s4v hi = __builtin_amdgcn_ds_read_tr16_b64_v4i16((LAS s4v*)(T + (rb + 4 * g + q) * pitch + c0 + 4 * pp));
    return (bf16x8v){lo[0], lo[1], lo[2], lo[3], hi[0], hi[1], hi[2], hi[3]};
}
__device__ __forceinline__ f32x4 mm16_trb(f32x4 acc, const act_t* A, int pa, const act_t* T, int pitch, int c0, int K, int lane) {
    const act_t* ap = A + (lane & 15) * pa + 8 * (lane >> 4);
#pragma unroll 4
    for (int k0 = 0; k0 < K; k0 += 32) acc = __builtin_amdgcn_mfma_f32_16x16x32_bf16(*(const bf16x8v*)(ap + k0), tr_frag(T, pitch, k0, c0, lane), acc, 0, 0, 0);
    return acc;
}
#endif
#define RPK (RC + 8)
#define RPQ 72
__device__ __forceinline__ void st_ret_a(const Params& p, int wv, unsigned char* lds, int l, int bid, int nb) {
    const int tid = TIDX(), wave = tid >> 6, lane = tid & 63;
#if defined(EMU)
    act_t* kTf = (act_t*)lds; act_t* kTb = kTf + 64 * RPK; act_t* vT = kTb + 64 * RPK;
#else
    act_t* ksf = (act_t*)lds; act_t* ksb = ksf + RC * RPQ; act_t* vs = ksb + RC * RPQ;
#endif
    const int total = BATCH * 4 * NCHK;
    A8 pk[2], pv[2];
    auto fetch = [&](int uu) __attribute__((always_inline)) {
        const int row0 = chunk_row0(uu / (NCHK * 4), uu % NCHK), h = (uu / NCHK) & 3;
        _Pragma("unroll") for (int q = 0; q < 2; ++q) {
            const int e = tid + q * NT, sx = e >> 3, d8 = (e & 7) * 8;
            const act_t* pr = p.proj + (long)(row0 + sx) * PROJ_W;
            pk[q] = ld_a8(pr + O_RK + h * 64 + d8); pv[q] = ld_a8(pr + O_RV + h * 64 + d8);
        }
    };
    if (bid < total) fetch(bid);
    for (int u = bid; u < total; u += nb) {
        const int cidx = u % NCHK, h = (u / NCHK) & 3, b = u / (NCHK * 4);
        const float lgf = log_sigmoid_f(p.in[I_RET_DECAY][(l * 2 + 0) * 4 + h]), lgb = log_sigmoid_f(p.in[I_RET_DECAY][(l * 2 + 1) * 4 + h]);
        _Pragma("unroll") for (int q = 0; q < 2; ++q) {
            const int e = tid + q * NT, sx = e >> 3, d8 = (e & 7) * 8;
            float kv[8], vv[8];
            a8f(kv, pk[q]); a8f(vv, pv[q]);
            const float df = exp_fast(lgf * (float)(RC - 1 - sx)), db = exp_fast(lgb * (float)sx);
#if defined(EMU)
            for (int j = 0; j < 8; ++j) {
                kTf[(d8 + j) * RPK + sx] = f2a(kv[j] * df);
                kTb[(d8 + j) * RPK + sx] = f2a(kv[j] * db);
                vT[(d8 + j) * RPK + sx] = f2a(vv[j]);
            }
#else
            {
                float kf[8], kb[8];
                for (int j = 0; j < 8; ++j) { kf[j] = kv[j] * df; kb[j] = kv[j] * db; }
                store8(ksf + sx * RPQ + d8, kf); store8(ksb + sx * RPQ + d8, kb); st_a8(vs + sx * RPQ + d8, pv[q]);
            }
#endif
        }
        if (u + nb < total) fetch(u + nb);
        __syncthreads();
        {
            const int dir = wave >> 2, db = wave & 3;
            float* D = p.retD + ((size_t)(((b * 4 + h) * 2 + dir) * NCHK + cidx)) * 4096;
#if defined(EMU)
            const act_t* Ak = (dir ? kTb : kTf) + 16 * db * RPK;
            for (int n = 0; n < 4; ++n) {
                f32x4 acc = (f32x4){0.f, 0.f, 0.f, 0.f};
                acc = mm16(acc, Ak, RPK, vT + 16 * n * RPK, RPK, RC, lane);
                for (int r = 0; r < 4; ++r) D[(16 * db + 4 * (lane >> 4) + r) * 64 + 16 * n + (lane & 15)] = acc[r];
            }
#else
            {
                const act_t* ksd = dir ? ksb : ksf;
                f32x4 acc[4];
                float zf = 0.f; asm volatile("" : "+v"(zf));
                _Pragma("unroll") for (int n = 0; n < 4; ++n) acc[n] = (f32x4){zf, zf, zf, zf};
                _Pragma("unroll") for (int k0 = 0; k0 < RC; k0 += 32) {
                    const bf16x8v af = tr_frag(ksd, RPQ, k0, 16 * db, lane);
                    _Pragma("unroll") for (int n = 0; n < 4; ++n) acc[n] = __builtin_amdgcn_mfma_f32_16x16x32_bf16(af, tr_frag(vs, RPQ, k0, 16 * n, lane), acc[n], 0, 0, 0);
                }
                _Pragma("unroll") for (int n = 0; n < 4; ++n) for (int r = 0; r < 4; ++r) D[(16 * db + 4 * (lane >> 4) + r) * 64 + 16 * n + (lane & 15)] = acc[n][r];
            }
#endif
        }
        __syncthreads();
    }
}
__device__ __forceinline__ void st_ret_b(const Params& p, int wv, int l, int bid, int nb, bool dry = false) {
    const int tid = TIDX();
    for (int it = bid * NT + tid; it < BATCH * 4 * 2 * 4096; it += nb * NT) {
        const int el = it & 4095, seq = it >> 12, dir = seq & 1, h = (seq >> 1) & 3;
        const float gC = expf((float)RC * log_sigmoid_f(p.in[I_RET_DECAY][(l * 2 + dir) * 4 + h]));
        float* base = p.retD + (size_t)seq * NCHK * 4096 + el;
        float S = 0.f;
#pragma unroll 1
        for (int kb = 0; kb < NCHK; kb += 17) {
            float Dv[17];
#pragma unroll
            for (int j = 0; j < 17; ++j) Dv[j] = (kb + j < NCHK) ? base[(size_t)chunk_at(dir, kb + j) * 4096] : 0.f;
#pragma unroll
            for (int j = 0; j < 17; ++j) if (kb + j < NCHK) { if (!dry) base[(size_t)chunk_at(dir, kb + j) * 4096] = S; S = gC * S + Dv[j]; }
        }
#if !defined(EMU)
        if (dry) asm volatile("" :: "v"(S));
#endif
    }
}
__device__ __forceinline__ void st_ret_c(const Params& p, int wv, unsigned char* lds, int l, int bid, int nb) {
    const int tid = TIDX(), wave = tid >> 6, lane = tid & 63;
    const bool need_ctx = (l != DEPTH - 1);
    act_t* qs = (act_t*)lds; act_t* ks = qs + RC * RPQ; act_t* P = qs;
#if defined(EMU)
    act_t* vT = ks + RC * RPQ; act_t* qt = vT + 64 * RPK; act_t* ST = qt + RC * RPK; float* mt = (float*)(ST + 64 * RPK);
#else
    act_t* vs = ks + RC * RPQ; act_t* qt = vs + RC * RPQ; act_t* Ss = qt + RC * RPK; float* mt = (float*)(Ss + RC * RPQ);
#endif
    float* of = (float*)qt;
    const int ncpu = need_ctx ? NCHK : NCH_LAT, c_lo = need_ctx ? 0 : NCH_CTX;
    const int total = BATCH * 4 * ncpu;
    A8 pq[2], pk[2], pv[2];
    auto fetch = [&](int uu) __attribute__((always_inline)) {
        const int row0 = chunk_row0(uu / (ncpu * 4), c_lo + uu % ncpu), h = (uu / ncpu) & 3;
        _Pragma("unroll") for (int q = 0; q < 2; ++q) {
            const int e = tid + q * NT, sx = e >> 3, d8 = (e & 7) * 8;
            const act_t* pr = p.proj + (long)(row0 + sx) * PROJ_W;
            pq[q] = ld_a8(pr + O_RQ + h * 64 + d8); pk[q] = ld_a8(pr + O_RK + h * 64 + d8); pv[q] = ld_a8(pr + O_RV + h * 64 + d8);
        }
    };
    int u = bid;
    if (u < total) fetch(u);
    while (u < total) {
        const int cidx = c_lo + u % ncpu, h = (u / ncpu) & 3, b = u / (ncpu * 4);
        const int row0 = chunk_row0(b, cidx);
        const float lgf = log_sigmoid_f(p.in[I_RET_DECAY][(l * 2 + 0) * 4 + h]), lgb = log_sigmoid_f(p.in[I_RET_DECAY][(l * 2 + 1) * 4 + h]);
        f32x4 sv[4];
        _Pragma("unroll") for (int q = 0; q < 4; ++q) {
            const int e = tid + q * NT, dir = e >> 10, d = (e >> 4) & 63, e4 = (e & 15) * 4;
            sv[q] = *(const f32x4*)(p.retD + ((size_t)(((b * 4 + h) * 2 + dir) * NCHK + cidx)) * 4096 + d * 64 + e4);
        }
        const int ft = tid >> 2, fc0 = h * 64 + (tid & 3) * 16;
        A8 gq[2];
        gq[0] = ld_a8(p.proj + (long)(row0 + ft) * PROJ_W + O_RG + fc0); gq[1] = ld_a8(p.proj + (long)(row0 + ft) * PROJ_W + O_RG + fc0 + 8);
        _Pragma("unroll") for (int q = 0; q < 2; ++q) {
            const int e = tid + q * NT, sx = e >> 3, d8 = (e & 7) * 8;
            float qv[8], vv[8], q1[8], q2[8];
            a8f(qv, pq[q]); a8f(vv, pv[q]);
            st_a8(qs + sx * RPQ + d8, pq[q]);
            st_a8(ks + sx * RPQ + d8, pk[q]);
            const float e1 = exp_fast(lgf * (float)(sx + 1)), e2 = exp_fast(lgb * (float)(RC - sx));
#if defined(EMU)
            for (int j = 0; j < 8; ++j) vT[(d8 + j) * RPK + sx] = f2a(vv[j]);
#else
            (void)vv; st_a8(vs + sx * RPQ + d8, pv[q]);
#endif
            for (int j = 0; j < 8; ++j) { q1[j] = qv[j] * e1; q2[j] = qv[j] * e2; }
            store8(qt + sx * RPK + d8, q1); store8(qt + sx * RPK + 64 + d8, q2);
        }
        _Pragma("unroll") for (int q = 0; q < 4; ++q) {
            const int e = tid + q * NT, dir = e >> 10, d = (e >> 4) & 63, e4 = (e & 15) * 4;
#if defined(EMU)
            for (int j = 0; j < 4; ++j) ST[(e4 + j) * RPK + dir * 64 + d] = f2a(sv[q][j]);
#else
            { const float s4[4] = {sv[q][0], sv[q][1], sv[q][2], sv[q][3]}; store4(Ss + (dir * 64 + d) * RPQ + e4, s4); }
#endif
        }
        if (tid < 2 * RC - 1) { const int dl = tid - (RC - 1); mt[tid] = dl > 0 ? exp_fast(lgf * (float)dl) : (dl < 0 ? exp_fast(lgb * (float)(-dl)) : 2.0f); }
        __syncthreads();
        f32x4 racc[8];
#if defined(EMU)
        for (int n = 0; n < 8; ++n) { racc[n] = (f32x4){0.f, 0.f, 0.f, 0.f}; racc[n] = mm16(racc[n], qs + 16 * wave * RPQ, RPQ, ks + 16 * n * RPQ, RPQ, 64, lane); }
        __syncthreads();
        for (int n = 0; n < 8; ++n) for (int r = 0; r < 4; ++r) {
            const int t = 16 * wave + 4 * (lane >> 4) + r, sx = 16 * n + (lane & 15);
            P[t * RPK + sx] = f2a(racc[n][r] * mt[t - sx + RC - 1]);
        }
        __syncthreads();
#else
        for (int n = 0; n < 8; ++n) { racc[n] = (f32x4){0.f, 0.f, 0.f, 0.f}; racc[n] = mm16(racc[n], ks + 16 * n * RPQ, RPQ, qs + 16 * wave * RPQ, RPQ, 64, lane); }
        bf16x8v pa[4];
        {
            const int t = 16 * wave + (lane & 15), g4 = 4 * (lane >> 4);
            _Pragma("unroll") for (int n2 = 0; n2 < 4; ++n2) {
                float w8[8];
                _Pragma("unroll") for (int r = 0; r < 4; ++r) {
                    w8[r] = racc[2 * n2][r] * mt[t - (32 * n2 + g4 + r) + RC - 1];
                    w8[4 + r] = racc[2 * n2 + 1][r] * mt[t - (32 * n2 + 16 + g4 + r) + RC - 1];
                }
                const unsigned u0 = pk_bf16_sw(w8[0], w8[1]), u1 = pk_bf16_sw(w8[2], w8[3]), u2 = pk_bf16_sw(w8[4], w8[5]), u3 = pk_bf16_sw(w8[6], w8[7]);
                pa[n2] = __builtin_bit_cast(bf16x8v, (u32x4){u0, u1, u2, u3});
            }
        }
#endif
        f32x4 oacc[4];
        for (int n = 0; n < 4; ++n) {
            oacc[n] = (f32x4){0.f, 0.f, 0.f, 0.f};
#if defined(EMU)
            oacc[n] = mm16(oacc[n], P + 16 * wave * RPK, RPK, vT + 16 * n * RPK, RPK, RC, lane);
            oacc[n] = mm16(oacc[n], qt + 16 * wave * RPK, RPK, ST + 16 * n * RPK, RPK, 128, lane);
#else
            _Pragma("unroll") for (int n2 = 0; n2 < 4; ++n2) oacc[n] = __builtin_amdgcn_mfma_f32_16x16x32_bf16(pa[n2], tr_frag2(vs, RPQ, 32 * n2, 32 * n2 + 16, 16 * n, lane), oacc[n], 0, 0, 0);
            oacc[n] = mm16_trb(oacc[n], qt + 16 * wave * RPK, RPK, Ss, RPQ, 16 * n, 128, lane);
#endif
        }
        __syncthreads();
        for (int n = 0; n < 4; ++n) for (int r = 0; r < 4; ++r) of[(16 * wave + 4 * (lane >> 4) + r) * 68 + 16 * n + (lane & 15)] = oacc[n][r];
#if !defined(EMU)
        __builtin_amdgcn_sched_barrier(0);
#endif
        const int un = u + nb;
        if (un < total) fetch(un);
        __syncthreads();
        {
            float ov[16], gg[16], gb2[16], gt[16], o[16];
            for (int q4 = 0; q4 < 4; ++q4) ld4f(ov + 4 * q4, of + ft * 68 + (tid & 3) * 16 + 4 * q4);
            ld8(gg, p.in[I_RET_GN_G] + l * 256 + fc0); ld8(gg + 8, p.in[I_RET_GN_G] + l * 256 + fc0 + 8);
            ld8(gb2, p.in[I_RET_GN_B] + l * 256 + fc0); ld8(gb2 + 8, p.in[I_RET_GN_B] + l * 256 + fc0 + 8);
            a8f(gt, gq[0]); a8f(gt + 8, gq[1]);
            float sm = 0.f;
            for (int j = 0; j < 16; ++j) sm += ov[j];
            const float mu = quad_sum(sm) * (1.0f / 64.0f);
            float sq = 0.f;
            for (int j = 0; j < 16; ++j) { ov[j] -= mu; sq += ov[j] * ov[j]; }
            const float rstd = 1.0f / sqrtf(quad_sum(sq) * (1.0f / 64.0f) + LN_EPS);
            for (int j = 0; j < 16; ++j) o[j] = (ov[j] * rstd * gg[j] + gb2[j]) * silu_fast(gt[j]);
            store8(p.mix + (long)(row0 + ft) * DM + fc0, o); store8(p.mix + (long)(row0 + ft) * DM + fc0 + 8, o + 8);
        }
        __syncthreads();
        u = un;
    }
}
#define GC 64
#define GNCH_CTX (CTXL / GC)
#define GNCH_LAT (SEQ / GC)
#define GNCHK (GNCH_CTX + GNCH_LAT)
__device__ __forceinline__ int gchunk_row0(int b, int cidx) { return cidx < GNCH_CTX ? NLAT + b * CTXL + cidx * GC : b * SEQ + (cidx - GNCH_CTX) * GC; }
__device__ __forceinline__ int gchunk_at(int dir, int k) { if (!dir) return k; return k < GNCH_CTX ? GNCH_CTX - 1 - k : GNCH_CTX + (GNCH_LAT - 1 - (k - GNCH_CTX)); }
#define GP 72
__device__ __forceinline__ void gla_scan(float* cs, int tid);
__device__ __forceinline__ void gla_cumsum(const Params& p, float* cs, int row0, int h, int tid) {
    for (int e = tid; e < 2 * GC * 8; e += NT) {
        const int dir = e >> 9, t = (e >> 3) & 63, d4 = (e & 7) * 4;
        *(f32x4*)(cs + dir * GC * 32 + t * 32 + d4) = *(const f32x4*)(p.loga + (long)(row0 + t) * 256 + dir * 128 + h * 32 + d4);
    }
    __syncthreads();
    gla_scan(cs, tid);
}
__device__ __forceinline__ void gla_scan(float* cs, int tid) {
    {
        float* seg = cs + 2 * GC * 32;
        const int col = tid & 63, sg = tid >> 6, dir = col >> 5, d = col & 31;
        float* c = cs + dir * GC * 32 + d;
        float run = 0.f;
        for (int q = 0; q < 8; ++q) { const int t = dir ? GC - 1 - (sg * 8 + q) : sg * 8 + q; run += c[t * 32]; c[t * 32] = run; }
        seg[sg * 64 + col] = run;
        __syncthreads();
        float off = 0.f;
        for (int q = 0; q < sg; ++q) off += seg[q * 64 + col];
        if (sg) for (int q = 0; q < 8; ++q) { const int t = dir ? GC - 1 - (sg * 8 + q) : sg * 8 + q; c[t * 32] += off; }
    }
    __syncthreads();
}
__device__ __forceinline__ void st_gla_a(const Params& p, int wv, unsigned char* lds, int l, int bid, int nb) {
    const int tid = TIDX(), wave = tid >> 6, lane = tid & 63;
#if defined(EMU)
    float* cs = (float*)lds; act_t* kTf = (act_t*)(cs + 2 * GC * 32 + 512); act_t* kTb = kTf + 32 * GP; act_t* vT = kTb + 32 * GP;
#else
    float* cs = (float*)lds; act_t* ksf = (act_t*)(cs + 2 * GC * 32 + 512); act_t* ksb = ksf + GC * 40; act_t* vs = ksb + GC * 40;
#endif
    const int total = BATCH * 4 * GNCHK;
    f32x4 lg[2];
    auto fetch_lg = [&](int uu) __attribute__((always_inline)) {
        const int row0 = gchunk_row0(uu / (GNCHK * 4), uu % GNCHK), h = (uu / GNCHK) & 3;
        _Pragma("unroll") for (int q = 0; q < 2; ++q) { const int t = (tid >> 3) & 63, d4 = (tid & 7) * 4; lg[q] = *(const f32x4*)(p.loga + (long)(row0 + t) * 256 + q * 128 + h * 32 + d4); }
    };
    if (bid < total) fetch_lg(bid);
    for (int u = bid; u < total; u += nb) {
        const int cidx = u % GNCHK, h = (u / GNCHK) & 3, b = u / (GNCHK * 4);
        const int row0 = gchunk_row0(b, cidx);
        A8 rk, rv;
        if (tid < GC * 4) rk = ld_a8(p.proj + (long)(row0 + (tid >> 2)) * PROJ_W + O_GK + h * 32 + (tid & 3) * 8);
        rv = ld_a8(p.proj + (long)(row0 + (tid >> 3)) * PROJ_W + O_GV + h * 64 + (tid & 7) * 8);
        _Pragma("unroll") for (int q = 0; q < 2; ++q) { const int t = (tid >> 3) & 63, d4 = (tid & 7) * 4; *(f32x4*)(cs + q * GC * 32 + t * 32 + d4) = lg[q]; }
        __syncthreads();
        gla_scan(cs, tid);
        if (tid < GC * 4) {
            const int sx = tid >> 2, d8 = (tid & 3) * 8;
            float kv[8];
            a8f(kv, rk);
#if defined(EMU)
            for (int j = 0; j < 8; ++j) {
                const int d = d8 + j;
                kTf[d * GP + sx] = f2a(kv[j] * exp_fast(cs[(GC - 1) * 32 + d] - cs[sx * 32 + d]));
                kTb[d * GP + sx] = f2a(kv[j] * exp_fast(cs[GC * 32 + d] - cs[GC * 32 + sx * 32 + d]));
            }
#else
            {
                float kf[8], kb[8];
                for (int j = 0; j < 8; ++j) {
                    const int d = d8 + j;
                    kf[j] = kv[j] * exp_fast(cs[(GC - 1) * 32 + d] - cs[sx * 32 + d]);
                    kb[j] = kv[j] * exp_fast(cs[GC * 32 + d] - cs[GC * 32 + sx * 32 + d]);
                }
                store8(ksf + sx * 40 + d8, kf); store8(ksb + sx * 40 + d8, kb);
            }
#endif
        }
        {
            const int sx = tid >> 3, e8 = (tid & 7) * 8;
#if defined(EMU)
            float vv[8];
            a8f(vv, rv);
            for (int j = 0; j < 8; ++j) vT[(e8 + j) * GP + sx] = f2a(vv[j]);
#else
            st_a8(vs + sx * GP + e8, rv);
#endif
        }
        const size_t ub = (size_t)(b * 4 + h) * 2;
        if (tid < 64) { const int dir = tid >> 5, d = tid & 31; p.glaE[((ub + dir) * GNCHK + cidx) * 32 + d] = expf(dir ? cs[GC * 32 + d] : cs[(GC - 1) * 32 + d]); }
        if (u + nb < total) fetch_lg(u + nb);
        __syncthreads();
        {
            const int dir = wave >> 2, db = (wave >> 1) & 1, nh = wave & 1;
            float* D = p.glaD + ((ub + dir) * GNCHK + cidx) * 2048;
            for (int q = 0; q < 2; ++q) {
                const int n = nh * 2 + q;
                f32x4 acc = (f32x4){0.f, 0.f, 0.f, 0.f};
#if defined(EMU)
                acc = mm16(acc, (dir ? kTb : kTf) + 16 * db * GP, GP, vT + 16 * n * GP, GP, GC, lane);
#else
                _Pragma("unroll") for (int k0 = 0; k0 < GC; k0 += 32) acc = __builtin_amdgcn_mfma_f32_16x16x32_bf16(tr_frag(dir ? ksb : ksf, 40, k0, 16 * db, lane), tr_frag(vs, GP, k0, 16 * n, lane), acc, 0, 0, 0);
#endif
                for (int r = 0; r < 4; ++r) D[(16 * db + 4 * (lane >> 4) + r) * 64 + 16 * n + (lane & 15)] = acc[r];
            }
        }
        __syncthreads();
    }
}
__device__ __forceinline__ void st_gla_b(const Params& p, int wv, int l, int bid, int nb, bool dry = false) {
    const int tid = TIDX();
    for (int it = bid * NT + tid; it < BATCH * 4 * 2 * 2048; it += nb * NT) {
        const int el = it & 2047, seq = it >> 11, dir = seq & 1, d = el >> 6;
        float* base = p.glaD + (size_t)seq * GNCHK * 2048 + el;
        const float* eb = p.glaE + (size_t)seq * GNCHK * 32 + d;
        float S = 0.f;
#pragma unroll 1
        for (int kb = 0; kb < GNCHK; kb += 17) {
            float Dv[17], Ev[17];
#pragma unroll
            for (int j = 0; j < 17; ++j) { const int c = gchunk_at(dir, kb + j < GNCHK ? kb + j : 0); Dv[j] = base[(size_t)c * 2048]; Ev[j] = eb[c * 32]; }
#pragma unroll
            for (int j = 0; j < 17; ++j) if (kb + j < GNCHK) { if (!dry) base[(size_t)gchunk_at(dir, kb + j) * 2048] = S; S = Ev[j] * S + Dv[j]; }
        }
#if !defined(EMU)
        if (dry) asm volatile("" :: "v"(S));
#endif
    }
}
__device__ __forceinline__ void st_gla_c(const Params& p, int wv, unsigned char* lds, int l, int bid, int nb) {
    const int tid = TIDX(), wave = tid >> 6, lane = tid & 63;
    const bool need_ctx = (l != DEPTH - 1);
    float* cs = (float*)lds; act_t* qt = (act_t*)(cs + 2 * GC * 32 + 512); act_t* kt = qt + GC * GP; act_t* vT = kt + GC * GP; act_t* P = vT + 64 * GP; act_t* ST = P + GC * GP;
    float* of = (float*)(ST + 64 * GP);
    const int ncpu = need_ctx ? GNCHK : GNCH_LAT, c_lo = need_ctx ? 0 : GNCH_CTX;
    const int total = BATCH * 4 * ncpu;
    int u = bid;
    f32x4 lg[2];
    if (u < total) {
        const int row0 = gchunk_row0(u / (ncpu * 4), c_lo + u % ncpu), h = (u / ncpu) & 3;
        _Pragma("unroll") for (int q = 0; q < 2; ++q) { const int t = (tid >> 3) & 63, d4 = (tid & 7) * 4; lg[q] = *(const f32x4*)(p.loga + (long)(row0 + t) * 256 + q * 128 + h * 32 + d4); }
    }
    while (u < total) {
        const int cidx = c_lo + u % ncpu, h = (u / ncpu) & 3, b = u / (ncpu * 4);
        const int row0 = gchunk_row0(b, cidx);
        const int sx = tid >> 3, c8 = (tid & 7) * 8, dir = c8 >> 5, d8 = c8 & 31;
        float qv[8], kv[8], vv[8];
        {
            const act_t* pr = p.proj + (long)(row0 + sx) * PROJ_W;
            load8f(qv, pr + O_GQ + h * 32 + d8); load8f(kv, pr + O_GK + h * 32 + d8); load8f(vv, pr + O_GV + h * 64 + c8);
        }
        const size_t ub = (size_t)(b * 4 + h) * 2;
        f32x4 sv[2];
        _Pragma("unroll") for (int q = 0; q < 2; ++q) { const int d = (tid >> 4) & 31, e4 = (tid & 15) * 4; sv[q] = *(const f32x4*)(p.glaD + ((ub + q) * GNCHK + cidx) * 2048 + d * 64 + e4); }
        const int ft = tid >> 3, fc0 = h * 64 + (tid & 7) * 8;
        const A8 gq = ld_a8(p.proj + (long)(row0 + ft) * PROJ_W + O_GR + fc0);
        _Pragma("unroll") for (int q = 0; q < 2; ++q) { const int t = (tid >> 3) & 63, d4 = (tid & 7) * 4; *(f32x4*)(cs + q * GC * 32 + t * 32 + d4) = lg[q]; }
        __syncthreads();
        gla_scan(cs, tid);
        {
            float qo[8], ko[8];
            for (int j = 0; j < 8; ++j) {
                const float cv = cs[dir * GC * 32 + sx * 32 + d8 + j];
                qo[j] = qv[j] * exp_fast(cv); ko[j] = kv[j] * exp_fast(-cv);
#if defined(EMU)
                vT[(c8 + j) * GP + sx] = f2a(vv[j]);
#endif
            }
            store8(qt + sx * GP + c8, qo); store8(kt + sx * GP + c8, ko);
#if !defined(EMU)
            store8(vT + sx * GP + c8, vv);
#endif
        }
        _Pragma("unroll") for (int q = 0; q < 2; ++q) {
            const int d = (tid >> 4) & 31, e4 = (tid & 15) * 4;
#if defined(EMU)
            for (int j = 0; j < 4; ++j) ST[(e4 + j) * GP + q * 32 + d] = f2a(sv[q][j]);
#else
            { const float s4[4] = {sv[q][0], sv[q][1], sv[q][2], sv[q][3]}; store4(ST + (q * 32 + d) * GP + e4, s4); }
#endif
        }
        __syncthreads();
#if defined(EMU)
        {
            const int rb = wave & 3, nh = wave >> 2;
            for (int q = 0; q < 2; ++q) {
                const int n = nh * 2 + q;
                f32x4 rf = (f32x4){0.f, 0.f, 0.f, 0.f}, rbk = (f32x4){0.f, 0.f, 0.f, 0.f};
                rf = mm16(rf, qt + 16 * rb * GP, GP, kt + 16 * n * GP, GP, 32, lane);
                rbk = mm16(rbk, qt + 16 * rb * GP + 32, GP, kt + 16 * n * GP + 32, GP, 32, lane);
                for (int r = 0; r < 4; ++r) {
                    const int t = 16 * rb + 4 * (lane >> 4) + r, sxx = 16 * n + (lane & 15);
                    P[t * GP + sxx] = f2a((sxx <= t ? rf[r] : 0.f) + (sxx >= t ? rbk[r] : 0.f));
                }
            }
        }
        __syncthreads();
        {
            const int rb = wave & 3, nh = wave >> 2;
            for (int q = 0; q < 2; ++q) {
                const int n = nh * 2 + q;
                f32x4 acc = (f32x4){0.f, 0.f, 0.f, 0.f};
#if defined(EMU)
                acc = mm16(acc, P + 16 * rb * GP, GP, vT + 16 * n * GP, GP, GC, lane);
                acc = mm16(acc, qt + 16 * rb * GP, GP, ST + 16 * n * GP, GP, 64, lane);
#else
                acc = mm16_trb(acc, P + 16 * rb * GP, GP, vT, GP, 16 * n, GC, lane);
                acc = mm16_trb(acc, qt + 16 * rb * GP, GP, ST, GP, 16 * n, 64, lane);
#endif
                for (int r = 0; r < 4; ++r) of[(16 * rb + 4 * (lane >> 4) + r) * 68 + 16 * n + (lane & 15)] = acc[r];
            }
        }
#else
        {
            const int rb = wave & 3, nh = wave >> 2;
            bf16x8v pa[2];
            {
                const int t = 16 * rb + (lane & 15), g4 = 4 * (lane >> 4);
                _Pragma("unroll") for (int n2 = 0; n2 < 2; ++n2) {
                    float w8[8];
                    _Pragma("unroll") for (int hh = 0; hh < 2; ++hh) {
                        const int n = 2 * n2 + hh;
                        f32x4 rf = (f32x4){0.f, 0.f, 0.f, 0.f}, rbk = (f32x4){0.f, 0.f, 0.f, 0.f};
                        rf = mm16(rf, kt + 16 * n * GP, GP, qt + 16 * rb * GP, GP, 32, lane);
                        rbk = mm16(rbk, kt + 16 * n * GP + 32, GP, qt + 16 * rb * GP + 32, GP, 32, lane);
                        _Pragma("unroll") for (int r = 0; r < 4; ++r) { const int sxx = 16 * n + g4 + r; w8[4 * hh + r] = (sxx <= t ? rf[r] : 0.f) + (sxx >= t ? rbk[r] : 0.f); }
                    }
                    const unsigned u0 = pk_bf16_sw(w8[0], w8[1]), u1 = pk_bf16_sw(w8[2], w8[3]), u2 = pk_bf16_sw(w8[4], w8[5]), u3 = pk_bf16_sw(w8[6], w8[7]);
                    pa[n2] = __builtin_bit_cast(bf16x8v, (u32x4){u0, u1, u2, u3});
                }
            }
            for (int q = 0; q < 2; ++q) {
                const int n = nh * 2 + q;
                f32x4 acc = (f32x4){0.f, 0.f, 0.f, 0.f};
                acc = __builtin_amdgcn_mfma_f32_16x16x32_bf16(pa[0], tr_frag2(vT, GP, 0, 16, 16 * n, lane), acc, 0, 0, 0);
                acc = __builtin_amdgcn_mfma_f32_16x16x32_bf16(pa[1], tr_frag2(vT, GP, 32, 48, 16 * n, lane), acc, 0, 0, 0);
                acc = mm16_trb(acc, qt + 16 * rb * GP, GP, ST, GP, 16 * n, 64, lane);
                for (int r = 0; r < 4; ++r) of[(16 * rb + 4 * (lane >> 4) + r) * 68 + 16 * n + (lane & 15)] = acc[r];
            }
        }
#endif
        const int un = u + nb;
        if (un < total) {
            const int nrow0 = gchunk_row0(un / (ncpu * 4), c_lo + un % ncpu), nh2 = (un / ncpu) & 3;
            _Pragma("unroll") for (int q = 0; q < 2; ++q) { const int t = (tid >> 3) & 63, d4 = (tid & 7) * 4; lg[q] = *(const f32x4*)(p.loga + (long)(nrow0 + t) * 256 + q * 128 + nh2 * 32 + d4); }
        }
        __syncthreads();
        {
            float ov[8], ng[8], gt[8], o[8];
            ld4f(ov, of + ft * 68 + (tid & 7) * 8); ld4f(ov + 4, of + ft * 68 + (tid & 7) * 8 + 4);
            ld8(ng, p.in[I_GLA_NORM_G] + l * 256 + fc0);
            a8f(gt, gq);
            float sq = 0.f;
            for (int j = 0; j < 8; ++j) sq += ov[j] * ov[j];
            const float rstd = 1.0f / sqrtf(oct_sum(sq) * (1.0f / 64.0f) + LN_EPS);
            for (int j = 0; j < 8; ++j) o[j] = ov[j] * rstd * ng[j] * silu_fast(gt[j]);
            store8(p.mix + (long)(row0 + ft) * DM + 256 + fc0, o);
        }
        __syncthreads();
        u = un;
    }
}
#define SC 64
#define SNCHK ((CTXL + SEQ) / SC)
#define SNCOL (BATCH * SNCHK)
#define SNLATC (BATCH * (SNCHK - GNCH_CTX))
__device__ __forceinline__ int s5_col_b(int col) { return col < SNLATC ? col / (SNCHK - GNCH_CTX) : (col - SNLATC) / GNCH_CTX; }
__device__ __forceinline__ int s5_col_c(int col) { return col < SNLATC ? GNCH_CTX + col % (SNCHK - GNCH_CTX) : (col - SNLATC) % GNCH_CTX; }
#define SNCT ((SNCOL + 15) / 16)
#define SPU (SC * 16 + 8)
#define SPH 264
__device__ __forceinline__ void st_s5_tables(const Params& p, int wv, int l, int bid, int nb) {
    const int tid = TIDX();
    for (int it = bid * NT + tid; it < 16 * 127 * 64; it += nb * NT) {
        const int p4 = (it & 3) * 4, pq = (it >> 2) & 15, dl = (it >> 6) % 127, g = it / (127 * 64);
        const int delta = dl - 63;
        float val[4] = {0.f, 0.f, 0.f, 0.f};
        for (int d = 0; d < 2; ++d) {
            if (d == 0 ? delta < 0 : delta > 0) continue;
            const int tau = delta < 0 ? -delta : delta, pg = (l * 2 + d) * 16 + g;
            const float* cre = p.in[I_S5_C_RE] + ((size_t)pg * 16 + pq) * 64; const float* cim = p.in[I_S5_C_IM] + ((size_t)pg * 16 + pq) * 64;
            const float* pw = p.s5pw + ((size_t)pg * 65 + tau) * 128;
#pragma unroll 2
            for (int n0 = 0; n0 < 64; n0 += 4) {
                float c4[4], s4[4], w8[8];
                ld4f(c4, cre + n0); ld4f(s4, cim + n0); ld4f(w8, pw + 2 * n0); ld4f(w8 + 4, pw + 2 * n0 + 4);
                _Pragma("unroll") for (int q = 0; q < 4; ++q) {
                    const float* tb = p.s5tab + ((size_t)pg * 64 + n0 + q) * 36;
                    float br[4], bi[4];
                    ld4f(br, tb + 4 + p4); ld4f(bi, tb + 20 + p4);
                    const float wr = w8[2 * q], wi = w8[2 * q + 1];
                    _Pragma("unroll") for (int j = 0; j < 4; ++j) {
                        const float vr = wr * br[j] - wi * bi[j], vi = wr * bi[j] + wi * br[j];
                        val[j] += c4[q] * vr - s4[q] * vi;
                    }
                }
            }
        }
        store4(p.s5Tc + (size_t)it * 4, val);
    }
    for (int it = bid * NT + tid; it < 16 * 1024 * 32; it += nb * NT) {
        const int k8 = (it & 31) * 8, row = (it >> 5) & 1023, g = it >> 15;
        const int d = k8 >> 7, ri = (k8 >> 6) & 1, n0 = k8 & 63, i = row >> 4, pq = row & 15, pg = (l * 2 + d) * 16 + g;
        const int ex = d ? SC - i : i + 1;
        float cr[8], ci[8], w[16], o[8];
        ld8(cr, p.in[I_S5_C_RE] + ((size_t)pg * 16 + pq) * 64 + n0); ld8(ci, p.in[I_S5_C_IM] + ((size_t)pg * 16 + pq) * 64 + n0);
        ld8(w, p.s5pw + (((size_t)pg * 65 + ex) * 64 + n0) * 2); ld8(w + 8, p.s5pw + (((size_t)pg * 65 + ex) * 64 + n0) * 2 + 8);
        _Pragma("unroll") for (int j = 0; j < 8; ++j) { const float wr = w[2 * j], wi = w[2 * j + 1]; o[j] = ri ? -(cr[j] * wi + ci[j] * wr) : (cr[j] * wr - ci[j] * wi); }
        store8(p.s5Win + (size_t)it * 8, o);
    }
    for (int it = bid * NT + tid; it < 16 * 2 * 128 * 128; it += nb * NT) {
        const int k8 = (it & 127) * 8, nri = (it >> 7) & 127, d = (it >> 14) & 1, g = it >> 15;
        const int j = k8 >> 4, pp0 = k8 & 15, ri = nri >> 6, n = nri & 63, pg = (l * 2 + d) * 16 + g;
        const int ex = d ? j : SC - 1 - j;
        const float* tb = p.s5tab + ((size_t)pg * 64 + n) * 36;
        const float wr = p.s5pw[(((size_t)pg * 65 + ex) * 64 + n) * 2], wi = p.s5pw[(((size_t)pg * 65 + ex) * 64 + n) * 2 + 1];
        float br[8], bi[8], o[8];
        ld8(br, tb + 4 + pp0); ld8(bi, tb + 20 + pp0);
        _Pragma("unroll") for (int q = 0; q < 8; ++q) o[q] = ri ? (wr * bi[q] + wi * br[q]) : (wr * br[q] - wi * bi[q]);
        store8(p.s5Wend + (size_t)it * 8, o);
    }
}
__device__ __forceinline__ void s5_load_cols(const Params& p, act_t* U, int g, int ct, int tid) {
    for (int e = tid; e < 16 * SC * 2; e += NT) {
        const int hf = e & 1, j = (e >> 1) & 63, cl = e >> 7, col = ct * 16 + cl;
        act_t* dst = U + cl * SPU + j * 16 + hf * 8;
        if (SNCOL % 16 == 0 || col < SNCOL) copy8(dst, p.proj + (long)(gchunk_row0(s5_col_b(col), s5_col_c(col)) + j) * PROJ_W + O_SU + g * 16 + hf * 8);
        else { float z8[8] = {0.f, 0.f, 0.f, 0.f, 0.f, 0.f, 0.f, 0.f}; store8(dst, z8); }
    }
}
__device__ __forceinline__ void st_s5_a(const Params& p, int wv, unsigned char* lds, int l, int bid, int nb, int dry = 0) {
    const int tid = TIDX(), wave = tid >> 6, lane = tid & 63;
    act_t* U = (act_t*)lds;
    const bool xmap = (nb % 16) == 0; const int half = nb / 16;
    const int g0 = xmap ? 2 * (bid % 8) + (bid / 8) / half : 0, j0 = xmap ? (bid / 8) % half : 0;
    (void)dry;
    for (int kk = 0; ; kk += 3) {
        int ct[3], g = 0, n = 0;
        for (int k = 0; k < 3; ++k) {
            int c, gg;
            if (xmap) { gg = g0; c = j0 + (kk + k) * half; if (c >= SNCT) break; }
            else { const int u = bid + (kk + k) * nb; if (u >= 16 * SNCT) break; c = u % SNCT; gg = u / SNCT; }
            if (k > 0 && gg != g) break;
            g = gg; ct[k] = c; n = k + 1;
        }
        if (n == 0) break;
        for (int k = 0; k < n; ++k) s5_load_cols(p, U + k * 16 * SPU, g, ct[k], tid);
        __syncthreads();
#if !defined(EMU)
        f32x4 a4[3][2][2];
        {
            const int pq = lane & 15, kq = lane >> 4;
            const act_t* ub = U + pq * SPU + 8 * kq;
            const act_t* w0 = p.s5Wend + ((size_t)(g * 2) * 128 + 16 * wave + pq) * 1024 + 8 * kq;
            const act_t* w1 = w0 + (size_t)128 * 1024;
            float zf = 0.f; asm volatile("" : "+v"(zf));
            _Pragma("unroll") for (int k = 0; k < 3; ++k) { a4[k][0][0] = (f32x4){zf, zf, zf, zf}; a4[k][0][1] = a4[k][0][0]; a4[k][1][0] = a4[k][0][0]; a4[k][1][1] = a4[k][0][0]; }
            const bool three = n > 2, two = n > 1;
            const int krot = (j0 * 32) & 511;
            _Pragma("unroll 4") for (int kx = 0; kx < 512; kx += 32) {
                const int k0 = (kx + krot) & 511;
                const bf16x8v a00 = *(const bf16x8v*)(w0 + k0), a01 = *(const bf16x8v*)(w0 + 512 + k0), a10 = *(const bf16x8v*)(w1 + k0), a11 = *(const bf16x8v*)(w1 + 512 + k0);
                _Pragma("unroll") for (int k = 0; k < 3; ++k) {
                    if ((k == 1 && !two) || (k == 2 && !three)) continue;
                    const bf16x8v b0 = *(const bf16x8v*)(ub + k * 16 * SPU + k0), b1 = *(const bf16x8v*)(ub + k * 16 * SPU + 512 + k0);
                    a4[k][0][0] = __builtin_amdgcn_mfma_f32_16x16x32_bf16(a00, b0, a4[k][0][0], 0, 0, 0);
                    a4[k][0][1] = __builtin_amdgcn_mfma_f32_16x16x32_bf16(a01, b1, a4[k][0][1], 0, 0, 0);
                    a4[k][1][0] = __builtin_amdgcn_mfma_f32_16x16x32_bf16(a10, b0, a4[k][1][0], 0, 0, 0);
                    a4[k][1][1] = __builtin_amdgcn_mfma_f32_16x16x32_bf16(a11, b1, a4[k][1][1], 0, 0, 0);
                }
            }
        }
#endif
        _Pragma("unroll") for (int k = 0; k < 3; ++k) {
            if (k >= n) continue;
            _Pragma("unroll") for (int dir = 0; dir < 2; ++dir) {
#if defined(EMU)
                f32x4 acc = (f32x4){0.f, 0.f, 0.f, 0.f};
                acc = mm16(acc, p.s5Wend + ((size_t)(g * 2 + dir) * 128 + 16 * wave) * 1024, 1024, U + k * 16 * SPU, SPU, 1024, lane);
#else
                const f32x4 acc = a4[k][dir][0] + a4[k][dir][1];
#endif
                const int col = ct[k] * 16 + (lane & 15);
                if (col < SNCOL) {
                    const int b = s5_col_b(col), cidx = s5_col_c(col);
                    float* S = p.s5S + ((size_t)((b * 16 + g) * 2 + dir) * SNCHK + cidx) * 128;
                    for (int r = 0; r < 4; ++r) S[16 * wave + 4 * (lane >> 4) + r] = acc[r];
                }
            }
        }
        __syncthreads();
        if (!xmap && n < 3) {   kk -= (3 - n); }
    }
}
__device__ __forceinline__ void st_s5_b(const Params& p, int wv, int l, int bid, int nb, bool dry = false) {
    const int tid = TIDX();
    for (int it = bid * NT + tid; it < BATCH * 16 * 2 * 64; it += nb * NT) {
        const int n = it & 63, seq = it >> 6, dir = seq & 1, g = (seq >> 1) & 15, pg = (l * 2 + dir) * 16 + g;
        const float lr = p.s5pw[(((size_t)pg * 65 + SC) * 64 + n) * 2], li = p.s5pw[(((size_t)pg * 65 + SC) * 64 + n) * 2 + 1];
        float* base = p.s5S + (size_t)seq * SNCHK * 128 + n;
        float hr = 0.f, hi = 0.f;
#pragma unroll 1
        for (int kb = 0; kb < SNCHK; kb += 17) {
            float sr[17], si[17];
#pragma unroll
            for (int j = 0; j < 17; ++j) { const int c = gchunk_at(dir, kb + j < SNCHK ? kb + j : 0); sr[j] = base[c * 128]; si[j] = base[c * 128 + 64]; }
#pragma unroll
            for (int j = 0; j < 17; ++j) if (kb + j < SNCHK) {
                const int c = gchunk_at(dir, kb + j);
                if (!dry) { base[c * 128] = hr; base[c * 128 + 64] = hi; }
                const float nr = lr * hr - li * hi + sr[j], ni = lr * hi + li * hr + si[j];
                hr = nr; hi = ni;
            }
        }
#if !defined(EMU)
        if (dry) asm volatile("" :: "v"(hr), "v"(hi));
#endif
    }
}
__device__ __forceinline__ f32x4 mm16_toep(f32x4 acc, const act_t* Tc, int i, const act_t* U, int lane) {
#if defined(EMU)
    for (int r = 0; r < 4; ++r) {
        const int pq = 4 * (lane >> 4) + r, cl = lane & 15;
        float sacc = 0.f;
        for (int j = 0; j < SC; ++j) for (int pp = 0; pp < 16; ++pp) sacc += a2f(Tc[((i - j + 63) * 16 + pq) * 16 + pp]) * a2f(U[cl * SPU + j * 16 + pp]);
        acc[r] += sacc;
    }
    return acc;
#else
    const int pq = lane & 15, kq = lane >> 4;
    const act_t* bp = U + (lane & 15) * SPU + 8 * kq;
    for (int ks = 0; ks < SC / 2; ++ks) {
        const int j = 2 * ks + (kq >> 1);
        const bf16x8v a = *(const bf16x8v*)(Tc + ((i - j + 63) * 16 + pq) * 16 + 8 * (kq & 1)), b = *(const bf16x8v*)(bp + ks * 32);
        acc = __builtin_amdgcn_mfma_f32_16x16x32_bf16(a, b, acc, 0, 0, 0);
    }
    return acc;
#endif
}
__device__ __forceinline__ void st_s5_c(const Params& p, int wv, unsigned char* lds, int l, int bid, int nb) {
    const int tid = TIDX(), wave = tid >> 6, lane = tid & 63;
    const bool need_ctx = (l != DEPTH - 1);
    act_t* U = (act_t*)lds; act_t* Hc = U + 16 * SPU; act_t* Tc = Hc + 16 * SPH;
    const bool xmap = (nb % 16) == 0; const int half = nb / 16;
    const int g0 = xmap ? 2 * (bid % 8) + (bid / 8) / half : 0, j0 = xmap ? (bid / 8) % half : 0;
    const int nct = need_ctx ? SNCT : (SNLATC + 15) / 16;
    int g_cur = -1;
    for (int kk = 0; ; ++kk) {
        int ct, g;
        if (xmap) { g = g0; ct = j0 + kk * half; if (ct >= nct) break; }
        else { const int u = bid + kk * nb; if (u >= 16 * nct) break; ct = u % nct; g = u / nct; }
        s5_load_cols(p, U, g, ct, tid);
        for (int e = tid; e < 16 * 64; e += NT) {
            const int k4 = (e & 63) * 4, cl = e >> 6, col = ct * 16 + cl;
            float v[4] = {0.f, 0.f, 0.f, 0.f};
            if (col < SNCOL) { const f32x4 sv = *(const f32x4*)(p.s5S + ((size_t)((s5_col_b(col) * 16 + g) * 2 + (k4 >> 7)) * SNCHK + s5_col_c(col)) * 128 + (k4 & 127)); v[0] = sv[0]; v[1] = sv[1]; v[2] = sv[2]; v[3] = sv[3]; }
            store4(Hc + cl * SPH + k4, v);
        }
        if (g != g_cur) { for (int e = tid; e < 127 * 32; e += NT) copy8(Tc + e * 8, p.s5Tc + (size_t)g * 127 * 256 + e * 8); g_cur = g; }
        __syncthreads();
        const int col = ct * 16 + (lane & 15);
        const bool valid = col < SNCOL && (need_ctx || col < SNLATC);
        const int row0 = valid ? gchunk_row0(s5_col_b(col), s5_col_c(col)) : 0;
        float dsk[4];
        for (int r = 0; r < 4; ++r) dsk[r] = p.in[I_S5_D][l * 256 + g * 16 + 4 * (lane >> 4) + r];
#if defined(EMU)
        for (int i = wave; i < SC; i += NW) {
            f32x4 acc = (f32x4){0.f, 0.f, 0.f, 0.f};
            acc = mm16_toep(acc, Tc, i, U, lane);
            acc = mm16(acc, p.s5Win + ((size_t)g * 1024 + i * 16) * 256, 256, Hc, SPH, 256, lane);
            if (valid) {
                float o[4];
                for (int r = 0; r < 4; ++r) {
                    const int pq = 4 * (lane >> 4) + r;
                    const float yv = acc[r] + dsk[r] * a2f(U[(lane & 15) * SPU + i * 16 + pq]);
                    o[r] = gelu_fast(yv);
                }
                store4(p.gbuf + (size_t)(row0 + i) * 256 + g * 16 + 4 * (lane >> 4), o);
            }
        }
#else
        {
            const int pq = lane & 15, kq = lane >> 4;
            const act_t* ub = U + pq * SPU + 8 * kq;
            const act_t* hb = Hc + pq * SPH + 8 * kq;
            _Pragma("unroll 1") for (int q0 = 0; q0 < 8; q0 += 4) {
                const int i0 = wave + 8 * q0;
                const act_t* wp = p.s5Win + ((size_t)g * 1024 + i0 * 16 + pq) * 256 + 8 * kq;
                bf16x8v wa[4][4];
                _Pragma("unroll") for (int q = 0; q < 4; ++q) _Pragma("unroll") for (int k = 0; k < 4; ++k) wa[q][k] = *(const bf16x8v*)(wp + (size_t)q * 8 * 16 * 256 + k * 32);
                f32x4 acc[4];
                { float zf = 0.f; asm volatile("" : "+v"(zf)); _Pragma("unroll") for (int q = 0; q < 4; ++q) acc[q] = (f32x4){zf, zf, zf, zf}; }
                const act_t* tb = Tc + ((i0 + 63 - (kq >> 1)) * 16 + pq) * 16 + 8 * (kq & 1);
                {
                    bf16x8v S[4][4];
                    _Pragma("unroll") for (int m = 0; m < 4; ++m) _Pragma("unroll") for (int u = 0; u < 4; ++u) S[m][u] = *(const bf16x8v*)(tb + (8 * m - 2 * u) * 256);
                    _Pragma("unroll") for (int kb = 0; kb < SC / 8; ++kb) {
                        if (kb > 0) { _Pragma("unroll") for (int u = 0; u < 4; ++u) S[(-kb) & 3][u] = *(const bf16x8v*)(tb + (-8 * kb - 2 * u) * 256); }
                        _Pragma("unroll") for (int u = 0; u < 4; ++u) {
                            const bf16x8v b = *(const bf16x8v*)(ub + (4 * kb + u) * 32);
                            _Pragma("unroll") for (int q = 0; q < 4; ++q) acc[q] = __builtin_amdgcn_mfma_f32_16x16x32_bf16(S[(q - kb) & 3][u], b, acc[q], 0, 0, 0);
                        }
                    }
                }
                _Pragma("unroll") for (int k = 0; k < 4; ++k) {
                    const bf16x8v b = *(const bf16x8v*)(hb + k * 32);
                    _Pragma("unroll") for (int q = 0; q < 4; ++q) acc[q] = __builtin_amdgcn_mfma_f32_16x16x32_bf16(wa[q][k], b, acc[q], 0, 0, 0);
                }
                _Pragma("unroll") for (int q = 0; q < 4; ++q) _Pragma("unroll") for (int k = 0; k < 4; ++k) wa[q][k] = *(const bf16x8v*)(wp + (size_t)q * 8 * 16 * 256 + 128 + k * 32);
                _Pragma("unroll") for (int k = 0; k < 4; ++k) {
                    const bf16x8v b = *(const bf16x8v*)(hb + 128 + k * 32);
                    _Pragma("unroll") for (int q = 0; q < 4; ++q) acc[q] = __builtin_amdgcn_mfma_f32_16x16x32_bf16(wa[q][k], b, acc[q], 0, 0, 0);
                }
                if (valid) {
                    _Pragma("unroll") for (int q = 0; q < 4; ++q) {
                        const int i = i0 + 8 * q;
                        float o[4];
                        _Pragma("unroll") for (int r = 0; r < 4; ++r) {
                            const float yv = acc[q][r] + dsk[r] * a2f(U[pq * SPU + i * 16 + 4 * kq + r]);
                            o[r] = gelu_fast(yv);
                        }
                        store4(p.gbuf + (size_t)(row0 + i) * 256 + g * 16 + 4 * kq, o);
                    }
                }
            }
        }
#endif
        __syncthreads();
    }
}
__device__ __forceinline__ int scan_row(int b, int dir, int step, bool& isctx) {
    isctx = step < CTXL;
    if (isctx) { int t = dir ? CTXL - 1 - step : step; return NLAT + b * CTXL + t; }
    int s2 = step - CTXL; int t = dir ? SEQ - 1 - s2 : s2; return b * SEQ + t;
}
__device__ __forceinline__ void st_scan_ret(const Params& p, int wv, int l, int bid, int nb) {
    const int tid = TIDX();
    const bool need_ctx = (l != DEPTH - 1);
    for (int it = bid * NT + tid; it < BATCH * 256; it += nb * NT) {
        const int b = it >> 8, h = (it >> 6) & 3, e = it & 63;
        for (int dir = 0; dir < 2; ++dir) {
            float dec = p.in[I_RET_DECAY][(l * 2 + dir) * 4 + h];
            float g = expf(log_sigmoid_f(dec));
            float S[64];
            for (int d = 0; d < 64; ++d) S[d] = 0.f;
            for (int step = 0; step < CTXL + SEQ; ++step) {
                bool isctx; const int row = scan_row(b, dir, step, isctx);
                const act_t* pr = p.proj + (long)row * PROJ_W;
                float v = a2f(pr[O_RV + h * 64 + e]);
                float o = 0.f;
                for (int d = 0; d < 64; ++d) {
                    float k = a2f(pr[O_RK + h * 64 + d]);
                    float q = a2f(pr[O_RQ + h * 64 + d]);
                    S[d] = g * S[d] + k * v;
                    o += q * S[d];
                }
                if (!isctx || need_ctx) {
                    float* dst = p.osum + (long)row * 256 + h * 64 + e;
                    if (dir == 0) *dst = o; else *dst += o;
                }
            }
        }
    }
}
__device__ __forceinline__ void st_scan_gla(const Params& p, int wv, int l, int bid, int nb) {
    const int tid = TIDX();
    const bool need_ctx = (l != DEPTH - 1);
    for (int it = bid * NT + tid; it < BATCH * 256; it += nb * NT) {
        const int b = it >> 8, h = (it >> 6) & 3, e = it & 63;
        for (int dir = 0; dir < 2; ++dir) {
            float S[32];
            for (int d = 0; d < 32; ++d) S[d] = 0.f;
            for (int step = 0; step < CTXL + SEQ; ++step) {
                bool isctx; const int row = scan_row(b, dir, step, isctx);
                const act_t* pr = p.proj + (long)row * PROJ_W;
                const float* la = p.loga + (long)row * 256 + dir * 128 + h * 32;
                float v = a2f(pr[O_GV + h * 64 + e]);
                float o = 0.f;
                for (int d = 0; d < 32; ++d) {
                    float k = a2f(pr[O_GK + h * 32 + d]);
                    float q = a2f(pr[O_GQ + h * 32 + d]);
                    S[d] = expf(la[d]) * S[d] + k * v;
                    o += q * S[d];
                }
                if (!isctx || need_ctx) {
                    float* dst = p.osum + (long)row * 256 + h * 64 + e;
                    if (dir == 0) *dst = o; else *dst += o;
                }
            }
        }
    }
}
__device__ __forceinline__ void st_scan_s5(const Params& p, int wv, unsigned char* lds, int l, int bid, int nb) {
    const bool need_ctx = (l != DEPTH - 1);
    float* sh = (float*)lds;
    const int tid = TIDX(), gl = tid >> 6, n = tid & 63;
    float* hsh = sh + gl * 128;
    for (int blk = bid; blk < BATCH * 2; blk += nb) {
        const int b = blk >> 1, g = (blk & 1) * 8 + gl;
        for (int dir = 0; dir < 2; ++dir) {
            const int pg = (l * 2 + dir) * 16 + g;
            const float* tb = p.s5tab + ((size_t)pg * 64 + n) * 36;
            float bbr[16], bbi[16];
            for (int q = 0; q < 16; ++q) { bbr[q] = tb[4 + q]; bbi[q] = tb[20 + q]; }
            const float flr = tb[0], fli = tb[1];
            const float* cre = p.in[I_S5_C_RE] + ((long)pg * 16 + (n & 15)) * 64;
            const float* cim = p.in[I_S5_C_IM] + ((long)pg * 16 + (n & 15)) * 64;
            float hr = 0.f, hi = 0.f;
            for (int step = 0; step < CTXL + SEQ; ++step) {
                bool isctx; const int row = scan_row(b, dir, step, isctx);
                const act_t* uu = p.proj + (long)row * PROJ_W + O_SU + g * 16;
                float br = 0.f, bi = 0.f;
                for (int q = 0; q < 16; ++q) { float uv = a2f(uu[q]); br += bbr[q] * uv; bi += bbi[q] * uv; }
                float nr = flr * hr - fli * hi + br;
                float ni = flr * hi + fli * hr + bi;
                hr = nr; hi = ni;
                hsh[n] = hr; hsh[64 + n] = hi;
                __syncthreads();
                if (n < 16 && (!isctx || need_ctx)) {
                    float yv = 0.f;
                    for (int m = 0; m < 64; ++m) yv += cre[m] * hsh[m] - cim[m] * hsh[64 + m];
                    float* dst = p.osum + (long)row * 256 + g * 16 + n;
                    if (dir == 0) *dst = yv; else *dst += yv;
                }
                __syncthreads();
            }
        }
    }
}
__device__ __forceinline__ void st_finish(const Params& p, int wv, int l, int which) {
    const int tid = TIDX(), wave = tid >> 6, lane = tid & 63;
    const int nrows = (l == DEPTH - 1) ? NLAT : NTOK;
    for (int base = BIDX() * NW; base < nrows; base += NBLK() * NW) {
        const int row = base + wave;
        const act_t* pr = p.proj + (long)row * PROJ_W;
        for (int h = 0; h < 4; ++h) {
            int c = h * 64 + lane;
            float* op = p.osum + (long)row * 256 + c;
            float o = *op;
            if (which == 0) {
                float mu = wave_sum(o) * (1.0f / 64.0f);
                float d = o - mu;
                float var = wave_sum(d * d) * (1.0f / 64.0f);
                float yv = d * (1.0f / sqrtf(var + LN_EPS)) * p.in[I_RET_GN_G][l * 256 + c] + p.in[I_RET_GN_B][l * 256 + c];
                p.mix[(long)row * DM + c] = f2a(yv * silu_f(a2f(pr[O_RG + c])));
            } else if (which == 1) {
                float ms = wave_sum(o * o) * (1.0f / 64.0f);
                float yv = o * (1.0f / sqrtf(ms + LN_EPS)) * p.in[I_GLA_NORM_G][l * 256 + c];
                p.mix[(long)row * DM + 256 + c] = f2a(yv * silu_f(a2f(pr[O_GR + c])));
            } else {
                float yv = o + p.in[I_S5_D][l * 256 + c] * a2f(pr[O_SU + c]);
                *op = gelu_tanh_f(yv);
            }
        }
    }
}

#ifdef EMU
#define PHASE(call) emu_launch(EMU_GRID, NT, [&]() { unsigned char* lds = emu_lds(); (void)lds; call; })
#else
#define PHASE(call) do { call; GRID_BAR(); } while (0)
#endif

#ifndef PHMASK
#define PHMASK 0xffffffffu
#endif
#ifndef PREFIX_K
#define PREFIX_K 0
#endif
#define PHASEN(i, call) do { if (((PHMASK >> (i)) & 1u) && (KSTOP == 0 || ((i) < 3 ? (i) : 3 + 20 * lcur_ + ((i) - 3)) <= KSTOP)) PHASE(call); } while (0)
#ifndef DUPSEL
#define DUPSEL 0
#endif
#ifndef DUPN
#define DUPN 3
#endif
#define ROT(o) ((bidx + (o)) % nbk)
#define REP(k, call) do { call; if (DUPSEL == (k)) for (int _r = 0; _r < DUPN; ++_r) { call; } } while (0)
#ifdef EMU
static const int KSTOP = 0;
static void forward(const Params& p)
#else
template <int KSTOP> __global__ void __launch_bounds__(NT, 2) fwd_megakernel(Params p)
#endif
{
#ifndef EMU
    extern __shared__ __attribute__((aligned(16))) unsigned char lds[];
    {
        volatile LAS unsigned* misc = (volatile LAS unsigned*)((LAS unsigned char*)lds + LDS_MISC);
        if (threadIdx.x < 64) misc[threadIdx.x] = 0u;
        __syncthreads();
    }
    (void)xcd_barrier_post(p.ctl, (volatile LAS unsigned*)((LAS unsigned char*)lds + LDS_MISC) + 8);
    const int wv = __builtin_amdgcn_readfirstlane(threadIdx.x >> 6);
#define nbk NBLK()
#define bidx BIDX()
#else
    const int nbk = EMU_GRID; const int wv = 0; (void)wv;
#define bidx ((int)blockIdx.x)
#endif
    int lcur_ = 0;
    PHASEN(1, REP(1, st_prep(p, wv, lds)));
    PHASEN(2, REP(2, (st_prep2(p, wv), st_ln(p, wv, lds, 0, 0), st_s5_tables(p, wv, 0, bidx, nbk), st_hy_taps(p, wv, lds, 0, bidx, nbk))));
    if (DUPSEL == 21) for (int _r = 0; _r < DUPN; ++_r) { PHASE(st_ln(p, wv, lds, 0, 0)); }
    if (DUPSEL == 23) for (int _r = 0; _r < DUPN; ++_r) { PHASE(st_s5_tables(p, wv, 0, bidx, nbk)); }
    if (DUPSEL == 24) for (int _r = 0; _r < DUPN; ++_r) { PHASE(st_hy_taps(p, wv, lds, 0, bidx, nbk)); }
#pragma unroll 1
    for (int l = 0; l < DEPTH; ++l) {
        lcur_ = l;
        PHASEN(3, REP(3, st_gemm<G_PROJ>(p, wv, lds, l, 0)));
        PHASEN(4, { REP(4, st_ret_a(p, wv, lds, l, ROT(0), nbk)); REP(5, st_gla_a(p, wv, lds, l, ROT(128), nbk)); REP(6, st_s5_a(p, wv, lds, l, ROT(64), nbk)); REP(7, st_hy_spec(p, wv, lds, l, bidx, nbk)); REP(8, st_hy_pre(p, wv, lds, l, bidx, nbk)); if (l == 0) st_hy_ctx_pre(p, wv, l, bidx, nbk); });
        PHASEN(5, (st_ret_b(p, wv, l, bidx, nbk), st_gla_b(p, wv, l, bidx, nbk), st_s5_b(p, wv, l, bidx, nbk)));
        if (DUPSEL == 25) for (int _r = 0; _r < DUPN; ++_r) { PHASE((st_ret_b(p, wv, l, bidx, nbk, true), st_gla_b(p, wv, l, bidx, nbk, true), st_s5_b(p, wv, l, bidx, nbk, true))); }
        PHASEN(6, { REP(9, st_ret_c(p, wv, lds, l, ROT(0), nbk)); REP(10, st_gla_c(p, wv, lds, l, ROT(160), nbk)); REP(11, st_s5_c(p, wv, lds, l, ROT(192), nbk)); st_hy_fft(p, wv, lds, l, bidx, nbk); if (l == 0) REP(22, st_hy_ctx_conv(p, wv, l, bidx, nbk)); });
        PHASEN(10, { REP(12, st_hy_post(p, wv, lds, l, bidx, nbk)); REP(13, st_glu2(p, wv, lds, l, bidx, nbk)); });
        PHASEN(11, REP(14, st_gemm<G_OUT>(p, wv, lds, l, 0)));
        if ((l & 1) == 0) {
            PHASEN(12, st_ln(p, wv, lds, l, 1));
            PHASEN(13, { st_gemm<G_FFN1>(p, wv, lds, l, 0); if (DUPSEL == 15) for (int _r = 0; _r < DUPN; ++_r) { st_gemm<G_FFN1>(p, wv, lds, l, 1); } });
            PHASEN(14, REP(16, st_gemm<G_FFN2>(p, wv, lds, l, 0)));
        } else {
            PHASEN(15, { st_ln(p, wv, lds, l, 1); REP(19, st_convert_items(p, wv, lds, 1)); });
            PHASEN(17, st_place(p, wv, lds));
#pragma unroll 1
            for (int ps = 0; ps < MOE_NPASS; ++ps) {
                PHASEN(18, REP(17, st_gemm<G_MFFN1>(p, wv, lds, l, ps)));
                PHASEN(19, REP(18, st_gemm<G_MFFN2>(p, wv, lds, l, ps)));
            }
        }
        PHASEN(20, (st_ln(p, wv, lds, l, 2), (l + 1 < DEPTH ? (st_s5_tables(p, wv, l + 1, bidx, nbk), st_hy_taps(p, wv, lds, l + 1, bidx, nbk)) : (void)0)));
        if (DUPSEL == 20) for (int _r = 0; _r < 10; ++_r) { PHASE((void)0); }
    }
}

static inline size_t align_up(size_t v, size_t a) { return (v + a - 1) / a * a; }
#ifdef EMU
Params g_dbg_params;
#endif

extern "C" void kernel_launch(void* const* d_in, const int* in_sizes, int n_in, void* d_out, int out_size, void* d_ws,
                              size_t ws_size, hipStream_t stream) {
    Params p{};
    for (int i = 0; i < N_IN; ++i) p.in[i] = (const float*)d_in[i];
    p.out = (float*)d_out;
    char* ws = (char*)d_ws;
    size_t off = 0;
    auto take = [&](size_t bytes) { char* r = ws + off; off = align_up(off + bytes, 256); return r; };
    const size_t A = sizeof(act_t);
    p.ctl = (unsigned*)take(CTL_WORDS * 4);
    p.u = (act_t*)take((size_t)NTOK * DM * A > (size_t)NTOK * DM * 2 ? (size_t)NTOK * DM * A : (size_t)NTOK * DM * 2);
    p.retD = (float*)p.u;
    p.glaD = p.retD + (size_t)NTOK * 256;
    const size_t mix_bytes = (size_t)NTOK * DM * A + (size_t)2 * NTOK * 256 * 4;
    char* mixr = take(mix_bytes);
    p.mix = (act_t*)mixr;
    p.osum = (float*)(mixr + (size_t)NTOK * DM * A);
    p.gbuf = (act_t*)p.osum;
    p.loga = p.osum + (size_t)NTOK * 256;
    p.ys = (act_t*)mixr;
    const size_t ys_bytes = align_up((size_t)2 * NLAT * DM * A, 256);
    char* moe_base = mixr + (ys_bytes < mix_bytes ? ys_bytes : align_up(mix_bytes, 256));
    p.wmoe13 = (act_t*)moe_base;
    p.wmoe2 = p.wmoe13 + (size_t)NEXP * 2 * DFF * DM;
    p.hch = p.wmoe2 + (size_t)NEXP * DM * DFF;
    char* moe_end = (char*)(p.hch + (size_t)MOE_PT * 256 * DFF);
    p.proj = (act_t*)take((size_t)NTOK * PROJ_W * A);
    p.hz = (act_t*)take((size_t)NTOK * 256 * A);
    p.s5Win = (act_t*)take((size_t)16 * 1024 * 256 * A);
    p.s5Wend = (act_t*)take((size_t)16 * 1024 * 256 * A);
    p.glaE = (float*)take((size_t)BATCH * 4 * 2 * ((CTXL + SEQ) / 64) * 32 * 4);
    p.win_t = (act_t*)take((size_t)DEPTH * NPROJ_T * DM * A);
    p.wout_t = (act_t*)take((size_t)DEPTH * DM * DM * A);
    p.w13_t = (act_t*)take((size_t)2 * DFF * DM * A);
    p.w2_t = (act_t*)take((size_t)DM * DFF * A);
    p.wglu_t = (act_t*)take((size_t)DEPTH * 256 * 256 * A);
    p.hctx = (float*)take((size_t)NCTX * DM * 4);
    p.filt = (float*)take((size_t)DEPTH * FILT_LAYER_FLOATS * 4);
    p.fnorm = (float*)take((size_t)DEPTH * 256 * 4);
    p.hdn2 = (float*)take((size_t)DEPTH * SEQ * 64 * 4);
    p.fft_tw = (float*)take((size_t)FN * 2 * 4);
    p.hspec = (float*)take((size_t)256 * FN * 2 * 4);
    p.rot = (float*)take((size_t)SEQ * 32 * 2 * 4);
    p.s5tab = (float*)take((size_t)DEPTH * 2 * 16 * 64 * 36 * 4);
    p.s5pw = (float*)take((size_t)DEPTH * 2 * 16 * 65 * 64 * 2 * 4);
    p.s5Tc = (act_t*)take((size_t)16 * 127 * 256 * A);
    p.s5S = (float*)take((size_t)BATCH * 16 * 2 * ((CTXL + SEQ) / 64) * 128 * 4);
    if (ws + off < moe_end) off = align_up((size_t)(moe_end - ws), 256);
    p.mod = (float*)take((size_t)DEPTH * (BATCH + 1) * 6 * DM * 4);
    p.tok_e = (int*)take((size_t)NLAT * 2 * 4);
    p.tok_g = (float*)take((size_t)NLAT * 2 * 4);
    p.slot_asg = (int*)take((size_t)MOE_CAP * 4);
    p.tok_slot = (int*)take((size_t)NLAT * 2 * 4);
    p.tail_asg = (int*)take((size_t)MOE_TAIL_ROWS * 4);
    p.tail_g = (float*)take((size_t)MOE_TAIL_ROWS * 4);
    p.pbuf_d = p.mix;
    p.pbuf_m = p.hch + (size_t)MOE_TAIL_ROWS * DFF;
#ifdef EMU
    g_dbg_params = p;
    memset(p.ctl, 0, CTL_WORDS * 4);
    forward(p);
#else
    if (off > ws_size) return;
    static int grid_blocks = 0;
    if (!grid_blocks) {
        int dev = 0, cus = 0;
        (void)hipGetDevice(&dev);
        (void)hipDeviceGetAttribute(&cus, hipDeviceAttributeMultiprocessorCount, dev);
        (void)hipFuncSetAttribute((const void*)fwd_megakernel<0>, hipFuncAttributeMaxDynamicSharedMemorySize, LDS_BYTES);
#if PREFIX_K > 0
        (void)hipFuncSetAttribute((const void*)fwd_megakernel<PREFIX_K>, hipFuncAttributeMaxDynamicSharedMemorySize, LDS_BYTES);
#endif
        grid_blocks = cus;
    }
#if PREFIX_K > 0
    (void)hipMemsetAsync(p.ctl, 0, CTL_WORDS * 4, stream);
    hipLaunchKernelGGL(fwd_megakernel<PREFIX_K>, dim3(grid_blocks), dim3(NT), LDS_BYTES, stream, p);
#endif
    (void)hipMemsetAsync(p.ctl, 0, CTL_WORDS * 4, stream);
    hipLaunchKernelGGL(fwd_megakernel<0>, dim3(grid_blocks), dim3(NT), LDS_BYTES, stream, p);
#endif
}
```
